# Optimizing an MI355X kernel written in HIP

```python
import math
import jax, jax.numpy as jnp
from jax import lax
import numpy as np

D_MODEL = 2048
BATCH = 8
SEQ = 2048
DEPTH = 2

N_MIXERS = 2
N_RET_LAYERS = (DEPTH + 1) // 2
N_MOBA_LAYERS = DEPTH // 2
DEEPNORM_ALPHA = (2.0 * DEPTH) ** 0.25
DEEPNORM_BETA = (8.0 * DEPTH) ** -0.25
LN_EPS = 1e-5
ADA_SCALE = 0.1

RET_HEADS = 8
RET_DK = D_MODEL // RET_HEADS
RET_DV = 2 * D_MODEL // RET_HEADS
RET_QK = RET_HEADS * RET_DK
RET_V = RET_HEADS * RET_DV
RET_GATE = RET_V
RET_IN = 2 * RET_QK + RET_V + RET_GATE
RET_CHUNK = 128
RET_THETA = 10000.0
RET_GN_EPS = 1e-5

MOBA_HEADS = 16
MOBA_DH = D_MODEL // MOBA_HEADS
MOBA_W = MOBA_HEADS * MOBA_DH
MOBA_IN = 4 * MOBA_W
MOBA_BLOCK = 256
MOBA_TOPK = 3
MOBA_QCHUNK = 8
ROPE_THETA = 500000.0
ROPE_DIMS = MOBA_DH // 4
NEG = -1e30

kernel_name = "hybrid_retention_moba_adaln_deepnorm"


def _rope(x, pos, n_rot, theta):
    half = n_rot // 2
    inv = theta ** (-jnp.arange(half, dtype=jnp.float32) * 2.0 / n_rot)
    ang = pos.astype(jnp.float32)[..., None] * inv
    cos = jnp.cos(ang)[:, :, None, :].astype(x.dtype)
    sin = jnp.sin(ang)[:, :, None, :].astype(x.dtype)
    x1 = x[..., :half]
    x2 = x[..., half:n_rot]
    return jnp.concatenate([x1 * cos - x2 * sin, x2 * cos + x1 * sin, x[..., n_rot:]], axis=-1)


def _layernorm(x, g, b):
    xf = x.astype(jnp.float32)
    mu = jnp.mean(xf, axis=-1, keepdims=True)
    var = jnp.mean(jnp.square(xf - mu), axis=-1, keepdims=True)
    y = (xf - mu) * lax.rsqrt(var + LN_EPS)
    return (y * g.astype(jnp.float32) + b.astype(jnp.float32)).astype(x.dtype)


def _retention(h, w_in, w_out, positions):
    B, S, _ = h.shape
    proj = h @ w_in
    q = proj[..., :RET_QK].reshape(B, S, RET_HEADS, RET_DK)
    k = proj[..., RET_QK:2 * RET_QK].reshape(B, S, RET_HEADS, RET_DK)
    v = proj[..., 2 * RET_QK:2 * RET_QK + RET_V].reshape(B, S, RET_HEADS, RET_DV)
    g = proj[..., 2 * RET_QK + RET_V:]
    q = _rope(q, positions, RET_DK, RET_THETA)
    k = _rope(k, positions, RET_DK, RET_THETA) * (RET_DK ** -0.5)

    n_chunks = S // RET_CHUNK
    def to_chunks(t):
        return t.reshape(B, n_chunks, RET_CHUNK, RET_HEADS, t.shape[-1]).transpose(1, 0, 3, 2, 4)
    qc, kc, vc = to_chunks(q), to_chunks(k), to_chunks(v)

    log_gamma = jnp.log(1.0 - 2.0 ** (-5.0 - jnp.arange(RET_HEADS, dtype=jnp.float32)))
    n = jnp.arange(RET_CHUNK, dtype=jnp.float32)
    diff = n[:, None] - n[None, :]
    inner_decay = jnp.where(diff >= 0, jnp.exp(jnp.maximum(diff, 0.0) * log_gamma[:, None, None]), 0.0).astype(h.dtype)
    q_decay = jnp.exp((n + 1.0) * log_gamma[:, None]).astype(h.dtype)
    k_decay = jnp.exp((RET_CHUNK - 1.0 - n) * log_gamma[:, None]).astype(h.dtype)
    chunk_decay = jnp.exp(RET_CHUNK * log_gamma).astype(h.dtype)

    def step(state, xs):
        qi, ki, vi = xs
        scores = jnp.einsum('bhnd,bhmd->bhnm', qi, ki) * inner_decay
        inner = jnp.einsum('bhnm,bhmv->bhnv', scores, vi)
        cross = jnp.einsum('bhnd,bhdv->bhnv', qi, state) * q_decay[None, :, :, None]
        new_state = state * chunk_decay[None, :, None, None] + jnp.einsum(
            'bhmd,bhmv->bhdv', ki * k_decay[None, :, :, None], vi)
        return new_state, inner + cross

    state0 = jnp.zeros((B, RET_HEADS, RET_DK, RET_DV), dtype=qc.dtype)
    _, o = lax.scan(step, state0, (qc, kc, vc))
    o = o.transpose(1, 0, 3, 2, 4).reshape(B, S, RET_HEADS, RET_DV)
    of = o.astype(jnp.float32)
    mu = jnp.mean(of, axis=-1, keepdims=True)
    var = jnp.mean(jnp.square(of - mu), axis=-1, keepdims=True)
    o = ((of - mu) * lax.rsqrt(var + RET_GN_EPS)).astype(h.dtype).reshape(B, S, RET_V)
    return (o * jax.nn.silu(g)) @ w_out


def _moba(h, w_in, w_out, positions):
    B, S, _ = h.shape
    proj = h @ w_in
    q = proj[..., :MOBA_W].reshape(B, S, MOBA_HEADS, MOBA_DH)
    k = proj[..., MOBA_W:2 * MOBA_W].reshape(B, S, MOBA_HEADS, MOBA_DH)
    v = proj[..., 2 * MOBA_W:3 * MOBA_W].reshape(B, S, MOBA_HEADS, MOBA_DH)
    g = proj[..., 3 * MOBA_W:]
    q = _rope(q, positions, ROPE_DIMS, ROPE_THETA).transpose(0, 2, 1, 3)
    k = _rope(k, positions, ROPE_DIMS, ROPE_THETA).transpose(0, 2, 1, 3)
    v = v.transpose(0, 2, 1, 3)

    n_blocks = -(-S // MOBA_BLOCK)
    pad = n_blocks * MOBA_BLOCK - S
    kb = jnp.pad(k, ((0, 0), (0, 0), (0, pad), (0, 0))).reshape(B, MOBA_HEADS, n_blocks, MOBA_BLOCK, MOBA_DH)
    vb = jnp.pad(v, ((0, 0), (0, 0), (0, pad), (0, 0))).reshape(B, MOBA_HEADS, n_blocks, MOBA_BLOCK, MOBA_DH)
    k_mean = jnp.mean(kb, axis=3)

    t = jnp.arange(S)
    blk_t = t // MOBA_BLOCK
    gate = jnp.einsum('bhtd,bhnd->bhtn', q, k_mean).astype(jnp.float32)
    past = jnp.arange(n_blocks)[None, :] < blk_t[:, None]
    gate = jnp.where(past, gate, NEG)
    topk = min(MOBA_TOPK, n_blocks)
    _, top_idx = lax.top_k(gate, topk)
    valid = top_idx < blk_t[None, None, :, None]

    n_q = S // MOBA_QCHUNK
    def qchunks(a):
        a = a.reshape(B, MOBA_HEADS, n_q, MOBA_QCHUNK, *a.shape[3:])
        return jnp.moveaxis(a, 2, 0)
    qs, idxs, valids = qchunks(q), qchunks(top_idx), qchunks(valid)
    scale = MOBA_DH ** -0.5
    bi = jnp.arange(B)[:, None, None, None]
    hi = jnp.arange(MOBA_HEADS)[None, :, None, None]

    def chunk_fn(args):
        ci, qc, idxc, validc = args
        tq = ci * MOBA_QCHUNK + jnp.arange(MOBA_QCHUNK)
        own = (ci * MOBA_QCHUNK) // MOBA_BLOCK
        k_own = lax.dynamic_index_in_dim(kb, own, axis=2, keepdims=False)
        v_own = lax.dynamic_index_in_dim(vb, own, axis=2, keepdims=False)
        kpos_own = own * MOBA_BLOCK + jnp.arange(MOBA_BLOCK)
        s_own = jnp.einsum('bhqd,bhkd->bhqk', qc, k_own).astype(jnp.float32) * scale
        s_own = jnp.where(kpos_own[None, :] <= tq[:, None], s_own, NEG)
        kg = kb[bi, hi, idxc]
        vg = vb[bi, hi, idxc]
        s_sel = jnp.einsum('bhqd,bhqnkd->bhqnk', qc, kg).astype(jnp.float32) * scale
        s_sel = jnp.where(validc[..., None], s_sel, NEG)
        logits = jnp.concatenate([s_sel.reshape(*s_sel.shape[:3], -1), s_own], axis=-1)
        p = jax.nn.softmax(logits, axis=-1).astype(qc.dtype)
        n_sel = topk * MOBA_BLOCK
        p_sel = p[..., :n_sel].reshape(s_sel.shape)
        p_own = p[..., n_sel:]
        return (jnp.einsum('bhqnk,bhqnkd->bhqd', p_sel, vg)
                + jnp.einsum('bhqk,bhkd->bhqd', p_own, v_own))

    o = lax.map(chunk_fn, (jnp.arange(n_q), qs, idxs, valids))
    o = o.transpose(1, 0, 3, 2, 4).reshape(B, S, MOBA_W)
    return (o * jax.nn.silu(g)) @ w_out


def setup_inputs(seed: int = 0) -> dict:
    key = jax.random.key(seed)
    ks = jax.random.split(key, 16)
    D = D_MODEL
    x = jax.random.normal(ks[0], (BATCH, SEQ, D), jnp.float32)
    c = jax.random.normal(ks[1], (BATCH, D), jnp.float32)
    offs = jax.random.randint(ks[2], (BATCH, 1), 0, 4096, dtype=jnp.int32)
    positions = (offs + jnp.arange(SEQ, dtype=jnp.int32)[None, :]).astype(jnp.int32)

    ret_w_in = jax.random.normal(ks[3], (N_RET_LAYERS, D, RET_IN), jnp.float32) * D ** -0.5
    col = jnp.arange(RET_IN)
    v_cols = (col >= 2 * RET_QK) & (col < 2 * RET_QK + RET_V)
    ret_w_in = ret_w_in * jnp.where(v_cols, DEEPNORM_BETA, 1.0).astype(jnp.float32)
    ret_w_out = jax.random.normal(ks[4], (N_RET_LAYERS, RET_V, D), jnp.float32) * (RET_V ** -0.5 * DEEPNORM_BETA)

    moba_w_in = jax.random.normal(ks[5], (N_MOBA_LAYERS, D, MOBA_IN), jnp.float32) * D ** -0.5
    mcol = jnp.arange(MOBA_IN)
    mv_cols = (mcol >= 2 * MOBA_W) & (mcol < 3 * MOBA_W)
    moba_w_in = moba_w_in * jnp.where(mv_cols, DEEPNORM_BETA, 1.0).astype(jnp.float32)
    moba_w_out = jax.random.normal(ks[6], (N_MOBA_LAYERS, MOBA_W, D), jnp.float32) * (MOBA_W ** -0.5 * DEEPNORM_BETA)

    w_ada = jax.random.normal(ks[7], (DEPTH, D, 3 * D), jnp.float32) * (ADA_SCALE * D ** -0.5)
    b_ada = 0.02 * jax.random.normal(ks[8], (DEPTH, 3 * D), jnp.float32)
    b_ada = b_ada + jnp.concatenate([jnp.zeros((2 * D,)), jnp.ones((D,))]).astype(jnp.float32)[None, :]
    ln_g = 1.0 + 0.02 * jax.random.normal(ks[9], (DEPTH, D), jnp.float32)
    ln_b = 0.02 * jax.random.normal(ks[10], (DEPTH, D), jnp.float32)
    return {"x": x, "c": c, "positions": positions,
            "ret_w_in": ret_w_in, "ret_w_out": ret_w_out,
            "moba_w_in": moba_w_in, "moba_w_out": moba_w_out,
            "w_ada": w_ada, "b_ada": b_ada, "ln_g": ln_g, "ln_b": ln_b}


def reference(x, c, positions, ret_w_in, ret_w_out, moba_w_in, moba_w_out, w_ada, b_ada, ln_g, ln_b):
    D = x.shape[-1]
    for layer in range(DEPTH):
        mod = c @ w_ada[layer] + b_ada[layer]
        shift = mod[:, None, :D]
        scale = mod[:, None, D:2 * D]
        gate = mod[:, None, 2 * D:]
        h = x * (1.0 + scale) + shift
        if layer % N_MIXERS == 0:
            y = _retention(h, ret_w_in[layer // N_MIXERS], ret_w_out[layer // N_MIXERS], positions)
        else:
            y = _moba(h, moba_w_in[layer // N_MIXERS], moba_w_out[layer // N_MIXERS], positions)
        x = _layernorm(DEEPNORM_ALPHA * x + gate * y, ln_g[layer], ln_b[layer])
    return x
```

```cpp
#include <hip/hip_runtime.h>
#include <cstdio>
#include <cstdint>
#include <cmath>

typedef _Float16 h16;
typedef _Float16 h16x8 __attribute__((ext_vector_type(8)));
typedef _Float16 h16x4 __attribute__((ext_vector_type(4)));
typedef _Float16 h16x2 __attribute__((ext_vector_type(2)));
typedef float f32x4 __attribute__((ext_vector_type(4)));
typedef float f32x2 __attribute__((ext_vector_type(2)));
typedef unsigned u32x4 __attribute__((ext_vector_type(4)));
typedef unsigned u32x2 __attribute__((ext_vector_type(2)));
#define LAS __attribute__((address_space(3)))

constexpr int D = 2048, BATCH = 8, SEQ = 2048, M = BATCH * SEQ;
constexpr int RET_HEADS = 8, RET_DK = 256, RET_DV = 512, RET_QK = 2048, RET_V = 4096, RET_IN = 12288;
constexpr int MOBA_HEADS = 16, MOBA_DH = 128, MOBA_W = 2048, MOBA_IN = 8192, MOBA_BLOCK = 256, NBLK = 8;
constexpr float ALPHA = 1.4142135623730951f;
constexpr float LN_EPS = 1e-5f, GN_EPS = 1e-5f;
constexpr int MODW = 3 * D;
constexpr int KSPLIT = 4;

constexpr size_t MiB = 1u << 20;
constexpr size_t WS_CTL = 0;
constexpr size_t WS_MOD = 1 * MiB;
constexpr size_t WS_KMEAN = WS_MOD + 512 * 1024;
constexpr size_t WS_RCS1 = 2 * MiB;
constexpr size_t WS_W0IN = 4 * MiB;
constexpr size_t WS_W0OUT = 52 * MiB;
constexpr size_t WS_W1IN = 68 * MiB;
constexpr size_t WS_W1OUT = 100 * MiB;
constexpr size_t WS_ACT = 108 * MiB;
constexpr size_t WS_Q0 = WS_ACT, WS_K0 = WS_ACT + 64 * MiB, WS_V0 = WS_ACT + 128 * MiB, WS_G0 = WS_ACT + 256 * MiB;
constexpr size_t WS_H1 = WS_ACT, WS_Q1 = WS_ACT + 64 * MiB, WS_K1 = WS_ACT + 128 * MiB, WS_V1 = WS_ACT + 192 * MiB, WS_G1 = WS_ACT + 256 * MiB, WS_A1 = WS_ACT + 320 * MiB;
constexpr size_t WS_RCS0 = 492 * MiB;
constexpr size_t WS_PART = 508 * MiB;
constexpr size_t WS_END = 512 * MiB;

__device__ __forceinline__ unsigned pk_h2(float lo, float hi) { h16x2 h = {(h16)lo, (h16)hi}; return __builtin_bit_cast(unsigned, h); }
__device__ __forceinline__ float wave_sum(float v) {
#pragma unroll
    for (int o = 1; o < 64; o <<= 1) v += __shfl_xor(v, o);
    return v;
}
__device__ __forceinline__ float silu(float g) { return g / (1.0f + __expf(-g)); }

namespace pg8 {
constexpr int BM = 256, BK = 64, HALF = 128, HTB = HALF * BK * 2, STAGE_BYTES = 8 * HTB, NXCD = 8, WGM = 8;
__host__ __device__ __forceinline__ int lds_byte(int r, int c) { const int st = (r >> 4) * 2 + (c >> 5), rr = r & 15, cc = c & 31, ob = rr * 64 + cc * 2; return st * 1024 + (ob ^ (((ob >> 9) & 1) << 5)); }
__host__ __device__ __forceinline__ void stage_rc(int b, int& R, int& C) { const int st = b / 1024, sb = b % 1024, swz = sb ^ (((sb >> 9) & 1) << 5); R = (st >> 1) * 16 + swz / 64; C = (st & 1) * 32 + (swz % 64) / 2; }
__host__ __device__ __forceinline__ int perm32(int rho) { const int n = rho >> 4, i = rho & 15; return 8 * (i >> 2) + 4 * n + (i & 3); }
struct Unit { int pm, pn; };
struct Gemm { const h16* A; const h16* Bt; int M, N, K, pad; };
struct StaticOrder {
    int nM, nN, nwg, G, c;
    __host__ __device__ void init(int M_, int N_, int G_, int c_) { nM = M_ / BM; nN = N_ / BM; nwg = nM * nN; G = G_; c = c_; }
    __host__ __device__ bool next(int i, Unit& u) const {
        const long L = (long)i * G + c; if (L >= nwg) return false;
        int wgid = (int)L; { const int q = nwg / NXCD, r = nwg % NXCD, xcd = wgid % NXCD, off = wgid / NXCD; wgid = (xcd < r ? xcd * (q + 1) : r * (q + 1) + (xcd - r) * q) + off; }
        const int nig = WGM * nN, gid = wgid / nig, fm = gid * WGM, gsz = (nM - fm) < WGM ? (nM - fm) : WGM;
        u.pm = fm + ((wgid % nig) % gsz); u.pn = (wgid % nig) / gsz; return true;
    }
    __device__ __forceinline__ void a_ready(const Unit&) const {}
    __device__ __forceinline__ void done(const Unit&) const {}
};

template <class Epi, class Sched, bool ALIGN_EPI = false, bool SP2 = false>
__device__ __forceinline__ void gemm_phase(LAS unsigned char* lds, const Gemm g, const Sched& S, const Epi& E) {
    const int tid = threadIdx.x, wid = __builtin_amdgcn_readfirstlane(tid >> 6), lane = tid & 63, wr = wid >> 2, wc = wid & 3, fr = lane & 15, fq = lane >> 4;
    const int K = g.K, nt = K / BK;
    unsigned voffA[2], voffB[2];
#pragma unroll
    for (int i = 0; i < 2; ++i) { int R, C; stage_rc(tid * 16 + i * 8192, R, C); const int Rb = Epi::PERM ? ((R & ~31) + perm32(R & 31)) : R;
        voffA[i] = (unsigned)(R * K + C) * 2u; voffB[i] = (unsigned)(Rb * K + C) * 2u; }
    const size_t kstep = (size_t)(BK * 2);
    const size_t hstep = (size_t)HALF * K * 2;
    const size_t tstep = 2 * hstep;
    const unsigned ldsw = (unsigned)wid * 1024u;
    const int aoff = lds_byte(wr * 64 + fr, fq * 8), boff = lds_byte(wc * 32 + fr, fq * 8);
#define PG8_SA(b, h) (((b) * 2 + (h)) * HTB)
#define PG8_SB(b, h) ((4 + (b) * 2 + (h)) * HTB)
#define PG8_STAGE(bufoff, gbase, voff) do { _Pragma("unroll") for (int _i = 0; _i < 2; ++_i) \
        __builtin_amdgcn_global_load_lds((const unsigned*)((const char*)(gbase) + (voff)[_i]), (LAS unsigned*)(lds + (bufoff) + ldsw + _i * 8192), 16, 0, 0); } while (0)
#define PG8_LDA(dst, b, h) do { _Pragma("unroll") for (int m = 0; m < 4; ++m) _Pragma("unroll") for (int k = 0; k < 2; ++k) dst[m][k] = *(const LAS h16x8*)(lds + PG8_SA(b, h) + aoff + m * 2048 + k * 1024); } while (0)
#define PG8_LDB(dst, b, h) do { _Pragma("unroll") for (int n = 0; n < 2; ++n) _Pragma("unroll") for (int k = 0; k < 2; ++k) dst[n][k] = *(const LAS h16x8*)(lds + PG8_SB(b, h) + boff + n * 2048 + k * 1024); } while (0)
#define PG8_MMA(ai, bj, At, Bt) do { __builtin_amdgcn_s_setprio(1); _Pragma("unroll") for (int m = 0; m < 4; ++m) _Pragma("unroll") for (int n = 0; n < 2; ++n) _Pragma("unroll") for (int k = 0; k < 2; ++k) \
        acc[ai][bj][m][n] = __builtin_amdgcn_mfma_f32_16x16x32_f16(Bt[n][k], At[m][k], acc[ai][bj][m][n], 0, 0, 0); __builtin_amdgcn_s_setprio(0); } while (0)
#define PG8_WAIT_V(n) asm volatile("s_waitcnt vmcnt(" #n ")" ::: "memory")
#define PG8_WAIT_L(n) asm volatile("s_waitcnt lgkmcnt(" #n ")" ::: "memory")
#define PG8_BAR __builtin_amdgcn_s_barrier()
#define PG8_SCHED __builtin_amdgcn_sched_barrier(0)
    Unit cur, nxt; int ui = 0;
    if (!S.next(0, cur)) return;
    f32x4 acc[2][2][4][2];
#pragma unroll
    for (int a = 0; a < 2; ++a)
#pragma unroll
        for (int b = 0; b < 2; ++b)
#pragma unroll
            for (int m = 0; m < 4; ++m)
#pragma unroll
                for (int n = 0; n < 2; ++n) acc[a][b][m][n] = (f32x4){0.f, 0.f, 0.f, 0.f};
    h16x8 At[4][2], B0[2][2], B1[2][2];
    const char* cA = (const char*)g.A + (size_t)cur.pm * tstep; const char* cB = (const char*)g.Bt + (size_t)cur.pn * tstep;
    S.a_ready(cur);
    if constexpr (SP2) {
        PG8_STAGE(PG8_SB(0, 0), cB, voffB); PG8_STAGE(PG8_SB(0, 1), cB + hstep, voffB); PG8_STAGE(PG8_SA(0, 0), cA, voffA); PG8_STAGE(PG8_SA(0, 1), cA + hstep, voffA);
        if (wr == 1) PG8_BAR;
        PG8_WAIT_V(2); PG8_BAR;
        PG8_STAGE(PG8_SB(1, 0), cB + kstep, voffB); PG8_STAGE(PG8_SA(1, 0), cA + kstep, voffA); PG8_STAGE(PG8_SB(1, 1), cB + hstep + kstep, voffB);
        PG8_WAIT_V(6); PG8_BAR;
    } else {
        PG8_STAGE(PG8_SB(0, 0), cB, voffB); PG8_STAGE(PG8_SA(0, 0), cA, voffA); PG8_STAGE(PG8_SB(0, 1), cB + hstep, voffB); PG8_STAGE(PG8_SA(0, 1), cA + hstep, voffA);
        if (wr == 1) PG8_BAR;
        PG8_WAIT_V(4); PG8_BAR;
        PG8_STAGE(PG8_SB(1, 0), cB + kstep, voffB); PG8_STAGE(PG8_SA(1, 0), cA + kstep, voffA); PG8_STAGE(PG8_SB(1, 1), cB + hstep + kstep, voffB);
        PG8_WAIT_V(6); PG8_BAR;
    }
    for (;;) {
        const bool has_next = S.next(ui + 1, nxt);
        const char* nA = has_next ? (const char*)g.A + (size_t)nxt.pm * tstep : cA; const char* nB = has_next ? (const char*)g.Bt + (size_t)nxt.pn * tstep : cB;
        for (int t = 0; t < nt; t += 2) {
            const bool last = (t == nt - 2);
            const char* a1 = cA + (size_t)(t + 1) * kstep;
            const char* a2 = last ? nA : cA + (size_t)(t + 2) * kstep; const char* b2 = last ? nB : cB + (size_t)(t + 2) * kstep;
            const char* a3 = a2 + kstep; const char* b3 = b2 + kstep;
            if (last && has_next) S.a_ready(nxt);
            if constexpr (SP2) {
            PG8_LDB(B0, 0, 0); PG8_LDB(B1, 0, 1); PG8_SCHED; PG8_LDA(At, 0, 0); PG8_STAGE(PG8_SA(1, 1), a1 + hstep, voffA);
            PG8_WAIT_V(8); PG8_WAIT_L(0); PG8_BAR; PG8_MMA(0, 0, At, B0); PG8_MMA(0, 1, At, B1); PG8_BAR; PG8_SCHED;
            PG8_LDA(At, 0, 1); PG8_STAGE(PG8_SB(0, 0), b2, voffB); PG8_STAGE(PG8_SB(0, 1), b2 + hstep, voffB); PG8_STAGE(PG8_SA(0, 0), a2, voffA);
            PG8_WAIT_V(8); PG8_WAIT_L(0); PG8_BAR; PG8_MMA(1, 0, At, B0); PG8_MMA(1, 1, At, B1); PG8_BAR; PG8_SCHED;
            PG8_LDB(B0, 1, 0); PG8_LDB(B1, 1, 1); PG8_SCHED; PG8_LDA(At, 1, 0); PG8_STAGE(PG8_SA(0, 1), a2 + hstep, voffA);
            PG8_WAIT_V(8); PG8_WAIT_L(0); PG8_BAR; PG8_MMA(0, 0, At, B0); PG8_MMA(0, 1, At, B1); PG8_BAR; PG8_SCHED;
            PG8_LDA(At, 1, 1); PG8_STAGE(PG8_SB(1, 0), b3, voffB); PG8_STAGE(PG8_SB(1, 1), b3 + hstep, voffB); PG8_STAGE(PG8_SA(1, 0), a3, voffA);
            PG8_WAIT_V(8); PG8_WAIT_L(0); PG8_BAR; PG8_MMA(1, 0, At, B0); PG8_MMA(1, 1, At, B1); PG8_BAR; PG8_SCHED;
            } else {
            PG8_LDB(B0, 0, 0); PG8_SCHED; PG8_LDA(At, 0, 0); PG8_STAGE(PG8_SA(1, 1), a1 + hstep, voffA);
            PG8_WAIT_L(8); PG8_BAR; PG8_WAIT_L(0); PG8_MMA(0, 0, At, B0); PG8_BAR; PG8_SCHED;
            PG8_LDB(B1, 0, 1); PG8_STAGE(PG8_SB(0, 0), b2, voffB);
            PG8_BAR; PG8_WAIT_L(0); PG8_MMA(0, 1, At, B1); PG8_BAR;
            PG8_LDA(At, 0, 1); PG8_STAGE(PG8_SA(0, 0), a2, voffA);
            PG8_BAR; PG8_WAIT_L(0); PG8_MMA(1, 0, At, B0); PG8_BAR; PG8_SCHED;
            PG8_STAGE(PG8_SB(0, 1), b2 + hstep, voffB);
            PG8_WAIT_V(6); PG8_BAR; PG8_MMA(1, 1, At, B1); PG8_BAR;
            PG8_LDB(B0, 1, 0); PG8_SCHED; PG8_LDA(At, 1, 0); PG8_STAGE(PG8_SA(0, 1), a2 + hstep, voffA);
            PG8_WAIT_L(8); PG8_BAR; PG8_WAIT_L(0); PG8_MMA(0, 0, At, B0); PG8_BAR; PG8_SCHED;
            PG8_LDB(B1, 1, 1); PG8_STAGE(PG8_SB(1, 0), b3, voffB);
            PG8_BAR; PG8_WAIT_L(0); PG8_MMA(0, 1, At, B1); PG8_BAR;
            PG8_LDA(At, 1, 1); PG8_STAGE(PG8_SA(1, 0), a3, voffA);
            PG8_BAR; PG8_WAIT_L(0); PG8_MMA(1, 0, At, B0); PG8_BAR; PG8_SCHED;
            PG8_STAGE(PG8_SB(1, 1), b3 + hstep, voffB);
            PG8_WAIT_V(6); PG8_BAR; PG8_MMA(1, 1, At, B1); PG8_BAR;
            }
        }
        if constexpr (ALIGN_EPI) { if (wr == 0) PG8_BAR; }
        if constexpr (!Epi::AFTER_DRAIN) { E(acc, cur, wr, wc, fr, fq); S.done(cur); }
        if (!has_next) break;
#pragma unroll
        for (int a = 0; a < 2; ++a)
#pragma unroll
            for (int b = 0; b < 2; ++b)
#pragma unroll
                for (int m = 0; m < 4; ++m)
#pragma unroll
                    for (int n = 0; n < 2; ++n) acc[a][b][m][n] = (f32x4){0.f, 0.f, 0.f, 0.f};
        cur = nxt; cA = nA; cB = nB; ++ui;
        if constexpr (ALIGN_EPI) { if (wr == 1) PG8_BAR; }
    }
    PG8_WAIT_V(0);
    if constexpr (!ALIGN_EPI) { if (wr == 0) PG8_BAR; }
    PG8_BAR;
#undef PG8_SA
#undef PG8_SB
#undef PG8_STAGE
#undef PG8_LDA
#undef PG8_LDB
#undef PG8_MMA
#undef PG8_WAIT_V
#undef PG8_WAIT_L
#undef PG8_BAR
#undef PG8_SCHED
}
}

struct EpiRet {
    static constexpr bool PERM = true, AFTER_DRAIN = false;
    h16 *Q, *K, *V, *G; const float2* rcs;
    __device__ __forceinline__ void operator()(const f32x4 (&acc)[2][2][4][2], const pg8::Unit& u, int wr, int wc, int fr, int fq) const {
        const int row0 = u.pm * 256 + wr * 64 + fr;
        if (u.pn < 16) {
            h16* base = (u.pn < 8) ? Q + u.pn * 256 : K + (u.pn - 8) * 256; const float sc = (u.pn < 8) ? 1.0f : 0.0625f;
            const int d0 = wc * 32 + 8 * fq;
#pragma unroll
            for (int ai = 0; ai < 2; ++ai)
#pragma unroll
                for (int m = 0; m < 4; ++m) {
                    const int row = row0 + ai * 128 + m * 16;
                    const f32x4* cs = (const f32x4*)(rcs + (size_t)row * 128 + d0);
                    float o1[8], o2[8];
#pragma unroll
                    for (int n = 0; n < 2; ++n) { const f32x4 c01 = cs[2 * n], c23 = cs[2 * n + 1]; const f32x4 x1 = acc[ai][0][m][n], x2 = acc[ai][1][m][n];
                        const float cc[4] = {c01[0], c01[2], c23[0], c23[2]}, ss[4] = {c01[1], c01[3], c23[1], c23[3]};
#pragma unroll
                        for (int j = 0; j < 4; ++j) { o1[4 * n + j] = (x1[j] * cc[j] - x2[j] * ss[j]) * sc; o2[4 * n + j] = (x2[j] * cc[j] + x1[j] * ss[j]) * sc; } }
                    u32x4 w1, w2; w1.x = pk_h2(o1[0], o1[1]); w1.y = pk_h2(o1[2], o1[3]); w1.z = pk_h2(o1[4], o1[5]); w1.w = pk_h2(o1[6], o1[7]);
                    w2.x = pk_h2(o2[0], o2[1]); w2.y = pk_h2(o2[2], o2[3]); w2.z = pk_h2(o2[4], o2[5]); w2.w = pk_h2(o2[6], o2[7]);
                    h16* rp = base + (size_t)row * RET_QK + d0;
                    *(u32x4*)rp = w1; *(u32x4*)(rp + 128) = w2;
                }
        } else {
            h16* base = (u.pn < 32) ? V + (u.pn - 16) * 256 : G + (u.pn - 32) * 256;
            const int c0 = wc * 32 + 8 * fq;
#pragma unroll
            for (int ai = 0; ai < 2; ++ai)
#pragma unroll
                for (int m = 0; m < 4; ++m) {
                    h16* rp = base + (size_t)(row0 + ai * 128 + m * 16) * RET_V + c0;
#pragma unroll
                    for (int bj = 0; bj < 2; ++bj) { const f32x4 v0 = acc[ai][bj][m][0], v1 = acc[ai][bj][m][1];
                        u32x4 w; w.x = pk_h2(v0[0], v0[1]); w.y = pk_h2(v0[2], v0[3]); w.z = pk_h2(v1[0], v1[1]); w.w = pk_h2(v1[2], v1[3]);
                        *(u32x4*)(rp + bj * 128) = w; }
                }
        }
    }
};
struct EpiMoba {
    static constexpr bool PERM = true, AFTER_DRAIN = false;
    h16 *Q, *K, *V, *G; const float2* rcs;
    __device__ __forceinline__ void operator()(const f32x4 (&acc)[2][2][4][2], const pg8::Unit& u, int wr, int wc, int fr, int fq) const {
        const int row0 = u.pm * 256 + wr * 64 + fr; const int sel = u.pn >> 3;
        h16* base = (sel == 0 ? Q : sel == 1 ? K : sel == 2 ? V : G) + (u.pn & 7) * 256 + wc * 32 + 8 * fq;
        const bool rope = (sel < 2) && (wc == 0);
#pragma unroll
        for (int ai = 0; ai < 2; ++ai)
#pragma unroll
            for (int m = 0; m < 4; ++m) {
                const int row = row0 + ai * 128 + m * 16;
                float cc[8], ss[8];
                if (rope) { const f32x4* cs = (const f32x4*)(rcs + (size_t)row * 16 + ((8 * fq) & 15));
#pragma unroll
                    for (int q = 0; q < 4; ++q) { const f32x4 t = cs[q]; cc[2 * q] = t[0]; ss[2 * q] = t[1]; cc[2 * q + 1] = t[2]; ss[2 * q + 1] = t[3]; } }
#pragma unroll
                for (int bj = 0; bj < 2; ++bj) {
                    float o[8];
#pragma unroll
                    for (int n = 0; n < 2; ++n)
#pragma unroll
                        for (int j = 0; j < 4; ++j) { const float x = acc[ai][bj][m][n][j]; float r = x;
                            if (rope) { const float y = __shfl_xor(x, 32); r = (fq < 2) ? (x * cc[4 * n + j] - y * ss[4 * n + j]) : (x * cc[4 * n + j] + y * ss[4 * n + j]); }
                            o[4 * n + j] = r; }
                    u32x4 w; w.x = pk_h2(o[0], o[1]); w.y = pk_h2(o[2], o[3]); w.z = pk_h2(o[4], o[5]); w.w = pk_h2(o[6], o[7]);
                    *(u32x4*)(base + (size_t)row * MOBA_W + bj * 128) = w;
                }
            }
    }
};
struct EpiRes {
    static constexpr bool PERM = false, AFTER_DRAIN = false;
    const float* xin; float* zout; const float* gate;
    __device__ __forceinline__ void operator()(const f32x4 (&acc)[2][2][4][2], const pg8::Unit& u, int wr, int wc, int fr, int fq) const {
        const int row0 = u.pm * 256 + wr * 64 + fr, col0 = u.pn * 256 + wc * 32 + 4 * fq; const int b = u.pm >> 3;
        f32x4 gv[2][2];
#pragma unroll
        for (int bj = 0; bj < 2; ++bj)
#pragma unroll
            for (int n = 0; n < 2; ++n) gv[bj][n] = *(const f32x4*)(gate + (size_t)b * MODW + col0 + bj * 128 + n * 16);
#pragma unroll
        for (int ai = 0; ai < 2; ++ai)
#pragma unroll
            for (int m = 0; m < 4; ++m) { const size_t off = (size_t)(row0 + ai * 128 + m * 16) * D + col0;
#pragma unroll
                for (int bj = 0; bj < 2; ++bj)
#pragma unroll
                    for (int n = 0; n < 2; ++n) { const f32x4 xv = *(const f32x4*)(xin + off + bj * 128 + n * 16);
                        *(f32x4*)(zout + off + bj * 128 + n * 16) = xv * ALPHA + gv[bj][n] * acc[ai][bj][m][n]; } }
    }
};

constexpr int GEMM_LDS = 147456;
template <class Epi>
__global__ void __launch_bounds__(512, 2) k_gemm(pg8::Gemm g, Epi E) {
    extern __shared__ __attribute__((aligned(16))) unsigned char lds[];
    pg8::StaticOrder S; S.init(g.M, g.N, (int)gridDim.x, (int)blockIdx.x);
    pg8::gemm_phase<Epi, pg8::StaticOrder, true, true>((LAS unsigned char*)lds, g, S, E);
}

__device__ __forceinline__ void mod_partial_item(int item, const float* c, const float* w_ada, float* part, float* lds) {
    const int tid = threadIdx.x, NT = blockDim.x, nks = NT / 16, kper = 512 / nks, nw = NT / 64;
    const int l = item / (96 * KSPLIT), r = item % (96 * KSPLIT), cg64 = r / KSPLIT, s = r % KSPLIT, k0 = s * 512, col0 = cg64 * 64;
    float* cs = lds;
    float* red = lds + 8 * 512;
    for (int i = tid; i < 8 * 512; i += NT) cs[i] = c[(i >> 9) * D + k0 + (i & 511)];
    __syncthreads();
    const int cg = tid & 15, ks = tid >> 4;
    f32x4 acc[8];
#pragma unroll
    for (int b = 0; b < 8; ++b) acc[b] = (f32x4){0.f, 0.f, 0.f, 0.f};
    const float* wp = w_ada + ((size_t)l * D + k0 + ks * kper) * MODW + col0 + cg * 4;
    for (int kk = 0; kk < kper; ++kk) { const f32x4 w = *(const f32x4*)(wp + (size_t)kk * MODW);
#pragma unroll
        for (int b = 0; b < 8; ++b) acc[b] += w * cs[b * 512 + ks * kper + kk]; }
#pragma unroll
    for (int b = 0; b < 8; ++b)
#pragma unroll
        for (int j = 0; j < 4; ++j) { float v = acc[b][j]; v += __shfl_xor(v, 16); v += __shfl_xor(v, 32); acc[b][j] = v; }
    if ((tid & 63) < 16) {
#pragma unroll
        for (int b = 0; b < 8; ++b) *(f32x4*)(red + ((tid >> 6) * 8 + b) * 64 + cg * 4) = acc[b];
    }
    __syncthreads();
    for (int o = tid; o < 512; o += NT) { float v = 0.f; for (int w = 0; w < nw; ++w) v += red[w * 512 + o];
        part[(((size_t)l * KSPLIT + s) * 8 + (o >> 6)) * MODW + col0 + (o & 63)] = v; }
    __syncthreads();
}
__global__ void __launch_bounds__(256) k_mod_partial(const float* c, const float* w_ada, float* part) {
    __shared__ float lds[8 * 512 + 4 * 512];
    for (int it = blockIdx.x; it < 2 * 96 * KSPLIT; it += gridDim.x) mod_partial_item(it, c, w_ada, part, lds);
}
__global__ void k_mod_reduce(const float* part, const float* b_ada, float* mod) {
    const int i = blockIdx.x * blockDim.x + threadIdx.x; if (i >= 2 * 8 * MODW) return;
    const int l = i / (8 * MODW), r = i % (8 * MODW), b = r / MODW, j = r % MODW;
    float v = b_ada[l * MODW + j];
    for (int s = 0; s < KSPLIT; ++s) v += part[(((size_t)l * KSPLIT + s) * 8 + b) * MODW + j];
    mod[i] = v;
}
__device__ __forceinline__ void transpose_item(const float* W, int K, int N, h16* WT, float* scr, int item, int lane) {
    const int nblk = N / 32, kb = item / nblk, nb = item % nblk, k0 = 64 * kb, n0 = 32 * nb;
#pragma unroll 8
    for (int i = 0; i < 32; ++i) { const int kk = 2 * i + (lane >> 5); scr[kk * 33 + (lane & 31)] = W[(size_t)(k0 + kk) * N + n0 + (lane & 31)]; }
    __builtin_amdgcn_wave_barrier(); asm volatile("s_waitcnt lgkmcnt(0)" ::: "memory");
    const int c = lane & 7;
#pragma unroll
    for (int j = 0; j < 4; ++j) { const int n = (lane >> 3) + 8 * j; const float* s = scr + (8 * c) * 33 + n;
        u32x4 o; o.x = pk_h2(s[0 * 33], s[1 * 33]); o.y = pk_h2(s[2 * 33], s[3 * 33]); o.z = pk_h2(s[4 * 33], s[5 * 33]); o.w = pk_h2(s[6 * 33], s[7 * 33]);
        *(u32x4*)(WT + (size_t)(n0 + n) * K + k0 + 8 * c) = o; }
    asm volatile("s_waitcnt lgkmcnt(0)" ::: "memory"); __builtin_amdgcn_wave_barrier();
}
constexpr int IT_W0IN = (D / 64) * (RET_IN / 32), IT_W0OUT = (RET_V / 64) * (D / 32), IT_W1IN = (D / 64) * (MOBA_IN / 32), IT_W1OUT = (MOBA_W / 64) * (D / 32);
constexpr int IT_WALL = IT_W0IN + IT_W0OUT + IT_W1IN + IT_W1OUT;
__global__ void __launch_bounds__(256) k_convert_w(const float* w0in, const float* w0out, const float* w1in, const float* w1out, h16* o0in, h16* o0out, h16* o1in, h16* o1out) {
    __shared__ float scr_all[4 * 64 * 33];
    const int wave = threadIdx.x >> 6, lane = threadIdx.x & 63; float* scr = scr_all + wave * 64 * 33;
    const int gw = blockIdx.x * 4 + wave, NGW = gridDim.x * 4;
    for (int it = gw; it < IT_WALL; it += NGW) { int r = it;
        if (r < IT_W0IN) { transpose_item(w0in, D, RET_IN, o0in, scr, r, lane); continue; } r -= IT_W0IN;
        if (r < IT_W0OUT) { transpose_item(w0out, RET_V, D, o0out, scr, r, lane); continue; } r -= IT_W0OUT;
        if (r < IT_W1IN) { transpose_item(w1in, D, MOBA_IN, o1in, scr, r, lane); continue; } r -= IT_W1IN;
        transpose_item(w1out, MOBA_W, D, o1out, scr, r, lane); }
}
__global__ void k_rope_tables(const int* pos, float2* rcs0, float2* rcs1) {
    const int i = blockIdx.x * blockDim.x + threadIdx.x; if (i >= M * 144) return;
    const int m = i / 144, r = i % 144;
    const float p = (float)pos[m];
    if (r < 128) { const float inv = powf(10000.0f, -(float)r * 2.0f / 256.0f); const float a = p * inv; rcs0[(size_t)m * 128 + r] = make_float2(cosf(a), sinf(a)); }
    else { const int q = r - 128; const float inv = powf(500000.0f, -(float)q * 2.0f / 32.0f); const float a = p * inv; rcs1[(size_t)m * 16 + q] = make_float2(cosf(a), sinf(a)); }
}
__global__ void k_make_h(const float* x, const float* mod_l, h16* H) {
    const size_t i = ((size_t)blockIdx.x * blockDim.x + threadIdx.x) * 4; if (i >= (size_t)M * D) return;
    const int m = (int)(i / D), j = (int)(i % D), b = m / SEQ;
    const f32x4 xv = *(const f32x4*)(x + i), sh = *(const f32x4*)(mod_l + (size_t)b * MODW + j), sc = *(const f32x4*)(mod_l + (size_t)b * MODW + D + j);
    const f32x4 h = xv * (sc + 1.0f) + sh;
    u32x2 w; w.x = pk_h2(h[0], h[1]); w.y = pk_h2(h[2], h[3]); *(u32x2*)(H + i) = w;
}
__global__ void __launch_bounds__(256) k_norm_gate(const h16* O, const h16* Gt, h16* A) {
    const int gw = blockIdx.x * 4 + (threadIdx.x >> 6), lane = threadIdx.x & 63, NGW = gridDim.x * 4;
    for (int it = gw; it < M * RET_HEADS; it += NGW) {
        const size_t off = (size_t)it * RET_DV + lane * 8;
        const h16x8 ov = *(const h16x8*)(O + off), gv = *(const h16x8*)(Gt + off);
        float o[8]; float s = 0.f;
#pragma unroll
        for (int j = 0; j < 8; ++j) { o[j] = (float)ov[j]; s += o[j]; }
        const float mu = wave_sum(s) * (1.0f / RET_DV); float q = 0.f;
#pragma unroll
        for (int j = 0; j < 8; ++j) { o[j] -= mu; q += o[j] * o[j]; }
        const float rstd = 1.0f / sqrtf(wave_sum(q) * (1.0f / RET_DV) + GN_EPS);
        float r[8];
#pragma unroll
        for (int j = 0; j < 8; ++j) r[j] = o[j] * rstd * silu((float)gv[j]);
        u32x4 w; w.x = pk_h2(r[0], r[1]); w.y = pk_h2(r[2], r[3]); w.z = pk_h2(r[4], r[5]); w.w = pk_h2(r[6], r[7]);
        *(u32x4*)(A + off) = w;
    }
}
__global__ void __launch_bounds__(256) k_layernorm(float* Z, const float* g, const float* bta, const float* mod_next, h16* H) {
    const int gw = blockIdx.x * 4 + (threadIdx.x >> 6), lane = threadIdx.x & 63, NGW = gridDim.x * 4;
    for (int m = gw; m < M; m += NGW) {
        float* zr = Z + (size_t)m * D; f32x4 v[8]; float s = 0.f;
#pragma unroll
        for (int j = 0; j < 8; ++j) { v[j] = *(const f32x4*)(zr + j * 256 + lane * 4); s += (v[j][0] + v[j][1]) + (v[j][2] + v[j][3]); }
        const float mu = wave_sum(s) * (1.0f / D); float q = 0.f;
#pragma unroll
        for (int j = 0; j < 8; ++j) { v[j] = v[j] - mu; q += (v[j][0] * v[j][0] + v[j][1] * v[j][1]) + (v[j][2] * v[j][2] + v[j][3] * v[j][3]); }
        const float rstd = 1.0f / sqrtf(wave_sum(q) * (1.0f / D) + LN_EPS);
        const int b = m / SEQ;
#pragma unroll
        for (int j = 0; j < 8; ++j) { const int c = j * 256 + lane * 4;
            const f32x4 xo = v[j] * rstd * *(const f32x4*)(g + c) + *(const f32x4*)(bta + c);
            *(f32x4*)(zr + c) = xo;
            if (H) { const f32x4 sh = *(const f32x4*)(mod_next + (size_t)b * MODW + c), sc = *(const f32x4*)(mod_next + (size_t)b * MODW + D + c);
                const f32x4 h = xo * (sc + 1.0f) + sh; u32x2 w; w.x = pk_h2(h[0], h[1]); w.y = pk_h2(h[2], h[3]); *(u32x2*)(H + (size_t)m * D + c) = w; } }
    }
}

__global__ void __launch_bounds__(256) k_retention_naive(const h16* Q, const h16* K, h16* VO) {
    constexpr int TT = 16;
    __shared__ float qs[TT][256], ks[TT][256], red[4][TT][64];
    const int blk = blockIdx.x, vg = blk & 7, h = (blk >> 3) & 7, b = blk >> 6;
    const int tid = threadIdx.x, vi = tid & 63, dq = tid >> 6;
    const float gamma = 1.0f - exp2f(-5.0f - (float)h);
    float S[64];
#pragma unroll
    for (int d = 0; d < 64; ++d) S[d] = 0.f;
    for (int t0 = 0; t0 < SEQ; t0 += TT) {
        __syncthreads();
        for (int i = tid; i < TT * 256; i += 256) { const int tt = i >> 8, d = i & 255; const size_t row = (size_t)(b * SEQ + t0 + tt);
            qs[tt][d] = (float)Q[row * RET_QK + h * 256 + d]; ks[tt][d] = (float)K[row * RET_QK + h * 256 + d]; }
        __syncthreads();
        float po[TT];
#pragma unroll
        for (int tt = 0; tt < TT; ++tt) {
            const float v = (float)VO[(size_t)(b * SEQ + t0 + tt) * RET_V + h * 512 + vg * 64 + vi];
            float a = 0.f;
#pragma unroll
            for (int d = 0; d < 64; ++d) { S[d] = gamma * S[d] + ks[tt][dq * 64 + d] * v; a += qs[tt][dq * 64 + d] * S[d]; }
            po[tt] = a;
        }
#pragma unroll
        for (int tt = 0; tt < TT; ++tt) red[dq][tt][vi] = po[tt];
        __syncthreads();
        for (int i = tid; i < TT * 64; i += 256) { const int tt = i >> 6, v = i & 63;
            const float o = (red[0][tt][v] + red[1][tt][v]) + (red[2][tt][v] + red[3][tt][v]);
            VO[(size_t)(b * SEQ + t0 + tt) * RET_V + h * 512 + vg * 64 + v] = (h16)o; }
    }
}

__global__ void k_kmean(const h16* K, float* kmean) {
    const int i = blockIdx.x * blockDim.x + threadIdx.x; if (i >= BATCH * NBLK * MOBA_W) return;
    const int col = i % MOBA_W, bb = i / MOBA_W;
    float s = 0.f; for (int t = 0; t < MOBA_BLOCK; ++t) s += (float)K[((size_t)bb * MOBA_BLOCK + t) * MOBA_W + col];
    kmean[i] = s * (1.0f / MOBA_BLOCK);
}
__global__ void __launch_bounds__(256) k_moba_naive(const h16* Q, const h16* K, const h16* V, const h16* Gt, const float* kmean, h16* A) {
    const int blk = blockIdx.x, qt = blk & 31, h = (blk >> 5) & 15, b = blk >> 9;
    const int tid = threadIdx.x, qi = tid >> 2, part = tid & 3;
    const int t = qt * 64 + qi, own = t >> 8; const size_t row = (size_t)b * SEQ + t;
    float q[32];
#pragma unroll
    for (int j = 0; j < 32; ++j) q[j] = (float)Q[row * MOBA_W + h * 128 + part * 32 + j];
    float gs[NBLK]; unsigned sel = 0u;
#pragma unroll
    for (int n = 0; n < NBLK; ++n) { float a = 0.f;
#pragma unroll
        for (int j = 0; j < 32; ++j) a += q[j] * kmean[((size_t)(b * NBLK + n)) * MOBA_W + h * 128 + part * 32 + j];
        a += __shfl_xor(a, 1); a += __shfl_xor(a, 2); gs[n] = a; }
#pragma unroll
    for (int r = 0; r < 3; ++r) { int best = -1; float bv = -3e38f;
#pragma unroll
        for (int n = 0; n < NBLK; ++n) if (n < own && !((sel >> n) & 1u) && gs[n] > bv) { bv = gs[n]; best = n; }
        if (best >= 0) sel |= 1u << best; }
    const float scale = 0.08838834764831845f;
    float mrun = -1e30f, lrun = 0.f, acc[32];
#pragma unroll
    for (int j = 0; j < 32; ++j) acc[j] = 0.f;
    for (int n = 0; n <= own; ++n) {
        const bool use = (n == own) || ((sel >> n) & 1u);
        if (!use) continue;
        const int kend = (n == own) ? (t & 255) + 1 : MOBA_BLOCK;
        for (int kk = 0; kk < kend; ++kk) {
            const size_t krow = (size_t)b * SEQ + n * MOBA_BLOCK + kk;
            const h16* kp = K + krow * MOBA_W + h * 128 + part * 32; float s = 0.f;
#pragma unroll
            for (int j = 0; j < 32; ++j) s += q[j] * (float)kp[j];
            s += __shfl_xor(s, 1); s += __shfl_xor(s, 2); s *= scale;
            const float mn = fmaxf(mrun, s), al = __expf(mrun - mn), p = __expf(s - mn);
            lrun = lrun * al + p; mrun = mn;
            const h16* vp = V + krow * MOBA_W + h * 128 + part * 32;
#pragma unroll
            for (int j = 0; j < 32; ++j) acc[j] = acc[j] * al + p * (float)vp[j];
        }
    }
    const float inv = 1.0f / lrun;
#pragma unroll
    for (int j = 0; j < 32; ++j) { const size_t o = row * MOBA_W + h * 128 + part * 32 + j; A[o] = (h16)(acc[j] * inv * silu((float)Gt[o])); }
}

extern "C" void kernel_launch(void* const* d_in, const int* in_sizes, int n_in, void* d_out, int out_size, void* d_ws, size_t ws_size, hipStream_t stream) {
    static int inited = 0;
    if (!inited) {
        if (n_in != 11 || out_size != M * D || ws_size < WS_END) { fprintf(stderr, "kernel_launch: unexpected shapes (n_in %d out %d ws %zu)\n", n_in, out_size, ws_size); inited = -1; return; }
        (void)hipFuncSetAttribute((const void*)k_gemm<EpiRet>, hipFuncAttributeMaxDynamicSharedMemorySize, GEMM_LDS);
        (void)hipFuncSetAttribute((const void*)k_gemm<EpiMoba>, hipFuncAttributeMaxDynamicSharedMemorySize, GEMM_LDS);
        (void)hipFuncSetAttribute((const void*)k_gemm<EpiRes>, hipFuncAttributeMaxDynamicSharedMemorySize, GEMM_LDS);
        inited = 1;
    }
    if (inited < 0) return;
    const float* x = (const float*)d_in[0]; const float* c = (const float*)d_in[1]; const int* pos = (const int*)d_in[2];
    const float* ret_w_in = (const float*)d_in[3]; const float* ret_w_out = (const float*)d_in[4];
    const float* moba_w_in = (const float*)d_in[5]; const float* moba_w_out = (const float*)d_in[6];
    const float* w_ada = (const float*)d_in[7]; const float* b_ada = (const float*)d_in[8]; const float* ln_g = (const float*)d_in[9]; const float* ln_b = (const float*)d_in[10];
    unsigned char* ws = (unsigned char*)d_ws; float* out = (float*)d_out;
    float* MOD = (float*)(ws + WS_MOD); float* PART = (float*)(ws + WS_PART); float* KMEAN = (float*)(ws + WS_KMEAN);
    float2* RCS0 = (float2*)(ws + WS_RCS0); float2* RCS1 = (float2*)(ws + WS_RCS1);
    h16 *W0IN = (h16*)(ws + WS_W0IN), *W0OUT = (h16*)(ws + WS_W0OUT), *W1IN = (h16*)(ws + WS_W1IN), *W1OUT = (h16*)(ws + WS_W1OUT);
    h16 *Q0 = (h16*)(ws + WS_Q0), *K0 = (h16*)(ws + WS_K0), *V0 = (h16*)(ws + WS_V0), *G0 = (h16*)(ws + WS_G0);
    h16 *H1 = (h16*)(ws + WS_H1), *Q1 = (h16*)(ws + WS_Q1), *K1 = (h16*)(ws + WS_K1), *V1 = (h16*)(ws + WS_V1), *G1 = (h16*)(ws + WS_G1), *A1 = (h16*)(ws + WS_A1);
    h16* H0 = (h16*)d_out;
    const int G = 256;
    k_mod_partial<<<256, 256, 0, stream>>>(c, w_ada, PART);
    k_mod_reduce<<<(2 * 8 * MODW + 255) / 256, 256, 0, stream>>>(PART, b_ada, MOD);
    k_convert_w<<<1024, 256, 0, stream>>>(ret_w_in, ret_w_out, moba_w_in, moba_w_out, W0IN, W0OUT, W1IN, W1OUT);
    k_rope_tables<<<(M * 144 + 255) / 256, 256, 0, stream>>>(pos, RCS0, RCS1);
    k_make_h<<<M * D / 4 / 256, 256, 0, stream>>>(x, MOD, H0);
    { pg8::Gemm g{H0, W0IN, M, RET_IN, D, 0}; EpiRet E{Q0, K0, V0, G0, RCS0}; k_gemm<EpiRet><<<G, 512, GEMM_LDS, stream>>>(g, E); }
    k_retention_naive<<<BATCH * RET_HEADS * 8, 256, 0, stream>>>(Q0, K0, V0);
    k_norm_gate<<<2048, 256, 0, stream>>>(V0, G0, G0);
    { pg8::Gemm g{G0, W0OUT, M, D, RET_V, 0}; EpiRes E{x, out, MOD + 2 * D}; k_gemm<EpiRes><<<G, 512, GEMM_LDS, stream>>>(g, E); }
    k_layernorm<<<2048, 256, 0, stream>>>(out, ln_g, ln_b, MOD + 8 * MODW, H1);
    { pg8::Gemm g{H1, W1IN, M, MOBA_IN, D, 0}; EpiMoba E{Q1, K1, V1, G1, RCS1}; k_gemm<EpiMoba><<<G, 512, GEMM_LDS, stream>>>(g, E); }
    k_kmean<<<BATCH * NBLK * MOBA_W / 256, 256, 0, stream>>>(K1, KMEAN);
    k_moba_naive<<<BATCH * MOBA_HEADS * 32, 256, 0, stream>>>(Q1, K1, V1, G1, KMEAN, A1);
    { pg8::Gemm g{A1, W1OUT, M, D, MOBA_W, 0}; EpiRes E{out, out, MOD + 8 * MODW + 2 * D}; k_gemm<EpiRes><<<G, 512, GEMM_LDS, stream>>>(g, E); }
    k_layernorm<<<2048, 256, 0, stream>>>(out, ln_g + D, ln_b + D, nullptr, nullptr);
}
```

```cpp
#include <hip/hip_runtime.h>
#include <cstdio>
#include <cstdint>
#include <cmath>

typedef _Float16 h16;
typedef _Float16 h16x8 __attribute__((ext_vector_type(8)));
typedef _Float16 h16x4 __attribute__((ext_vector_type(4)));
typedef _Float16 h16x2 __attribute__((ext_vector_type(2)));
typedef float f32x4 __attribute__((ext_vector_type(4)));
typedef float f32x2 __attribute__((ext_vector_type(2)));
typedef unsigned u32x4 __attribute__((ext_vector_type(4)));
typedef unsigned u32x2 __attribute__((ext_vector_type(2)));
#define LAS __attribute__((address_space(3)))

constexpr int D = 2048, BATCH = 8, SEQ = 2048, M = BATCH * SEQ;
constexpr int RET_HEADS = 8, RET_DK = 256, RET_DV = 512, RET_QK = 2048, RET_V = 4096, RET_IN = 12288;
constexpr int MOBA_HEADS = 16, MOBA_DH = 128, MOBA_W = 2048, MOBA_IN = 8192, MOBA_BLOCK = 256, NBLK = 8;
constexpr float ALPHA = 1.4142135623730951f;
constexpr float LN_EPS = 1e-5f, GN_EPS = 1e-5f;
constexpr int MODW = 3 * D;
constexpr int KSPLIT = 4;

constexpr size_t MiB = 1u << 20;
constexpr size_t WS_CTL = 0;
constexpr size_t WS_MOD = 1 * MiB;
constexpr size_t WS_KMEAN = WS_MOD + 512 * 1024;
constexpr size_t WS_RCS1 = 2 * MiB;
constexpr size_t WS_W0IN = 4 * MiB;
constexpr size_t WS_W0OUT = 52 * MiB;
constexpr size_t WS_W1IN = 68 * MiB;
constexpr size_t WS_W1OUT = 100 * MiB;
constexpr size_t WS_ACT = 108 * MiB;
constexpr size_t WS_Q0 = WS_ACT, WS_K0 = WS_ACT + 64 * MiB, WS_V0 = WS_ACT + 128 * MiB, WS_G0 = WS_ACT + 256 * MiB;
constexpr size_t WS_H1 = WS_ACT, WS_Q1 = WS_ACT + 64 * MiB, WS_K1 = WS_ACT + 128 * MiB, WS_V1 = WS_ACT + 192 * MiB, WS_G1 = WS_ACT + 256 * MiB, WS_A1 = WS_ACT + 320 * MiB;
constexpr size_t WS_RCS0 = 492 * MiB;
constexpr size_t WS_PART = 508 * MiB;
constexpr size_t WS_END = 512 * MiB;

__device__ __forceinline__ int opaque_tid() { int t = threadIdx.x; asm volatile("" : "+v"(t)); return t; }
__device__ __forceinline__ unsigned pk_h2(float lo, float hi) { h16x2 h = {(h16)lo, (h16)hi}; return __builtin_bit_cast(unsigned, h); }
__device__ __forceinline__ float wave_sum(float v) {
#pragma unroll
    for (int o = 1; o < 64; o <<= 1) v += __shfl_xor(v, o);
    return v;
}
__device__ __forceinline__ float silu(float g) { return g / (1.0f + __expf(-g)); }

namespace pg8 {
constexpr int BM = 256, BK = 64, HALF = 128, HTB = HALF * BK * 2, STAGE_BYTES = 8 * HTB, NXCD = 8, WGM = 8;
__host__ __device__ __forceinline__ int lds_byte(int r, int c) { const int st = (r >> 4) * 2 + (c >> 5), rr = r & 15, cc = c & 31, ob = rr * 64 + cc * 2; return st * 1024 + (ob ^ (((ob >> 9) & 1) << 5)); }
__host__ __device__ __forceinline__ void stage_rc(int b, int& R, int& C) { const int st = b / 1024, sb = b % 1024, swz = sb ^ (((sb >> 9) & 1) << 5); R = (st >> 1) * 16 + swz / 64; C = (st & 1) * 32 + (swz % 64) / 2; }
__host__ __device__ __forceinline__ int perm32(int rho) { const int n = rho >> 4, i = rho & 15; return 8 * (i >> 2) + 4 * n + (i & 3); }
struct Unit { int pm, pn; };
struct Gemm { const h16* A; const h16* Bt; int M, N, K, pad; };
struct StaticOrder {
    int nM, nN, nwg, G, c;
    __host__ __device__ void init(int M_, int N_, int G_, int c_) { nM = M_ / BM; nN = N_ / BM; nwg = nM * nN; G = G_; c = c_; }
    __host__ __device__ bool next(int i, Unit& u) const {
        const long L = (long)i * G + c; if (L >= nwg) return false;
        int wgid = (int)L; { const int q = nwg / NXCD, r = nwg % NXCD, xcd = wgid % NXCD, off = wgid / NXCD; wgid = (xcd < r ? xcd * (q + 1) : r * (q + 1) + (xcd - r) * q) + off; }
        const int nig = WGM * nN, gid = wgid / nig, fm = gid * WGM, gsz = (nM - fm) < WGM ? (nM - fm) : WGM;
        u.pm = fm + ((wgid % nig) % gsz); u.pn = (wgid % nig) / gsz; return true;
    }
    __device__ __forceinline__ void a_ready(const Unit&) const {}
    __device__ __forceinline__ void done(const Unit&) const {}
};

template <class Epi, class Sched, bool ALIGN_EPI = false, bool SP2 = false>
__device__ __forceinline__ void gemm_phase(LAS unsigned char* lds, const Gemm g, const Sched& S, const Epi& E) {
    const int tid = opaque_tid(), wid = __builtin_amdgcn_readfirstlane(tid >> 6), lane = tid & 63, wr = wid >> 2, wc = wid & 3, fr = lane & 15, fq = lane >> 4;
    const int K = g.K, nt = K / BK;
    unsigned voffA, voffB;
    { int R, C; stage_rc(tid * 16, R, C); const int Rb = Epi::PERM ? ((R & ~31) + perm32(R & 31)) : R;
        voffA = (unsigned)(R * K + C) * 2u; voffB = (unsigned)(Rb * K + C) * 2u; }
    const size_t pstep = (size_t)64 * K * 2;
    const size_t kstep = (size_t)(BK * 2);
    const size_t hstep = (size_t)HALF * K * 2;
    const size_t tstep = 2 * hstep;
    const unsigned ldsw = (unsigned)wid * 1024u;
    const int aoff = lds_byte(wr * 64 + fr, fq * 8), boff = lds_byte(wc * 32 + fr, fq * 8);
#define PG8_SA(b, h) (((b) * 2 + (h)) * HTB)
#define PG8_SB(b, h) ((4 + (b) * 2 + (h)) * HTB)
#define PG8_STAGE(bufoff, gbase, voff) do { _Pragma("unroll") for (int _i = 0; _i < 2; ++_i) \
        __builtin_amdgcn_global_load_lds((const unsigned*)((const char*)(gbase) + _i * pstep + (voff)), (LAS unsigned*)(lds + (bufoff) + ldsw + _i * 8192), 16, 0, 0); } while (0)
#define PG8_LDA(dst, b, h) do { _Pragma("unroll") for (int m = 0; m < 4; ++m) _Pragma("unroll") for (int k = 0; k < 2; ++k) dst[m][k] = *(const LAS h16x8*)(lds + PG8_SA(b, h) + aoff + m * 2048 + k * 1024); } while (0)
#define PG8_LDB(dst, b, h) do { _Pragma("unroll") for (int n = 0; n < 2; ++n) _Pragma("unroll") for (int k = 0; k < 2; ++k) dst[n][k] = *(const LAS h16x8*)(lds + PG8_SB(b, h) + boff + n * 2048 + k * 1024); } while (0)
#define PG8_MMA(ai, bj, At, Bt) do { __builtin_amdgcn_s_setprio(1); _Pragma("unroll") for (int m = 0; m < 4; ++m) _Pragma("unroll") for (int n = 0; n < 2; ++n) _Pragma("unroll") for (int k = 0; k < 2; ++k) \
        acc[ai][bj][m][n] = __builtin_amdgcn_mfma_f32_16x16x32_f16(Bt[n][k], At[m][k], acc[ai][bj][m][n], 0, 0, 0); __builtin_amdgcn_s_setprio(0); } while (0)
#define PG8_WAIT_V(n) asm volatile("s_waitcnt vmcnt(" #n ")" ::: "memory")
#define PG8_WAIT_L(n) asm volatile("s_waitcnt lgkmcnt(" #n ")" ::: "memory")
#define PG8_BAR __builtin_amdgcn_s_barrier()
#define PG8_SCHED __builtin_amdgcn_sched_barrier(0)
    Unit cur, nxt; int ui = 0;
    if (!S.next(0, cur)) return;
    f32x4 acc[2][2][4][2];
#pragma unroll
    for (int a = 0; a < 2; ++a)
#pragma unroll
        for (int b = 0; b < 2; ++b)
#pragma unroll
            for (int m = 0; m < 4; ++m)
#pragma unroll
                for (int n = 0; n < 2; ++n) acc[a][b][m][n] = (f32x4){0.f, 0.f, 0.f, 0.f};
    h16x8 At[4][2], B0[2][2], B1[2][2];
    const char* cA = (const char*)g.A + (size_t)cur.pm * tstep; const char* cB = (const char*)g.Bt + (size_t)cur.pn * tstep;
    S.a_ready(cur);
    if constexpr (SP2) {
        PG8_STAGE(PG8_SB(0, 0), cB, voffB); PG8_STAGE(PG8_SB(0, 1), cB + hstep, voffB); PG8_STAGE(PG8_SA(0, 0), cA, voffA); PG8_STAGE(PG8_SA(0, 1), cA + hstep, voffA);
        if (wr == 1) PG8_BAR;
        PG8_WAIT_V(2); PG8_BAR;
        PG8_STAGE(PG8_SB(1, 0), cB + kstep, voffB); PG8_STAGE(PG8_SA(1, 0), cA + kstep, voffA); PG8_STAGE(PG8_SB(1, 1), cB + hstep + kstep, voffB);
        PG8_WAIT_V(6); PG8_BAR;
    } else {
        PG8_STAGE(PG8_SB(0, 0), cB, voffB); PG8_STAGE(PG8_SA(0, 0), cA, voffA); PG8_STAGE(PG8_SB(0, 1), cB + hstep, voffB); PG8_STAGE(PG8_SA(0, 1), cA + hstep, voffA);
        if (wr == 1) PG8_BAR;
        PG8_WAIT_V(4); PG8_BAR;
        PG8_STAGE(PG8_SB(1, 0), cB + kstep, voffB); PG8_STAGE(PG8_SA(1, 0), cA + kstep, voffA); PG8_STAGE(PG8_SB(1, 1), cB + hstep + kstep, voffB);
        PG8_WAIT_V(6); PG8_BAR;
    }
    for (;;) {
        const bool has_next = S.next(ui + 1, nxt);
        const char* nA = has_next ? (const char*)g.A + (size_t)nxt.pm * tstep : cA; const char* nB = has_next ? (const char*)g.Bt + (size_t)nxt.pn * tstep : cB;
        for (int t = 0; t < nt; t += 2) {
            const bool last = (t == nt - 2);
            const char* a1 = cA + (size_t)(t + 1) * kstep;
            const char* a2 = last ? nA : cA + (size_t)(t + 2) * kstep; const char* b2 = last ? nB : cB + (size_t)(t + 2) * kstep;
            const char* a3 = a2 + kstep; const char* b3 = b2 + kstep;
            if (last && has_next) S.a_ready(nxt);
            if constexpr (SP2) {
            PG8_LDB(B0, 0, 0); PG8_LDB(B1, 0, 1); PG8_SCHED; PG8_LDA(At, 0, 0); PG8_STAGE(PG8_SA(1, 1), a1 + hstep, voffA);
            PG8_WAIT_V(8); PG8_WAIT_L(0); PG8_BAR; PG8_MMA(0, 0, At, B0); PG8_MMA(0, 1, At, B1); PG8_BAR; PG8_SCHED;
            PG8_LDA(At, 0, 1); PG8_STAGE(PG8_SB(0, 0), b2, voffB); PG8_STAGE(PG8_SB(0, 1), b2 + hstep, voffB); PG8_STAGE(PG8_SA(0, 0), a2, voffA);
            PG8_WAIT_V(8); PG8_WAIT_L(0); PG8_BAR; PG8_MMA(1, 0, At, B0); PG8_MMA(1, 1, At, B1); PG8_BAR; PG8_SCHED;
            PG8_LDB(B0, 1, 0); PG8_LDB(B1, 1, 1); PG8_SCHED; PG8_LDA(At, 1, 0); PG8_STAGE(PG8_SA(0, 1), a2 + hstep, voffA);
            PG8_WAIT_V(8); PG8_WAIT_L(0); PG8_BAR; PG8_MMA(0, 0, At, B0); PG8_MMA(0, 1, At, B1); PG8_BAR; PG8_SCHED;
            PG8_LDA(At, 1, 1); PG8_STAGE(PG8_SB(1, 0), b3, voffB); PG8_STAGE(PG8_SB(1, 1), b3 + hstep, voffB); PG8_STAGE(PG8_SA(1, 0), a3, voffA);
            PG8_WAIT_V(8); PG8_WAIT_L(0); PG8_BAR; PG8_MMA(1, 0, At, B0); PG8_MMA(1, 1, At, B1); PG8_BAR; PG8_SCHED;
            } else {
            PG8_LDB(B0, 0, 0); PG8_SCHED; PG8_LDA(At, 0, 0); PG8_STAGE(PG8_SA(1, 1), a1 + hstep, voffA);
            PG8_WAIT_L(8); PG8_BAR; PG8_WAIT_L(0); PG8_MMA(0, 0, At, B0); PG8_BAR; PG8_SCHED;
            PG8_LDB(B1, 0, 1); PG8_STAGE(PG8_SB(0, 0), b2, voffB);
            PG8_BAR; PG8_WAIT_L(0); PG8_MMA(0, 1, At, B1); PG8_BAR;
            PG8_LDA(At, 0, 1); PG8_STAGE(PG8_SA(0, 0), a2, voffA);
            PG8_BAR; PG8_WAIT_L(0); PG8_MMA(1, 0, At, B0); PG8_BAR; PG8_SCHED;
            PG8_STAGE(PG8_SB(0, 1), b2 + hstep, voffB);
            PG8_WAIT_V(6); PG8_BAR; PG8_MMA(1, 1, At, B1); PG8_BAR;
            PG8_LDB(B0, 1, 0); PG8_SCHED; PG8_LDA(At, 1, 0); PG8_STAGE(PG8_SA(0, 1), a2 + hstep, voffA);
            PG8_WAIT_L(8); PG8_BAR; PG8_WAIT_L(0); PG8_MMA(0, 0, At, B0); PG8_BAR; PG8_SCHED;
            PG8_LDB(B1, 1, 1); PG8_STAGE(PG8_SB(1, 0), b3, voffB);
            PG8_BAR; PG8_WAIT_L(0); PG8_MMA(0, 1, At, B1); PG8_BAR;
            PG8_LDA(At, 1, 1); PG8_STAGE(PG8_SA(1, 0), a3, voffA);
            PG8_BAR; PG8_WAIT_L(0); PG8_MMA(1, 0, At, B0); PG8_BAR; PG8_SCHED;
            PG8_STAGE(PG8_SB(1, 1), b3 + hstep, voffB);
            PG8_WAIT_V(6); PG8_BAR; PG8_MMA(1, 1, At, B1); PG8_BAR;
            }
        }
        if constexpr (ALIGN_EPI) { if (wr == 0) PG8_BAR; }
        if constexpr (!Epi::AFTER_DRAIN) { E(acc, cur, wr, wc, fr, fq); S.done(cur); }
        if (!has_next) break;
#pragma unroll
        for (int a = 0; a < 2; ++a)
#pragma unroll
            for (int b = 0; b < 2; ++b)
#pragma unroll
                for (int m = 0; m < 4; ++m)
#pragma unroll
                    for (int n = 0; n < 2; ++n) acc[a][b][m][n] = (f32x4){0.f, 0.f, 0.f, 0.f};
        cur = nxt; cA = nA; cB = nB; ++ui;
        if constexpr (ALIGN_EPI) { if (wr == 1) PG8_BAR; }
    }
    PG8_WAIT_V(0);
    if constexpr (!ALIGN_EPI) { if (wr == 0) PG8_BAR; }
    PG8_BAR;
#undef PG8_SA
#undef PG8_SB
#undef PG8_STAGE
#undef PG8_LDA
#undef PG8_LDB
#undef PG8_MMA
#undef PG8_WAIT_V
#undef PG8_WAIT_L
#undef PG8_BAR
#undef PG8_SCHED
}
}

struct EpiRet {
    static constexpr bool PERM = true, AFTER_DRAIN = false;
    h16 *Q, *K, *V, *G; const float2* rcs;
    __device__ __forceinline__ void operator()(const f32x4 (&acc)[2][2][4][2], const pg8::Unit& u, int wr, int wc, int fr, int fq) const {
        const int row0 = u.pm * 256 + wr * 64 + fr;
        if (u.pn < 16) {
            h16* base = (u.pn < 8) ? Q + u.pn * 256 : K + (u.pn - 8) * 256; const float sc = (u.pn < 8) ? 1.0f : 0.0625f;
            const int d0 = wc * 32 + 8 * fq;
#pragma unroll
            for (int ai = 0; ai < 2; ++ai)
#pragma unroll
                for (int m = 0; m < 4; ++m) {
                    const int row = row0 + ai * 128 + m * 16;
                    const f32x4* cs = (const f32x4*)(rcs + (size_t)row * 128 + d0);
                    float o1[8], o2[8];
#pragma unroll
                    for (int n = 0; n < 2; ++n) { const f32x4 c01 = cs[2 * n], c23 = cs[2 * n + 1]; const f32x4 x1 = acc[ai][0][m][n], x2 = acc[ai][1][m][n];
                        const float cc[4] = {c01[0], c01[2], c23[0], c23[2]}, ss[4] = {c01[1], c01[3], c23[1], c23[3]};
#pragma unroll
                        for (int j = 0; j < 4; ++j) { o1[4 * n + j] = (x1[j] * cc[j] - x2[j] * ss[j]) * sc; o2[4 * n + j] = (x2[j] * cc[j] + x1[j] * ss[j]) * sc; } }
                    u32x4 w1, w2; w1.x = pk_h2(o1[0], o1[1]); w1.y = pk_h2(o1[2], o1[3]); w1.z = pk_h2(o1[4], o1[5]); w1.w = pk_h2(o1[6], o1[7]);
                    w2.x = pk_h2(o2[0], o2[1]); w2.y = pk_h2(o2[2], o2[3]); w2.z = pk_h2(o2[4], o2[5]); w2.w = pk_h2(o2[6], o2[7]);
                    h16* rp = base + (size_t)row * RET_QK + d0;
                    *(u32x4*)rp = w1; *(u32x4*)(rp + 128) = w2;
                }
        } else {
            h16* base = (u.pn < 32) ? V + (u.pn - 16) * 256 : G + (u.pn - 32) * 256;
            const int c0 = wc * 32 + 8 * fq;
#pragma unroll
            for (int ai = 0; ai < 2; ++ai)
#pragma unroll
                for (int m = 0; m < 4; ++m) {
                    h16* rp = base + (size_t)(row0 + ai * 128 + m * 16) * RET_V + c0;
#pragma unroll
                    for (int bj = 0; bj < 2; ++bj) { const f32x4 v0 = acc[ai][bj][m][0], v1 = acc[ai][bj][m][1];
                        u32x4 w; w.x = pk_h2(v0[0], v0[1]); w.y = pk_h2(v0[2], v0[3]); w.z = pk_h2(v1[0], v1[1]); w.w = pk_h2(v1[2], v1[3]);
                        *(u32x4*)(rp + bj * 128) = w; }
                }
        }
    }
};
struct EpiMoba {
    static constexpr bool PERM = true, AFTER_DRAIN = false;
    h16 *Q, *K, *V, *G; const float2* rcs;
    __device__ __forceinline__ void operator()(const f32x4 (&acc)[2][2][4][2], const pg8::Unit& u, int wr, int wc, int fr, int fq) const {
        const int row0 = u.pm * 256 + wr * 64 + fr; const int sel = u.pn >> 3;
        h16* base = (sel == 0 ? Q : sel == 1 ? K : sel == 2 ? V : G) + (u.pn & 7) * 256 + wc * 32 + 8 * fq;
        const bool rope = (sel < 2) && (wc == 0);
#pragma unroll
        for (int ai = 0; ai < 2; ++ai)
#pragma unroll
            for (int m = 0; m < 4; ++m) {
                const int row = row0 + ai * 128 + m * 16;
                float cc[8], ss[8];
                if (rope) { const f32x4* cs = (const f32x4*)(rcs + (size_t)row * 16 + ((8 * fq) & 15));
#pragma unroll
                    for (int q = 0; q < 4; ++q) { const f32x4 t = cs[q]; cc[2 * q] = t[0]; ss[2 * q] = t[1]; cc[2 * q + 1] = t[2]; ss[2 * q + 1] = t[3]; } }
#pragma unroll
                for (int bj = 0; bj < 2; ++bj) {
                    float o[8];
#pragma unroll
                    for (int n = 0; n < 2; ++n)
#pragma unroll
                        for (int j = 0; j < 4; ++j) { const float x = acc[ai][bj][m][n][j]; float r = x;
                            if (rope) { const float y = __shfl_xor(x, 32); r = (fq < 2) ? (x * cc[4 * n + j] - y * ss[4 * n + j]) : (x * cc[4 * n + j] + y * ss[4 * n + j]); }
                            o[4 * n + j] = r; }
                    u32x4 w; w.x = pk_h2(o[0], o[1]); w.y = pk_h2(o[2], o[3]); w.z = pk_h2(o[4], o[5]); w.w = pk_h2(o[6], o[7]);
                    *(u32x4*)(base + (size_t)row * MOBA_W + bj * 128) = w;
                }
            }
    }
};
struct EpiRes {
    static constexpr bool PERM = false, AFTER_DRAIN = false;
    const float* xin; float* zout; const float* gate;
    __device__ __forceinline__ void operator()(const f32x4 (&acc)[2][2][4][2], const pg8::Unit& u, int wr, int wc, int fr, int fq) const {
        const int row0 = u.pm * 256 + wr * 64 + fr, col0 = u.pn * 256 + wc * 32 + 4 * fq; const int b = u.pm >> 3;
        f32x4 gv[2][2];
#pragma unroll
        for (int bj = 0; bj < 2; ++bj)
#pragma unroll
            for (int n = 0; n < 2; ++n) gv[bj][n] = *(const f32x4*)(gate + (size_t)b * MODW + col0 + bj * 128 + n * 16);
#pragma unroll
        for (int ai = 0; ai < 2; ++ai)
#pragma unroll
            for (int m = 0; m < 4; ++m) { const size_t off = (size_t)(row0 + ai * 128 + m * 16) * D + col0;
#pragma unroll
                for (int bj = 0; bj < 2; ++bj)
#pragma unroll
                    for (int n = 0; n < 2; ++n) { const f32x4 xv = *(const f32x4*)(xin + off + bj * 128 + n * 16);
                        *(f32x4*)(zout + off + bj * 128 + n * 16) = xv * ALPHA + gv[bj][n] * acc[ai][bj][m][n]; } }
    }
};

constexpr int NWAVES = 8, NT = NWAVES * 64;
constexpr int RING_BYTES = 131072;
constexpr int MISC_OFF = RING_BYTES;
constexpr int LDS_BYTES = 147456;
constexpr int CW_BAR = 4096;
constexpr size_t CTL_ZERO_BYTES = 64 * 1024;

#define GAS __attribute__((address_space(1)))
#define XB_TMO      128
#define XB_XCNT(j)  (256  + 64 * (j))
#define XB_XSUB(j)  (1280 + 64 * (j))
#define XB_XGEN(j)  (2304 + 64 * (j))
#define XB_TOP      3328
#define XB_TOPGEN   3392
#define XCD_BAR_WORDS 3456
#define XB_SPIN_CAP (1u << 22)
__device__ __forceinline__ unsigned xb_ld(unsigned* p)              { return __hip_atomic_load(p, __ATOMIC_RELAXED, __HIP_MEMORY_SCOPE_AGENT); }
__device__ __forceinline__ unsigned xb_add(unsigned* p, unsigned v) { return __hip_atomic_fetch_add(p, v, __ATOMIC_RELAXED, __HIP_MEMORY_SCOPE_AGENT); }
__device__ __forceinline__ unsigned xb_xcc_id() { return (unsigned)__builtin_amdgcn_s_getreg((3 << 11) | 20) & 0xFu; }
#define XB_SPIN(cond, bar) do { unsigned _sp = 0; while (cond) { __builtin_amdgcn_s_sleep(1); \
    if ((++_sp & 255u) == 0u) { if (xb_ld(&(bar)[XB_TMO])) break; if (_sp > XB_SPIN_CAP) { atomicAdd(&(bar)[XB_TMO], 1u); break; } } } } while (0)
struct XcdBarrier { unsigned* bar; unsigned x; volatile LAS unsigned* st; };
__device__ __forceinline__ XcdBarrier xcd_barrier_post(unsigned* bar, volatile LAS unsigned* st) {
    XcdBarrier b; b.bar = bar; b.x = xb_xcc_id(); b.st = st;
    if (threadIdx.x == 0) (void)xb_add(&bar[XB_XCNT(b.x)], 1u);
    return b;
}
__device__ __forceinline__ void xcd_barrier_complete(unsigned* bar, unsigned x, unsigned& nloc, unsigned& nx) {
    const unsigned G = gridDim.x * gridDim.y * gridDim.z;
    unsigned sum, cnt, mine, sp = 0u;
    for (;;) {
        sum = 0u; cnt = 0u; mine = 0u;
#pragma unroll
        for (unsigned j = 0; j < 16; ++j) { const unsigned c = xb_ld(&bar[XB_XCNT(j)]); sum += c; cnt += (c > 0u) ? 1u : 0u; mine = (j == x) ? c : mine; }
        if (sum == G) break;
        __builtin_amdgcn_s_sleep(1);
        if ((++sp & 255u) == 0u) { if (xb_ld(&bar[XB_TMO])) break; if (sp > XB_SPIN_CAP) { atomicAdd(&bar[XB_TMO], 1u); break; } }
    }
    nloc = mine > 0u ? mine : 1u; nx = cnt > 0u ? cnt : 1u;
}
__device__ __forceinline__ void xcd_barrier(const XcdBarrier& b) {
    asm volatile("s_waitcnt vmcnt(0)" ::: "memory");
    __syncthreads();
    if (threadIdx.x == 0) {
        unsigned* bar = b.bar;
        __builtin_amdgcn_s_waitcnt(0);
        unsigned nloc = b.st[0], nx = b.st[1];
        if (nloc == 0u) { xcd_barrier_complete(bar, b.x, nloc, nx); b.st[0] = nloc; b.st[1] = nx; }
        const unsigned old = xb_add(&bar[XB_XSUB(b.x)], 1u);
        const unsigned gen = old / nloc;
        if (old + 1u == (gen + 1u) * nloc) {
            __builtin_amdgcn_fence(__ATOMIC_RELEASE, "agent");
            asm volatile("s_waitcnt vmcnt(0)" ::: "memory");
            const unsigned og = xb_add(&bar[XB_TOP], 1u);
            const unsigned tg = og / nx;
            if (og + 1u == (tg + 1u) * nx) xb_add(&bar[XB_TOPGEN], 1u);
            else XB_SPIN(xb_ld(&bar[XB_TOPGEN]) == tg, bar);
            __builtin_amdgcn_fence(__ATOMIC_ACQUIRE, "agent");
            xb_add(&bar[XB_XGEN(b.x)], 1u);
            asm volatile("s_waitcnt vmcnt(0)" ::: "memory");
        } else {
            XB_SPIN(xb_ld(&bar[XB_XGEN(b.x)]) == gen, bar);
            __builtin_amdgcn_fence(__ATOMIC_ACQUIRE, "agent");
            asm volatile("s_waitcnt vmcnt(0)" ::: "memory");
        }
    }
    __syncthreads();
}

__device__ __forceinline__ void mod_partial_item(int item, const float* c, const float* w_ada, float* part, float* ldsf) {
    constexpr int nks = NT / 16, kper = 512 / nks, nw = NT / 64;
    const int tid = opaque_tid();
    const int l = item / (96 * KSPLIT), r = item % (96 * KSPLIT), cg64 = r / KSPLIT, s = r % KSPLIT, k0 = s * 512, col0 = cg64 * 64;
    float* cs = ldsf;
    float* red = ldsf + 8 * 512;
    for (int i = tid; i < 8 * 512; i += NT) cs[i] = c[(i >> 9) * D + k0 + (i & 511)];
    __syncthreads();
    const int cg = tid & 15, ks = tid >> 4;
    f32x4 acc[8];
#pragma unroll
    for (int b = 0; b < 8; ++b) acc[b] = (f32x4){0.f, 0.f, 0.f, 0.f};
    const float* wp = w_ada + ((size_t)l * D + k0 + ks * kper) * MODW + col0 + cg * 4;
#pragma unroll 4
    for (int kk = 0; kk < kper; ++kk) { const f32x4 w = *(const f32x4*)(wp + (size_t)kk * MODW);
#pragma unroll
        for (int b = 0; b < 8; ++b) acc[b] += w * cs[b * 512 + ks * kper + kk]; }
#pragma unroll
    for (int b = 0; b < 8; ++b)
#pragma unroll
        for (int j = 0; j < 4; ++j) { float v = acc[b][j]; v += __shfl_xor(v, 16); v += __shfl_xor(v, 32); acc[b][j] = v; }
    if ((tid & 63) < 16) {
#pragma unroll
        for (int b = 0; b < 8; ++b) *(f32x4*)(red + ((tid >> 6) * 8 + b) * 64 + cg * 4) = acc[b];
    }
    __syncthreads();
    for (int o = tid; o < 512; o += NT) { float v = 0.f;
#pragma unroll
        for (int w = 0; w < nw; ++w) v += red[w * 512 + o];
        part[(((size_t)l * KSPLIT + s) * 8 + (o >> 6)) * MODW + col0 + (o & 63)] = v; }
    __syncthreads();
}
__device__ __forceinline__ void transpose_item(const float* W, int K, int N, h16* WT, float* scr, int item, int lane) {
    const int nblk = N / 32, kb = item / nblk, nb = item % nblk, k0 = 64 * kb, n0 = 32 * nb;
#pragma unroll 8
    for (int i = 0; i < 32; ++i) { const int kk = 2 * i + (lane >> 5); scr[kk * 33 + (lane & 31)] = W[(size_t)(k0 + kk) * N + n0 + (lane & 31)]; }
    asm volatile("s_waitcnt lgkmcnt(0)" ::: "memory");
    const int c = lane & 7;
#pragma unroll
    for (int j = 0; j < 4; ++j) { const int n = (lane >> 3) + 8 * j; const float* s = scr + (8 * c) * 33 + n;
        u32x4 o; o.x = pk_h2(s[0 * 33], s[1 * 33]); o.y = pk_h2(s[2 * 33], s[3 * 33]); o.z = pk_h2(s[4 * 33], s[5 * 33]); o.w = pk_h2(s[6 * 33], s[7 * 33]);
        *(u32x4*)(WT + (size_t)(n0 + n) * K + k0 + 8 * c) = o; }
    asm volatile("s_waitcnt lgkmcnt(0)" ::: "memory");
}
constexpr int IT_W0IN = (D / 64) * (RET_IN / 32), IT_W0OUT = (RET_V / 64) * (D / 32), IT_W1IN = (D / 64) * (MOBA_IN / 32), IT_W1OUT = (MOBA_W / 64) * (D / 32);
constexpr int IT_WALL = IT_W0IN + IT_W0OUT + IT_W1IN + IT_W1OUT;

struct Ptrs {
    const float *x, *c; const int* pos; const float *ret_w_in, *ret_w_out, *moba_w_in, *moba_w_out, *w_ada, *b_ada, *ln_g, *ln_b;
    float* out; float *MOD, *PART, *KMEAN; float2 *RCS0, *RCS1;
    h16 *W0IN, *W0OUT, *W1IN, *W1OUT, *Q0, *K0, *V0, *G0, *H0, *H1, *Q1, *K1, *V1, *G1, *A1;
};

__device__ __forceinline__ void phase0(const Ptrs& P, float* ldsf, int bid, int G) {
    const int tid = opaque_tid(), wave = tid >> 6, lane = tid & 63;
    for (int it = bid; it < 2 * 96 * KSPLIT; it += G) mod_partial_item(it, P.c, P.w_ada, P.PART, ldsf);
    float* scr = ldsf + wave * (64 * 33);
    for (int it = bid * NWAVES + wave; it < IT_WALL; it += G * NWAVES) { int r = it;
        if (r < IT_W0IN) { transpose_item(P.ret_w_in, D, RET_IN, P.W0IN, scr, r, lane); continue; } r -= IT_W0IN;
        if (r < IT_W0OUT) { transpose_item(P.ret_w_out, RET_V, D, P.W0OUT, scr, r, lane); continue; } r -= IT_W0OUT;
        if (r < IT_W1IN) { transpose_item(P.moba_w_in, D, MOBA_IN, P.W1IN, scr, r, lane); continue; } r -= IT_W1IN;
        transpose_item(P.moba_w_out, MOBA_W, D, P.W1OUT, scr, r, lane); }
    for (int i = bid * NT + tid; i < M * 144; i += G * NT) {
        const int m = i / 144, r = i % 144; const float p = (float)P.pos[m];
        if (r < 128) { const float inv = powf(10000.0f, -(float)r * 2.0f / 256.0f); const float a = p * inv; P.RCS0[(size_t)m * 128 + r] = make_float2(cosf(a), sinf(a)); }
        else { const int q = r - 128; const float inv = powf(500000.0f, -(float)q * 2.0f / 32.0f); const float a = p * inv; P.RCS1[(size_t)m * 16 + q] = make_float2(cosf(a), sinf(a)); }
    }
}
__device__ __forceinline__ void phase1(const Ptrs& P, float* ldsf, int bid, int G) {
    const int tid = opaque_tid();
    for (int i = bid * NT + tid; i < 2 * 8 * MODW; i += G * NT) { const int l = i / (8 * MODW), r = i % (8 * MODW), b = r / MODW, j = r % MODW;
        float v = P.b_ada[l * MODW + j];
#pragma unroll
        for (int s = 0; s < KSPLIT; ++s) v += P.PART[(((size_t)l * KSPLIT + s) * 8 + b) * MODW + j];
        P.MOD[i] = v; }
    for (int ch = bid; ch < M / 64; ch += G) {
        const int b = ch / (SEQ / 64);
        __syncthreads();
        for (int j = tid; j < 2 * D; j += NT) { float v = P.b_ada[j];
#pragma unroll
            for (int s = 0; s < KSPLIT; ++s) v += P.PART[(((size_t)0 * KSPLIT + s) * 8 + b) * MODW + j];
            ldsf[j] = v; }
        __syncthreads();
        for (int e = tid; e < 64 * D / 4; e += NT) { const int rr = e / (D / 4), j = (e % (D / 4)) * 4; const size_t off = (size_t)(ch * 64 + rr) * D + j;
            const f32x4 xv = *(const f32x4*)(P.x + off), sh = *(const f32x4*)(ldsf + j), sc = *(const f32x4*)(ldsf + D + j);
            const f32x4 h = xv * (sc + 1.0f) + sh; u32x2 w; w.x = pk_h2(h[0], h[1]); w.y = pk_h2(h[2], h[3]); *(u32x2*)(P.H0 + off) = w; }
    }
}
__device__ __forceinline__ void phase_norm_gate(const h16* O, const h16* Gt, h16* A, int bid, int G) {
    const int tid_ = opaque_tid(); const int gw = bid * NWAVES + (tid_ >> 6), lane = tid_ & 63, NGW = G * NWAVES;
    for (int it = gw; it < M * RET_HEADS; it += NGW) {
        const size_t off = (size_t)it * RET_DV + lane * 8;
        const h16x8 ov = *(const h16x8*)(O + off), gv = *(const h16x8*)(Gt + off);
        float o[8]; float s = 0.f;
#pragma unroll
        for (int j = 0; j < 8; ++j) { o[j] = (float)ov[j]; s += o[j]; }
        const float mu = wave_sum(s) * (1.0f / RET_DV); float q = 0.f;
#pragma unroll
        for (int j = 0; j < 8; ++j) { o[j] -= mu; q += o[j] * o[j]; }
        const float rstd = 1.0f / sqrtf(wave_sum(q) * (1.0f / RET_DV) + GN_EPS);
        float r[8];
#pragma unroll
        for (int j = 0; j < 8; ++j) r[j] = o[j] * rstd * silu((float)gv[j]);
        u32x4 w; w.x = pk_h2(r[0], r[1]); w.y = pk_h2(r[2], r[3]); w.z = pk_h2(r[4], r[5]); w.w = pk_h2(r[6], r[7]);
        *(u32x4*)(A + off) = w;
    }
}
__device__ __forceinline__ void phase_layernorm(float* Z, const float* g, const float* bta, const float* mod_next, h16* H, int bid, int G) {
    const int tid_ = opaque_tid(); const int gw = bid * NWAVES + (tid_ >> 6), lane = tid_ & 63, NGW = G * NWAVES;
    for (int m = gw; m < M; m += NGW) {
        float* zr = Z + (size_t)m * D; f32x4 v[8]; float s = 0.f;
#pragma unroll
        for (int j = 0; j < 8; ++j) { v[j] = *(const f32x4*)(zr + j * 256 + lane * 4); s += (v[j][0] + v[j][1]) + (v[j][2] + v[j][3]); }
        const float mu = wave_sum(s) * (1.0f / D); float q = 0.f;
#pragma unroll
        for (int j = 0; j < 8; ++j) { v[j] = v[j] - mu; q += (v[j][0] * v[j][0] + v[j][1] * v[j][1]) + (v[j][2] * v[j][2] + v[j][3] * v[j][3]); }
        const float rstd = 1.0f / sqrtf(wave_sum(q) * (1.0f / D) + LN_EPS);
        const int b = m / SEQ;
#pragma unroll
        for (int j = 0; j < 8; ++j) { const int c = j * 256 + lane * 4;
            const f32x4 xo = v[j] * rstd * *(const f32x4*)(g + c) + *(const f32x4*)(bta + c);
            *(f32x4*)(zr + c) = xo;
            if (H) { const f32x4 sh = *(const f32x4*)(mod_next + (size_t)b * MODW + c), sc = *(const f32x4*)(mod_next + (size_t)b * MODW + D + c);
                const f32x4 h = xo * (sc + 1.0f) + sh; u32x2 w; w.x = pk_h2(h[0], h[1]); w.y = pk_h2(h[2], h[3]); *(u32x2*)(H + (size_t)m * D + c) = w; } }
    }
}

__device__ __forceinline__ void phase_retention_naive(const h16* Q, const h16* K, h16* VO, float* ldsf, int bid, int G) {
    constexpr int TT = 4;
    const int tid_ = opaque_tid(); const int half = tid_ >> 8, tid = tid_ & 255, vi = tid & 63, dq = tid >> 6;
    float* qs = ldsf + half * (3 * TT * 256);
    float* ks = qs + TT * 256;
    float* red = ks + TT * 256;
    for (int vb0 = bid * 2; vb0 < BATCH * RET_HEADS * 8; vb0 += 2 * G) {
        const int blk = vb0 + half, vg = blk & 7, h = (blk >> 3) & 7, b = blk >> 6;
        const float gamma = 1.0f - exp2f(-5.0f - (float)h);
        float S[64];
#pragma unroll
        for (int d = 0; d < 64; ++d) S[d] = 0.f;
        for (int t0 = 0; t0 < SEQ; t0 += TT) {
            __syncthreads();
            for (int i = tid; i < TT * 256; i += 256) { const int tt = i >> 8, d = i & 255; const size_t row = (size_t)(b * SEQ + t0 + tt);
                qs[tt * 256 + d] = (float)Q[row * RET_QK + h * 256 + d]; ks[tt * 256 + d] = (float)K[row * RET_QK + h * 256 + d]; }
            __syncthreads();
            float po[TT];
#pragma unroll
            for (int tt = 0; tt < TT; ++tt) {
                const float v = (float)VO[(size_t)(b * SEQ + t0 + tt) * RET_V + h * 512 + vg * 64 + vi];
                float a = 0.f;
#pragma unroll
                for (int d = 0; d < 64; ++d) { S[d] = gamma * S[d] + ks[tt * 256 + dq * 64 + d] * v; a += qs[tt * 256 + dq * 64 + d] * S[d]; }
                po[tt] = a;
            }
#pragma unroll
            for (int tt = 0; tt < TT; ++tt) red[(dq * TT + tt) * 64 + vi] = po[tt];
            __syncthreads();
            for (int i = tid; i < TT * 64; i += 256) { const int tt = i >> 6, v = i & 63;
                const float o = (red[(0 * TT + tt) * 64 + v] + red[(1 * TT + tt) * 64 + v]) + (red[(2 * TT + tt) * 64 + v] + red[(3 * TT + tt) * 64 + v]);
                VO[(size_t)(b * SEQ + t0 + tt) * RET_V + h * 512 + vg * 64 + v] = (h16)o; }
        }
        __syncthreads();
    }
}

__device__ __forceinline__ void phase_kmean(const h16* K, float* kmean, int bid, int G) {
    const int tid_ = opaque_tid();
    for (int i = bid * NT + tid_; i < BATCH * NBLK * MOBA_W; i += G * NT) {
        const int col = i % MOBA_W, bb = i / MOBA_W;
        float s = 0.f; for (int t = 0; t < MOBA_BLOCK; ++t) s += (float)K[((size_t)bb * MOBA_BLOCK + t) * MOBA_W + col];
        kmean[i] = s * (1.0f / MOBA_BLOCK); }
}
__device__ __forceinline__ void phase_moba_naive(const h16* Q, const h16* K, const h16* V, const h16* Gt, const float* kmean, h16* A, int bid, int G) {
    const int tid_ = opaque_tid(); const int half = tid_ >> 8, tid = tid_ & 255, qi = tid >> 2, part = tid & 3;
    for (int vb0 = bid * 2; vb0 < BATCH * MOBA_HEADS * 32; vb0 += 2 * G) {
        const int blk = vb0 + half, qt = blk & 31, h = (blk >> 5) & 15, b = blk >> 9;
        const int t = qt * 64 + qi, own = t >> 8; const size_t row = (size_t)b * SEQ + t;
        float q[32];
#pragma unroll
        for (int j = 0; j < 32; ++j) q[j] = (float)Q[row * MOBA_W + h * 128 + part * 32 + j];
        float gs[NBLK]; unsigned sel = 0u;
#pragma unroll
        for (int n = 0; n < NBLK; ++n) { float a = 0.f;
#pragma unroll
            for (int j = 0; j < 32; ++j) a += q[j] * kmean[((size_t)(b * NBLK + n)) * MOBA_W + h * 128 + part * 32 + j];
            a += __shfl_xor(a, 1); a += __shfl_xor(a, 2); gs[n] = a; }
#pragma unroll
        for (int r = 0; r < 3; ++r) { int best = -1; float bv = -3e38f;
#pragma unroll
            for (int n = 0; n < NBLK; ++n) if (n < own && !((sel >> n) & 1u) && gs[n] > bv) { bv = gs[n]; best = n; }
            if (best >= 0) sel |= 1u << best; }
        const float scale = 0.08838834764831845f;
        float mrun = -1e30f, lrun = 0.f, acc[32];
#pragma unroll
        for (int j = 0; j < 32; ++j) acc[j] = 0.f;
        for (int n = 0; n <= own; ++n) {
            const bool use = (n == own) || ((sel >> n) & 1u);
            if (!use) continue;
            const int kend = (n == own) ? (t & 255) + 1 : MOBA_BLOCK;
            for (int kk = 0; kk < kend; ++kk) {
                const size_t krow = (size_t)b * SEQ + n * MOBA_BLOCK + kk;
                const h16* kp = K + krow * MOBA_W + h * 128 + part * 32; float s = 0.f;
#pragma unroll
                for (int j = 0; j < 32; ++j) s += q[j] * (float)kp[j];
                s += __shfl_xor(s, 1); s += __shfl_xor(s, 2); s *= scale;
                const float mn = fmaxf(mrun, s), al = __expf(mrun - mn), p = __expf(s - mn);
                lrun = lrun * al + p; mrun = mn;
                const h16* vp = V + krow * MOBA_W + h * 128 + part * 32;
#pragma unroll
                for (int j = 0; j < 32; ++j) acc[j] = acc[j] * al + p * (float)vp[j];
            }
        }
        const float inv = 1.0f / lrun;
#pragma unroll
        for (int j = 0; j < 32; ++j) { const size_t o = row * MOBA_W + h * 128 + part * 32 + j; A[o] = (h16)(acc[j] * inv * silu((float)Gt[o])); }
    }
}

struct Args { const void* in[11]; float* out; unsigned char* ws; int ph_lo, ph_hi; };
constexpr int NPHASE = 12;
__global__ void __launch_bounds__(NT, 2) mk_fwd(Args a) {
    extern __shared__ __attribute__((aligned(16))) unsigned char lds[];
    LAS unsigned char* L = (LAS unsigned char*)lds;
    float* ldsf = (float*)lds;
    const int tid = threadIdx.x, bid = blockIdx.x, G = gridDim.x;
    volatile LAS unsigned* MISC = (volatile LAS unsigned*)(L + MISC_OFF);
    if (tid < 32) MISC[tid] = 0u;
    __syncthreads();
    unsigned char* ws = a.ws;
    Ptrs P;
    P.x = (const float*)a.in[0]; P.c = (const float*)a.in[1]; P.pos = (const int*)a.in[2];
    P.ret_w_in = (const float*)a.in[3]; P.ret_w_out = (const float*)a.in[4]; P.moba_w_in = (const float*)a.in[5]; P.moba_w_out = (const float*)a.in[6];
    P.w_ada = (const float*)a.in[7]; P.b_ada = (const float*)a.in[8]; P.ln_g = (const float*)a.in[9]; P.ln_b = (const float*)a.in[10];
    P.out = a.out; P.MOD = (float*)(ws + WS_MOD); P.PART = (float*)(ws + WS_PART); P.KMEAN = (float*)(ws + WS_KMEAN);
    P.RCS0 = (float2*)(ws + WS_RCS0); P.RCS1 = (float2*)(ws + WS_RCS1);
    P.W0IN = (h16*)(ws + WS_W0IN); P.W0OUT = (h16*)(ws + WS_W0OUT); P.W1IN = (h16*)(ws + WS_W1IN); P.W1OUT = (h16*)(ws + WS_W1OUT);
    P.Q0 = (h16*)(ws + WS_Q0); P.K0 = (h16*)(ws + WS_K0); P.V0 = (h16*)(ws + WS_V0); P.G0 = (h16*)(ws + WS_G0); P.H0 = (h16*)a.out;
    P.H1 = (h16*)(ws + WS_H1); P.Q1 = (h16*)(ws + WS_Q1); P.K1 = (h16*)(ws + WS_K1); P.V1 = (h16*)(ws + WS_V1); P.G1 = (h16*)(ws + WS_G1); P.A1 = (h16*)(ws + WS_A1);
    XcdBarrier bar = xcd_barrier_post((unsigned*)(ws + WS_CTL) + CW_BAR, MISC + 8);
    const int lo = a.ph_lo, hi = a.ph_hi;
#define IN(k) (lo <= (k) && (k) < hi)
#define SEAM(k) do { if (IN(k) && IN((k) + 1)) xcd_barrier(bar); } while (0)
    if (IN(0)) phase0(P, ldsf, bid, G);
    SEAM(0);
    if (IN(1)) phase1(P, ldsf, bid, G);
    SEAM(1);
    if (IN(2)) { pg8::Gemm g{P.H0, P.W0IN, M, RET_IN, D, 0}; pg8::StaticOrder S; S.init(M, RET_IN, G, bid); EpiRet E{P.Q0, P.K0, P.V0, P.G0, P.RCS0};
        pg8::gemm_phase<EpiRet, pg8::StaticOrder, true, true>(L, g, S, E); }
    SEAM(2);
    if (IN(3)) phase_retention_naive(P.Q0, P.K0, P.V0, ldsf, bid, G);
    SEAM(3);
    if (IN(4)) phase_norm_gate(P.V0, P.G0, P.G0, bid, G);
    SEAM(4);
    if (IN(5)) { pg8::Gemm g{P.G0, P.W0OUT, M, D, RET_V, 0}; pg8::StaticOrder S; S.init(M, D, G, bid); EpiRes E{P.x, P.out, P.MOD + 2 * D};
        pg8::gemm_phase<EpiRes, pg8::StaticOrder, true, true>(L, g, S, E); }
    SEAM(5);
    if (IN(6)) phase_layernorm(P.out, P.ln_g, P.ln_b, P.MOD + 8 * MODW, P.H1, bid, G);
    SEAM(6);
    if (IN(7)) { pg8::Gemm g{P.H1, P.W1IN, M, MOBA_IN, D, 0}; pg8::StaticOrder S; S.init(M, MOBA_IN, G, bid); EpiMoba E{P.Q1, P.K1, P.V1, P.G1, P.RCS1};
        pg8::gemm_phase<EpiMoba, pg8::StaticOrder, true, true>(L, g, S, E); }
    SEAM(7);
    if (IN(8)) phase_kmean(P.K1, P.KMEAN, bid, G);
    SEAM(8);
    if (IN(9)) phase_moba_naive(P.Q1, P.K1, P.V1, P.G1, P.KMEAN, P.A1, bid, G);
    SEAM(9);
    if (IN(10)) { pg8::Gemm g{P.A1, P.W1OUT, M, D, MOBA_W, 0}; pg8::StaticOrder S; S.init(M, D, G, bid); EpiRes E{P.out, P.out, P.MOD + 8 * MODW + 2 * D};
        pg8::gemm_phase<EpiRes, pg8::StaticOrder, true, true>(L, g, S, E); }
    SEAM(10);
    if (IN(11)) phase_layernorm(P.out, P.ln_g + D, P.ln_b + D, nullptr, nullptr, bid, G);
#undef IN
#undef SEAM
}

#ifndef MK_N_LAUNCHES
#define MK_N_LAUNCHES 1
#endif
extern "C" void kernel_launch(void* const* d_in, const int* in_sizes, int n_in, void* d_out, int out_size, void* d_ws, size_t ws_size, hipStream_t stream) {
    static int grid = 0;
    if (grid == 0) {
        if (n_in != 11 || out_size != M * D || ws_size < WS_END) { fprintf(stderr, "kernel_launch: unexpected shapes (n_in %d out %d ws %zu)\n", n_in, out_size, ws_size); grid = -1; return; }
        int dev = 0, cus = 0, per_cu = 0;
        if (hipGetDevice(&dev) != hipSuccess || hipDeviceGetAttribute(&cus, hipDeviceAttributeMultiprocessorCount, dev) != hipSuccess) { grid = -1; return; }
        if (hipFuncSetAttribute((const void*)mk_fwd, hipFuncAttributeMaxDynamicSharedMemorySize, LDS_BYTES) != hipSuccess) { fprintf(stderr, "kernel_launch: hipFuncSetAttribute failed\n"); grid = -1; return; }
        if (hipOccupancyMaxActiveBlocksPerMultiprocessor(&per_cu, (const void*)mk_fwd, NT, LDS_BYTES) != hipSuccess || per_cu < 1) { fprintf(stderr, "kernel_launch: occupancy query says %d\n", per_cu); (void)hipGetLastError(); grid = -1; return; }
        grid = cus;
    }
    if (grid < 0) return;
    if (hipMemsetAsync((char*)d_ws + WS_CTL, 0, CTL_ZERO_BYTES, stream) != hipSuccess) return;
    Args a{};
    for (int i = 0; i < 11; ++i) a.in[i] = d_in[i];
    a.out = (float*)d_out; a.ws = (unsigned char*)d_ws;
    if (MK_N_LAUNCHES == 1) { a.ph_lo = 0; a.ph_hi = NPHASE; hipLaunchKernelGGL(mk_fwd, dim3(grid), dim3(NT), LDS_BYTES, stream, a); }
    else for (int p = 0; p < NPHASE; ++p) { a.ph_lo = p; a.ph_hi = p + 1; hipLaunchKernelGGL(mk_fwd, dim3(grid), dim3(NT), LDS_BYTES, stream, a); }
}
```

```cpp
#include <hip/hip_runtime.h>
#include <cstdio>
#include <cstdint>
#include <cmath>

typedef _Float16 h16;
typedef _Float16 h16x8 __attribute__((ext_vector_type(8)));
typedef _Float16 h16x4 __attribute__((ext_vector_type(4)));
typedef _Float16 h16x2 __attribute__((ext_vector_type(2)));
typedef float f32x4 __attribute__((ext_vector_type(4)));
typedef float f32x2 __attribute__((ext_vector_type(2)));
typedef unsigned u32x4 __attribute__((ext_vector_type(4)));
typedef unsigned u32x2 __attribute__((ext_vector_type(2)));
#define LAS __attribute__((address_space(3)))

constexpr int D = 2048, BATCH = 8, SEQ = 2048, M = BATCH * SEQ;
constexpr int RET_HEADS = 8, RET_DK = 256, RET_DV = 512, RET_QK = 2048, RET_V = 4096, RET_IN = 12288;
constexpr int MOBA_HEADS = 16, MOBA_DH = 128, MOBA_W = 2048, MOBA_IN = 8192, MOBA_BLOCK = 256, NBLK = 8;
constexpr float ALPHA = 1.4142135623730951f;
constexpr float LN_EPS = 1e-5f, GN_EPS = 1e-5f;
constexpr int MODW = 3 * D;
constexpr int KSPLIT = 4;

constexpr size_t MiB = 1u << 20;
constexpr size_t WS_CTL = 0;
constexpr size_t WS_MOD = 1 * MiB;
constexpr size_t WS_KMEAN = WS_MOD + 512 * 1024;
constexpr size_t WS_RCS1 = 2 * MiB;
constexpr size_t WS_W0IN = 4 * MiB;
constexpr size_t WS_W0OUT = 52 * MiB;
constexpr size_t WS_W1IN = 68 * MiB;
constexpr size_t WS_W1OUT = 100 * MiB;
constexpr size_t WS_ACT = 108 * MiB;
constexpr size_t WS_Q0 = WS_ACT, WS_K0 = WS_ACT + 64 * MiB, WS_V0 = WS_ACT + 128 * MiB, WS_G0 = WS_ACT + 256 * MiB;
constexpr size_t WS_H1 = WS_ACT, WS_Q1 = WS_ACT + 64 * MiB, WS_K1 = WS_ACT + 128 * MiB, WS_V1 = WS_ACT + 192 * MiB, WS_G1 = WS_ACT + 256 * MiB, WS_A1 = WS_ACT + 320 * MiB;
constexpr size_t WS_RCS0 = 492 * MiB;
constexpr size_t WS_PART = 508 * MiB;
constexpr size_t WS_END = 512 * MiB;

__device__ __forceinline__ int opaque_tid() { int t = threadIdx.x; asm volatile("" : "+v"(t)); return t; }
__device__ __forceinline__ unsigned pk_h2(float lo, float hi) { h16x2 h = {(h16)lo, (h16)hi}; return __builtin_bit_cast(unsigned, h); }
__device__ __forceinline__ float wave_sum(float v) {
#pragma unroll
    for (int o = 1; o < 64; o <<= 1) v += __shfl_xor(v, o);
    return v;
}
__device__ __forceinline__ float silu(float g) { return g / (1.0f + __expf(-g)); }

namespace pg8 {
constexpr int BM = 256, BK = 64, HALF = 128, HTB = HALF * BK * 2, STAGE_BYTES = 8 * HTB, NXCD = 8, WGM = 8;
__host__ __device__ __forceinline__ int lds_byte(int r, int c) { const int st = (r >> 4) * 2 + (c >> 5), rr = r & 15, cc = c & 31, ob = rr * 64 + cc * 2; return st * 1024 + (ob ^ (((ob >> 9) & 1) << 5)); }
__host__ __device__ __forceinline__ void stage_rc(int b, int& R, int& C) { const int st = b / 1024, sb = b % 1024, swz = sb ^ (((sb >> 9) & 1) << 5); R = (st >> 1) * 16 + swz / 64; C = (st & 1) * 32 + (swz % 64) / 2; }
__host__ __device__ __forceinline__ int perm32(int rho) { const int n = rho >> 4, i = rho & 15; return 8 * (i >> 2) + 4 * n + (i & 3); }
struct Unit { int pm, pn; };
struct Gemm { const h16* A; const h16* Bt; int M, N, K, pad; };
struct StaticOrder {
    int nM, nN, nwg, G, c;
    __host__ __device__ void init(int M_, int N_, int G_, int c_) { nM = M_ / BM; nN = N_ / BM; nwg = nM * nN; G = G_; c = c_; }
    __host__ __device__ bool next(int i, Unit& u) const {
        const long L = (long)i * G + c; if (L >= nwg) return false;
        int wgid = (int)L; { const int q = nwg / NXCD, r = nwg % NXCD, xcd = wgid % NXCD, off = wgid / NXCD; wgid = (xcd < r ? xcd * (q + 1) : r * (q + 1) + (xcd - r) * q) + off; }
        const int nig = WGM * nN, gid = wgid / nig, fm = gid * WGM, gsz = (nM - fm) < WGM ? (nM - fm) : WGM;
        u.pm = fm + ((wgid % nig) % gsz); u.pn = (wgid % nig) / gsz; return true;
    }
    __device__ __forceinline__ void a_ready(const Unit&) const {}
    __device__ __forceinline__ void done(const Unit&) const {}
};

template <class Epi, class Sched, bool ALIGN_EPI = false, bool SP2 = false>
__device__ __forceinline__ void gemm_phase(LAS unsigned char* lds, const Gemm g, const Sched& S, const Epi& E) {
    const int tid = opaque_tid(), wid = __builtin_amdgcn_readfirstlane(tid >> 6), lane = tid & 63, wr = wid >> 2, wc = wid & 3, fr = lane & 15, fq = lane >> 4;
    const int K = g.K, nt = K / BK;
    unsigned voffA, voffB;
    { int R, C; stage_rc(tid * 16, R, C); const int Rb = Epi::PERM ? ((R & ~31) + perm32(R & 31)) : R;
        voffA = (unsigned)(R * K + C) * 2u; voffB = (unsigned)(Rb * K + C) * 2u; }
    const size_t pstep = (size_t)64 * K * 2;
    const size_t kstep = (size_t)(BK * 2);
    const size_t hstep = (size_t)HALF * K * 2;
    const size_t tstep = 2 * hstep;
    const unsigned ldsw = (unsigned)wid * 1024u;
    const int aoff = lds_byte(wr * 64 + fr, fq * 8), boff = lds_byte(wc * 32 + fr, fq * 8);
#define PG8_SA(b, h) (((b) * 2 + (h)) * HTB)
#define PG8_SB(b, h) ((4 + (b) * 2 + (h)) * HTB)
#define PG8_STAGE(bufoff, gbase, voff) do { _Pragma("unroll") for (int _i = 0; _i < 2; ++_i) \
        __builtin_amdgcn_global_load_lds((const unsigned*)((const char*)(gbase) + _i * pstep + (voff)), (LAS unsigned*)(lds + (bufoff) + ldsw + _i * 8192), 16, 0, 0); } while (0)
#define PG8_LDA(dst, b, h) do { _Pragma("unroll") for (int m = 0; m < 4; ++m) _Pragma("unroll") for (int k = 0; k < 2; ++k) dst[m][k] = *(const LAS h16x8*)(lds + PG8_SA(b, h) + aoff + m * 2048 + k * 1024); } while (0)
#define PG8_LDB(dst, b, h) do { _Pragma("unroll") for (int n = 0; n < 2; ++n) _Pragma("unroll") for (int k = 0; k < 2; ++k) dst[n][k] = *(const LAS h16x8*)(lds + PG8_SB(b, h) + boff + n * 2048 + k * 1024); } while (0)
#define PG8_MMA(ai, bj, At, Bt) do { __builtin_amdgcn_s_setprio(1); _Pragma("unroll") for (int m = 0; m < 4; ++m) _Pragma("unroll") for (int n = 0; n < 2; ++n) _Pragma("unroll") for (int k = 0; k < 2; ++k) \
        acc[ai][bj][m][n] = __builtin_amdgcn_mfma_f32_16x16x32_f16(Bt[n][k], At[m][k], acc[ai][bj][m][n], 0, 0, 0); __builtin_amdgcn_s_setprio(0); } while (0)
#define PG8_WAIT_V(n) asm volatile("s_waitcnt vmcnt(" #n ")" ::: "memory")
#define PG8_WAIT_L(n) asm volatile("s_waitcnt lgkmcnt(" #n ")" ::: "memory")
#define PG8_BAR __builtin_amdgcn_s_barrier()
#define PG8_SCHED __builtin_amdgcn_sched_barrier(0)
    Unit cur, nxt; int ui = 0;
    if (!S.next(0, cur)) return;
    f32x4 acc[2][2][4][2];
#pragma unroll
    for (int a = 0; a < 2; ++a)
#pragma unroll
        for (int b = 0; b < 2; ++b)
#pragma unroll
            for (int m = 0; m < 4; ++m)
#pragma unroll
                for (int n = 0; n < 2; ++n) acc[a][b][m][n] = (f32x4){0.f, 0.f, 0.f, 0.f};
    h16x8 At[4][2], B0[2][2], B1[2][2];
    const char* cA = (const char*)g.A + (size_t)cur.pm * tstep; const char* cB = (const char*)g.Bt + (size_t)cur.pn * tstep;
    S.a_ready(cur);
    if constexpr (SP2) {
        PG8_STAGE(PG8_SB(0, 0), cB, voffB); PG8_STAGE(PG8_SB(0, 1), cB + hstep, voffB); PG8_STAGE(PG8_SA(0, 0), cA, voffA); PG8_STAGE(PG8_SA(0, 1), cA + hstep, voffA);
        if (wr == 1) PG8_BAR;
        PG8_WAIT_V(2); PG8_BAR;
        PG8_STAGE(PG8_SB(1, 0), cB + kstep, voffB); PG8_STAGE(PG8_SA(1, 0), cA + kstep, voffA); PG8_STAGE(PG8_SB(1, 1), cB + hstep + kstep, voffB);
        PG8_WAIT_V(6); PG8_BAR;
    } else {
        PG8_STAGE(PG8_SB(0, 0), cB, voffB); PG8_STAGE(PG8_SA(0, 0), cA, voffA); PG8_STAGE(PG8_SB(0, 1), cB + hstep, voffB); PG8_STAGE(PG8_SA(0, 1), cA + hstep, voffA);
        if (wr == 1) PG8_BAR;
        PG8_WAIT_V(4); PG8_BAR;
        PG8_STAGE(PG8_SB(1, 0), cB + kstep, voffB); PG8_STAGE(PG8_SA(1, 0), cA + kstep, voffA); PG8_STAGE(PG8_SB(1, 1), cB + hstep + kstep, voffB);
        PG8_WAIT_V(6); PG8_BAR;
    }
    for (;;) {
        const bool has_next = S.next(ui + 1, nxt);
        const char* nA = has_next ? (const char*)g.A + (size_t)nxt.pm * tstep : cA; const char* nB = has_next ? (const char*)g.Bt + (size_t)nxt.pn * tstep : cB;
        for (int t = 0; t < nt; t += 2) {
            const bool last = (t == nt - 2);
            const char* a1 = cA + (size_t)(t + 1) * kstep;
            const char* a2 = last ? nA : cA + (size_t)(t + 2) * kstep; const char* b2 = last ? nB : cB + (size_t)(t + 2) * kstep;
            const char* a3 = a2 + kstep; const char* b3 = b2 + kstep;
            if (last && has_next) S.a_ready(nxt);
            if constexpr (SP2) {
            PG8_LDB(B0, 0, 0); PG8_LDB(B1, 0, 1); PG8_SCHED; PG8_LDA(At, 0, 0); PG8_STAGE(PG8_SA(1, 1), a1 + hstep, voffA);
            PG8_WAIT_V(8); PG8_WAIT_L(0); PG8_BAR; PG8_MMA(0, 0, At, B0); PG8_MMA(0, 1, At, B1); PG8_BAR; PG8_SCHED;
            PG8_LDA(At, 0, 1); PG8_STAGE(PG8_SB(0, 0), b2, voffB); PG8_STAGE(PG8_SB(0, 1), b2 + hstep, voffB); PG8_STAGE(PG8_SA(0, 0), a2, voffA);
            PG8_WAIT_V(8); PG8_WAIT_L(0); PG8_BAR; PG8_MMA(1, 0, At, B0); PG8_MMA(1, 1, At, B1); PG8_BAR; PG8_SCHED;
            PG8_LDB(B0, 1, 0); PG8_LDB(B1, 1, 1); PG8_SCHED; PG8_LDA(At, 1, 0); PG8_STAGE(PG8_SA(0, 1), a2 + hstep, voffA);
            PG8_WAIT_V(8); PG8_WAIT_L(0); PG8_BAR; PG8_MMA(0, 0, At, B0); PG8_MMA(0, 1, At, B1); PG8_BAR; PG8_SCHED;
            PG8_LDA(At, 1, 1); PG8_STAGE(PG8_SB(1, 0), b3, voffB); PG8_STAGE(PG8_SB(1, 1), b3 + hstep, voffB); PG8_STAGE(PG8_SA(1, 0), a3, voffA);
            PG8_WAIT_V(8); PG8_WAIT_L(0); PG8_BAR; PG8_MMA(1, 0, At, B0); PG8_MMA(1, 1, At, B1); PG8_BAR; PG8_SCHED;
            } else {
            PG8_LDB(B0, 0, 0); PG8_SCHED; PG8_LDA(At, 0, 0); PG8_STAGE(PG8_SA(1, 1), a1 + hstep, voffA);
            PG8_WAIT_L(8); PG8_BAR; PG8_WAIT_L(0); PG8_MMA(0, 0, At, B0); PG8_BAR; PG8_SCHED;
            PG8_LDB(B1, 0, 1); PG8_STAGE(PG8_SB(0, 0), b2, voffB);
            PG8_BAR; PG8_WAIT_L(0); PG8_MMA(0, 1, At, B1); PG8_BAR;
            PG8_LDA(At, 0, 1); PG8_STAGE(PG8_SA(0, 0), a2, voffA);
            PG8_BAR; PG8_WAIT_L(0); PG8_MMA(1, 0, At, B0); PG8_BAR; PG8_SCHED;
            PG8_STAGE(PG8_SB(0, 1), b2 + hstep, voffB);
            PG8_WAIT_V(6); PG8_BAR; PG8_MMA(1, 1, At, B1); PG8_BAR;
            PG8_LDB(B0, 1, 0); PG8_SCHED; PG8_LDA(At, 1, 0); PG8_STAGE(PG8_SA(0, 1), a2 + hstep, voffA);
            PG8_WAIT_L(8); PG8_BAR; PG8_WAIT_L(0); PG8_MMA(0, 0, At, B0); PG8_BAR; PG8_SCHED;
            PG8_LDB(B1, 1, 1); PG8_STAGE(PG8_SB(1, 0), b3, voffB);
            PG8_BAR; PG8_WAIT_L(0); PG8_MMA(0, 1, At, B1); PG8_BAR;
            PG8_LDA(At, 1, 1); PG8_STAGE(PG8_SA(1, 0), a3, voffA);
            PG8_BAR; PG8_WAIT_L(0); PG8_MMA(1, 0, At, B0); PG8_BAR; PG8_SCHED;
            PG8_STAGE(PG8_SB(1, 1), b3 + hstep, voffB);
            PG8_WAIT_V(6); PG8_BAR; PG8_MMA(1, 1, At, B1); PG8_BAR;
            }
        }
        if constexpr (ALIGN_EPI) { if (wr == 0) PG8_BAR; }
        if constexpr (!Epi::AFTER_DRAIN) { E(acc, cur, wr, wc, fr, fq); S.done(cur); }
        if (!has_next) break;
#pragma unroll
        for (int a = 0; a < 2; ++a)
#pragma unroll
            for (int b = 0; b < 2; ++b)
#pragma unroll
                for (int m = 0; m < 4; ++m)
#pragma unroll
                    for (int n = 0; n < 2; ++n) acc[a][b][m][n] = (f32x4){0.f, 0.f, 0.f, 0.f};
        cur = nxt; cA = nA; cB = nB; ++ui;
        if constexpr (ALIGN_EPI) { if (wr == 1) PG8_BAR; }
    }
    PG8_WAIT_V(0);
    if constexpr (!ALIGN_EPI) { if (wr == 0) PG8_BAR; }
    PG8_BAR;
#undef PG8_SA
#undef PG8_SB
#undef PG8_STAGE
#undef PG8_LDA
#undef PG8_LDB
#undef PG8_MMA
#undef PG8_WAIT_V
#undef PG8_WAIT_L
#undef PG8_BAR
#undef PG8_SCHED
}
}

struct EpiRet {
    static constexpr bool PERM = true, AFTER_DRAIN = false;
    h16 *Q, *K, *V, *G; const float2* rcs;
    __device__ __forceinline__ void operator()(const f32x4 (&acc)[2][2][4][2], const pg8::Unit& u, int wr, int wc, int fr, int fq) const {
        const int row0 = u.pm * 256 + wr * 64 + fr;
        if (u.pn < 16) {
            h16* base = (u.pn < 8) ? Q + u.pn * 256 : K + (u.pn - 8) * 256; const float sc = (u.pn < 8) ? 1.0f : 0.0625f;
            const int d0 = wc * 32 + 8 * fq;
#pragma unroll
            for (int ai = 0; ai < 2; ++ai)
#pragma unroll
                for (int m = 0; m < 4; ++m) {
                    const int row = row0 + ai * 128 + m * 16;
                    const f32x4* cs = (const f32x4*)(rcs + (size_t)row * 128 + d0);
                    float o1[8], o2[8];
#pragma unroll
                    for (int n = 0; n < 2; ++n) { const f32x4 c01 = cs[2 * n], c23 = cs[2 * n + 1]; const f32x4 x1 = acc[ai][0][m][n], x2 = acc[ai][1][m][n];
                        const float cc[4] = {c01[0], c01[2], c23[0], c23[2]}, ss[4] = {c01[1], c01[3], c23[1], c23[3]};
#pragma unroll
                        for (int j = 0; j < 4; ++j) { o1[4 * n + j] = (x1[j] * cc[j] - x2[j] * ss[j]) * sc; o2[4 * n + j] = (x2[j] * cc[j] + x1[j] * ss[j]) * sc; } }
                    u32x4 w1, w2; w1.x = pk_h2(o1[0], o1[1]); w1.y = pk_h2(o1[2], o1[3]); w1.z = pk_h2(o1[4], o1[5]); w1.w = pk_h2(o1[6], o1[7]);
                    w2.x = pk_h2(o2[0], o2[1]); w2.y = pk_h2(o2[2], o2[3]); w2.z = pk_h2(o2[4], o2[5]); w2.w = pk_h2(o2[6], o2[7]);
                    h16* rp = base + (size_t)row * RET_QK + d0;
                    *(u32x4*)rp = w1; *(u32x4*)(rp + 128) = w2;
                }
        } else {
            h16* base = (u.pn < 32) ? V + (u.pn - 16) * 256 : G + (u.pn - 32) * 256;
            const int c0 = wc * 32 + 8 * fq;
#pragma unroll
            for (int ai = 0; ai < 2; ++ai)
#pragma unroll
                for (int m = 0; m < 4; ++m) {
                    h16* rp = base + (size_t)(row0 + ai * 128 + m * 16) * RET_V + c0;
#pragma unroll
                    for (int bj = 0; bj < 2; ++bj) { const f32x4 v0 = acc[ai][bj][m][0], v1 = acc[ai][bj][m][1];
                        u32x4 w; w.x = pk_h2(v0[0], v0[1]); w.y = pk_h2(v0[2], v0[3]); w.z = pk_h2(v1[0], v1[1]); w.w = pk_h2(v1[2], v1[3]);
                        *(u32x4*)(rp + bj * 128) = w; }
                }
        }
    }
};
struct EpiMoba {
    static constexpr bool PERM = true, AFTER_DRAIN = false;
    h16 *Q, *K, *V, *G; const float2* rcs;
    __device__ __forceinline__ void operator()(const f32x4 (&acc)[2][2][4][2], const pg8::Unit& u, int wr, int wc, int fr, int fq) const {
        const int row0 = u.pm * 256 + wr * 64 + fr; const int sel = u.pn >> 3;
        h16* base = (sel == 0 ? Q : sel == 1 ? K : sel == 2 ? V : G) + (u.pn & 7) * 256 + wc * 32 + 8 * fq;
        const bool rope = (sel < 2) && (wc == 0);
#pragma unroll
        for (int ai = 0; ai < 2; ++ai)
#pragma unroll
            for (int m = 0; m < 4; ++m) {
                const int row = row0 + ai * 128 + m * 16;
                float cc[8], ss[8];
                if (rope) { const f32x4* cs = (const f32x4*)(rcs + (size_t)row * 16 + ((8 * fq) & 15));
#pragma unroll
                    for (int q = 0; q < 4; ++q) { const f32x4 t = cs[q]; cc[2 * q] = t[0]; ss[2 * q] = t[1]; cc[2 * q + 1] = t[2]; ss[2 * q + 1] = t[3]; } }
#pragma unroll
                for (int bj = 0; bj < 2; ++bj) {
                    float o[8];
#pragma unroll
                    for (int n = 0; n < 2; ++n)
#pragma unroll
                        for (int j = 0; j < 4; ++j) { const float x = acc[ai][bj][m][n][j]; float r = x;
                            if (rope) { const float y = __shfl_xor(x, 32); r = (fq < 2) ? (x * cc[4 * n + j] - y * ss[4 * n + j]) : (x * cc[4 * n + j] + y * ss[4 * n + j]); }
                            o[4 * n + j] = r; }
                    u32x4 w; w.x = pk_h2(o[0], o[1]); w.y = pk_h2(o[2], o[3]); w.z = pk_h2(o[4], o[5]); w.w = pk_h2(o[6], o[7]);
                    *(u32x4*)(base + (size_t)row * MOBA_W + bj * 128) = w;
                }
            }
    }
};
struct EpiRes {
    static constexpr bool PERM = false, AFTER_DRAIN = false;
    const float* xin; float* zout; const float* gate;
    __device__ __forceinline__ void operator()(const f32x4 (&acc)[2][2][4][2], const pg8::Unit& u, int wr, int wc, int fr, int fq) const {
        const int row0 = u.pm * 256 + wr * 64 + fr, col0 = u.pn * 256 + wc * 32 + 4 * fq; const int b = u.pm >> 3;
        f32x4 gv[2][2];
#pragma unroll
        for (int bj = 0; bj < 2; ++bj)
#pragma unroll
            for (int n = 0; n < 2; ++n) gv[bj][n] = *(const f32x4*)(gate + (size_t)b * MODW + col0 + bj * 128 + n * 16);
#pragma unroll
        for (int ai = 0; ai < 2; ++ai)
#pragma unroll
            for (int m = 0; m < 4; ++m) { const size_t off = (size_t)(row0 + ai * 128 + m * 16) * D + col0;
#pragma unroll
                for (int bj = 0; bj < 2; ++bj)
#pragma unroll
                    for (int n = 0; n < 2; ++n) { const f32x4 xv = *(const f32x4*)(xin + off + bj * 128 + n * 16);
                        *(f32x4*)(zout + off + bj * 128 + n * 16) = xv * ALPHA + gv[bj][n] * acc[ai][bj][m][n]; } }
    }
};

constexpr int NWAVES = 8, NT = NWAVES * 64;
constexpr int RING_BYTES = 131072;
constexpr int MISC_OFF = RING_BYTES;
constexpr int LDS_BYTES = 147456;
constexpr int CW_BAR = 4096;
constexpr size_t CTL_ZERO_BYTES = 64 * 1024;

#define GAS __attribute__((address_space(1)))
#define XB_TMO      128
#define XB_XCNT(j)  (256  + 64 * (j))
#define XB_XSUB(j)  (1280 + 64 * (j))
#define XB_XGEN(j)  (2304 + 64 * (j))
#define XB_TOP      3328
#define XB_TOPGEN   3392
#define XCD_BAR_WORDS 3456
#define XB_SPIN_CAP (1u << 22)
__device__ __forceinline__ unsigned xb_ld(unsigned* p)              { return __hip_atomic_load(p, __ATOMIC_RELAXED, __HIP_MEMORY_SCOPE_AGENT); }
__device__ __forceinline__ unsigned xb_add(unsigned* p, unsigned v) { return __hip_atomic_fetch_add(p, v, __ATOMIC_RELAXED, __HIP_MEMORY_SCOPE_AGENT); }
__device__ __forceinline__ unsigned xb_xcc_id() { return (unsigned)__builtin_amdgcn_s_getreg((3 << 11) | 20) & 0xFu; }
#define XB_SPIN(cond, bar) do { unsigned _sp = 0; while (cond) { __builtin_amdgcn_s_sleep(1); \
    if ((++_sp & 255u) == 0u) { if (xb_ld(&(bar)[XB_TMO])) break; if (_sp > XB_SPIN_CAP) { atomicAdd(&(bar)[XB_TMO], 1u); break; } } } } while (0)
struct XcdBarrier { unsigned* bar; unsigned x; volatile LAS unsigned* st; };
__device__ __forceinline__ XcdBarrier xcd_barrier_post(unsigned* bar, volatile LAS unsigned* st) {
    XcdBarrier b; b.bar = bar; b.x = xb_xcc_id(); b.st = st;
    if (threadIdx.x == 0) (void)xb_add(&bar[XB_XCNT(b.x)], 1u);
    return b;
}
__device__ __forceinline__ void xcd_barrier_complete(unsigned* bar, unsigned x, unsigned& nloc, unsigned& nx) {
    const unsigned G = gridDim.x * gridDim.y * gridDim.z;
    unsigned sum, cnt, mine, sp = 0u;
    for (;;) {
        sum = 0u; cnt = 0u; mine = 0u;
#pragma unroll
        for (unsigned j = 0; j < 16; ++j) { const unsigned c = xb_ld(&bar[XB_XCNT(j)]); sum += c; cnt += (c > 0u) ? 1u : 0u; mine = (j == x) ? c : mine; }
        if (sum == G) break;
        __builtin_amdgcn_s_sleep(1);
        if ((++sp & 255u) == 0u) { if (xb_ld(&bar[XB_TMO])) break; if (sp > XB_SPIN_CAP) { atomicAdd(&bar[XB_TMO], 1u); break; } }
    }
    nloc = mine > 0u ? mine : 1u; nx = cnt > 0u ? cnt : 1u;
}
__device__ __forceinline__ void xcd_barrier(const XcdBarrier& b) {
    asm volatile("s_waitcnt vmcnt(0)" ::: "memory");
    __syncthreads();
    if (threadIdx.x == 0) {
        unsigned* bar = b.bar;
        __builtin_amdgcn_s_waitcnt(0);
        unsigned nloc = b.st[0], nx = b.st[1];
        if (nloc == 0u) { xcd_barrier_complete(bar, b.x, nloc, nx); b.st[0] = nloc; b.st[1] = nx; }
        const unsigned old = xb_add(&bar[XB_XSUB(b.x)], 1u);
        const unsigned gen = old / nloc;
        if (old + 1u == (gen + 1u) * nloc) {
            __builtin_amdgcn_fence(__ATOMIC_RELEASE, "agent");
            asm volatile("s_waitcnt vmcnt(0)" ::: "memory");
            const unsigned og = xb_add(&bar[XB_TOP], 1u);
            const unsigned tg = og / nx;
            if (og + 1u == (tg + 1u) * nx) xb_add(&bar[XB_TOPGEN], 1u);
            else XB_SPIN(xb_ld(&bar[XB_TOPGEN]) == tg, bar);
            __builtin_amdgcn_fence(__ATOMIC_ACQUIRE, "agent");
            xb_add(&bar[XB_XGEN(b.x)], 1u);
            asm volatile("s_waitcnt vmcnt(0)" ::: "memory");
        } else {
            XB_SPIN(xb_ld(&bar[XB_XGEN(b.x)]) == gen, bar);
            __builtin_amdgcn_fence(__ATOMIC_ACQUIRE, "agent");
            asm volatile("s_waitcnt vmcnt(0)" ::: "memory");
        }
    }
    __syncthreads();
}

__device__ __forceinline__ void mod_partial_item(int item, const float* c, const float* w_ada, float* part, float* ldsf) {
    constexpr int nks = NT / 16, kper = 512 / nks, nw = NT / 64;
    const int tid = opaque_tid();
    const int l = item / (96 * KSPLIT), r = item % (96 * KSPLIT), cg64 = r / KSPLIT, s = r % KSPLIT, k0 = s * 512, col0 = cg64 * 64;
    float* cs = ldsf;
    float* red = ldsf + 8 * 512;
    for (int i = tid; i < 8 * 512; i += NT) cs[i] = c[(i >> 9) * D + k0 + (i & 511)];
    __syncthreads();
    const int cg = tid & 15, ks = tid >> 4;
    f32x4 acc[8];
#pragma unroll
    for (int b = 0; b < 8; ++b) acc[b] = (f32x4){0.f, 0.f, 0.f, 0.f};
    const float* wp = w_ada + ((size_t)l * D + k0 + ks * kper) * MODW + col0 + cg * 4;
#pragma unroll 4
    for (int kk = 0; kk < kper; ++kk) { const f32x4 w = *(const f32x4*)(wp + (size_t)kk * MODW);
#pragma unroll
        for (int b = 0; b < 8; ++b) acc[b] += w * cs[b * 512 + ks * kper + kk]; }
#pragma unroll
    for (int b = 0; b < 8; ++b)
#pragma unroll
        for (int j = 0; j < 4; ++j) { float v = acc[b][j]; v += __shfl_xor(v, 16); v += __shfl_xor(v, 32); acc[b][j] = v; }
    if ((tid & 63) < 16) {
#pragma unroll
        for (int b = 0; b < 8; ++b) *(f32x4*)(red + ((tid >> 6) * 8 + b) * 64 + cg * 4) = acc[b];
    }
    __syncthreads();
    for (int o = tid; o < 512; o += NT) { float v = 0.f;
#pragma unroll
        for (int w = 0; w < nw; ++w) v += red[w * 512 + o];
        part[(((size_t)l * KSPLIT + s) * 8 + (o >> 6)) * MODW + col0 + (o & 63)] = v; }
    __syncthreads();
}
__device__ __forceinline__ void transpose_item(const float* W, int K, int N, h16* WT, float* scr, int item, int lane) {
    const int nblk = N / 32, kb = item / nblk, nb = item % nblk, k0 = 64 * kb, n0 = 32 * nb;
#pragma unroll 8
    for (int i = 0; i < 32; ++i) { const int kk = 2 * i + (lane >> 5); scr[kk * 33 + (lane & 31)] = W[(size_t)(k0 + kk) * N + n0 + (lane & 31)]; }
    asm volatile("s_waitcnt lgkmcnt(0)" ::: "memory");
    const int c = lane & 7;
#pragma unroll
    for (int j = 0; j < 4; ++j) { const int n = (lane >> 3) + 8 * j; const float* s = scr + (8 * c) * 33 + n;
        u32x4 o; o.x = pk_h2(s[0 * 33], s[1 * 33]); o.y = pk_h2(s[2 * 33], s[3 * 33]); o.z = pk_h2(s[4 * 33], s[5 * 33]); o.w = pk_h2(s[6 * 33], s[7 * 33]);
        *(u32x4*)(WT + (size_t)(n0 + n) * K + k0 + 8 * c) = o; }
    asm volatile("s_waitcnt lgkmcnt(0)" ::: "memory");
}
constexpr int IT_W0IN = (D / 64) * (RET_IN / 32), IT_W0OUT = (RET_V / 64) * (D / 32), IT_W1IN = (D / 64) * (MOBA_IN / 32), IT_W1OUT = (MOBA_W / 64) * (D / 32);
constexpr int IT_WALL = IT_W0IN + IT_W0OUT + IT_W1IN + IT_W1OUT;

struct Ptrs {
    const float *x, *c; const int* pos; const float *ret_w_in, *ret_w_out, *moba_w_in, *moba_w_out, *w_ada, *b_ada, *ln_g, *ln_b;
    float* out; float *MOD, *PART, *KMEAN; float2 *RCS0, *RCS1;
    h16 *W0IN, *W0OUT, *W1IN, *W1OUT, *Q0, *K0, *V0, *G0, *H0, *H1, *Q1, *K1, *V1, *G1, *A1;
};

__device__ __forceinline__ void phase0(const Ptrs& P, float* ldsf, int bid, int G) {
    const int tid = opaque_tid(), wave = tid >> 6, lane = tid & 63;
    for (int it = bid; it < 2 * 96 * KSPLIT; it += G) mod_partial_item(it, P.c, P.w_ada, P.PART, ldsf);
    float* scr = ldsf + wave * (64 * 33);
    for (int it = bid * NWAVES + wave; it < IT_WALL; it += G * NWAVES) { int r = it;
        if (r < IT_W0IN) { transpose_item(P.ret_w_in, D, RET_IN, P.W0IN, scr, r, lane); continue; } r -= IT_W0IN;
        if (r < IT_W0OUT) { transpose_item(P.ret_w_out, RET_V, D, P.W0OUT, scr, r, lane); continue; } r -= IT_W0OUT;
        if (r < IT_W1IN) { transpose_item(P.moba_w_in, D, MOBA_IN, P.W1IN, scr, r, lane); continue; } r -= IT_W1IN;
        transpose_item(P.moba_w_out, MOBA_W, D, P.W1OUT, scr, r, lane); }
    for (int i = bid * NT + tid; i < M * 144; i += G * NT) {
        const int m = i / 144, r = i % 144; const float p = (float)P.pos[m];
        if (r < 128) { const float inv = powf(10000.0f, -(float)r * 2.0f / 256.0f); const float a = p * inv; P.RCS0[(size_t)m * 128 + r] = make_float2(cosf(a), sinf(a)); }
        else { const int q = r - 128; const float inv = powf(500000.0f, -(float)q * 2.0f / 32.0f); const float a = p * inv; P.RCS1[(size_t)m * 16 + q] = make_float2(cosf(a), sinf(a)); }
    }
}
__device__ __forceinline__ void phase1(const Ptrs& P, float* ldsf, int bid, int G) {
    const int tid = opaque_tid();
    for (int i = bid * NT + tid; i < 2 * 8 * MODW; i += G * NT) { const int l = i / (8 * MODW), r = i % (8 * MODW), b = r / MODW, j = r % MODW;
        float v = P.b_ada[l * MODW + j];
#pragma unroll
        for (int s = 0; s < KSPLIT; ++s) v += P.PART[(((size_t)l * KSPLIT + s) * 8 + b) * MODW + j];
        P.MOD[i] = v; }
    for (int ch = bid; ch < M / 64; ch += G) {
        const int b = ch / (SEQ / 64);
        __syncthreads();
        for (int j = tid; j < 2 * D; j += NT) { float v = P.b_ada[j];
#pragma unroll
            for (int s = 0; s < KSPLIT; ++s) v += P.PART[(((size_t)0 * KSPLIT + s) * 8 + b) * MODW + j];
            ldsf[j] = v; }
        __syncthreads();
        for (int e = tid; e < 64 * D / 4; e += NT) { const int rr = e / (D / 4), j = (e % (D / 4)) * 4; const size_t off = (size_t)(ch * 64 + rr) * D + j;
            const f32x4 xv = *(const f32x4*)(P.x + off), sh = *(const f32x4*)(ldsf + j), sc = *(const f32x4*)(ldsf + D + j);
            const f32x4 h = xv * (sc + 1.0f) + sh; u32x2 w; w.x = pk_h2(h[0], h[1]); w.y = pk_h2(h[2], h[3]); *(u32x2*)(P.H0 + off) = w; }
    }
}
__device__ __forceinline__ void phase_norm_gate(const h16* O, const h16* Gt, h16* A, int bid, int G) {
    const int tid_ = opaque_tid(); const int gw = bid * NWAVES + (tid_ >> 6), lane = tid_ & 63, NGW = G * NWAVES;
    for (int it = gw; it < M * RET_HEADS; it += NGW) {
        const size_t off = (size_t)it * RET_DV + lane * 8;
        const h16x8 ov = *(const h16x8*)(O + off), gv = *(const h16x8*)(Gt + off);
        float o[8]; float s = 0.f;
#pragma unroll
        for (int j = 0; j < 8; ++j) { o[j] = (float)ov[j]; s += o[j]; }
        const float mu = wave_sum(s) * (1.0f / RET_DV); float q = 0.f;
#pragma unroll
        for (int j = 0; j < 8; ++j) { o[j] -= mu; q += o[j] * o[j]; }
        const float rstd = 1.0f / sqrtf(wave_sum(q) * (1.0f / RET_DV) + GN_EPS);
        float r[8];
#pragma unroll
        for (int j = 0; j < 8; ++j) r[j] = o[j] * rstd * silu((float)gv[j]);
        u32x4 w; w.x = pk_h2(r[0], r[1]); w.y = pk_h2(r[2], r[3]); w.z = pk_h2(r[4], r[5]); w.w = pk_h2(r[6], r[7]);
        *(u32x4*)(A + off) = w;
    }
}
__device__ __forceinline__ void phase_layernorm(float* Z, const float* g, const float* bta, const float* mod_next, h16* H, int bid, int G) {
    const int tid_ = opaque_tid(); const int gw = bid * NWAVES + (tid_ >> 6), lane = tid_ & 63, NGW = G * NWAVES;
    for (int m = gw; m < M; m += NGW) {
        float* zr = Z + (size_t)m * D; f32x4 v[8]; float s = 0.f;
#pragma unroll
        for (int j = 0; j < 8; ++j) { v[j] = *(const f32x4*)(zr + j * 256 + lane * 4); s += (v[j][0] + v[j][1]) + (v[j][2] + v[j][3]); }
        const float mu = wave_sum(s) * (1.0f / D); float q = 0.f;
#pragma unroll
        for (int j = 0; j < 8; ++j) { v[j] = v[j] - mu; q += (v[j][0] * v[j][0] + v[j][1] * v[j][1]) + (v[j][2] * v[j][2] + v[j][3] * v[j][3]); }
        const float rstd = 1.0f / sqrtf(wave_sum(q) * (1.0f / D) + LN_EPS);
        const int b = m / SEQ;
#pragma unroll
        for (int j = 0; j < 8; ++j) { const int c = j * 256 + lane * 4;
            const f32x4 xo = v[j] * rstd * *(const f32x4*)(g + c) + *(const f32x4*)(bta + c);
            *(f32x4*)(zr + c) = xo;
            if (H) { const f32x4 sh = *(const f32x4*)(mod_next + (size_t)b * MODW + c), sc = *(const f32x4*)(mod_next + (size_t)b * MODW + D + c);
                const f32x4 h = xo * (sc + 1.0f) + sh; u32x2 w; w.x = pk_h2(h[0], h[1]); w.y = pk_h2(h[2], h[3]); *(u32x2*)(H + (size_t)m * D + c) = w; } }
    }
}

__device__ __forceinline__ void phase_retention_naive(const h16* Q, const h16* K, h16* VO, float* ldsf, int bid, int G) {
    constexpr int TT = 4;
    const int tid_ = opaque_tid(); const int half = tid_ >> 8, tid = tid_ & 255, vi = tid & 63, dq = tid >> 6;
    float* qs = ldsf + half * (3 * TT * 256);
    float* ks = qs + TT * 256;
    float* red = ks + TT * 256;
    for (int vb0 = bid * 2; vb0 < BATCH * RET_HEADS * 8; vb0 += 2 * G) {
        const int blk = vb0 + half, vg = blk & 7, h = (blk >> 3) & 7, b = blk >> 6;
        const float gamma = 1.0f - exp2f(-5.0f - (float)h);
        float S[64];
#pragma unroll
        for (int d = 0; d < 64; ++d) S[d] = 0.f;
        for (int t0 = 0; t0 < SEQ; t0 += TT) {
            __syncthreads();
            for (int i = tid; i < TT * 256; i += 256) { const int tt = i >> 8, d = i & 255; const size_t row = (size_t)(b * SEQ + t0 + tt);
                qs[tt * 256 + d] = (float)Q[row * RET_QK + h * 256 + d]; ks[tt * 256 + d] = (float)K[row * RET_QK + h * 256 + d]; }
            __syncthreads();
            float po[TT];
#pragma unroll
            for (int tt = 0; tt < TT; ++tt) {
                const float v = (float)VO[(size_t)(b * SEQ + t0 + tt) * RET_V + h * 512 + vg * 64 + vi];
                float a = 0.f;
#pragma unroll
                for (int d = 0; d < 64; ++d) { S[d] = gamma * S[d] + ks[tt * 256 + dq * 64 + d] * v; a += qs[tt * 256 + dq * 64 + d] * S[d]; }
                po[tt] = a;
            }
#pragma unroll
            for (int tt = 0; tt < TT; ++tt) red[(dq * TT + tt) * 64 + vi] = po[tt];
            __syncthreads();
            for (int i = tid; i < TT * 64; i += 256) { const int tt = i >> 6, v = i & 63;
                const float o = (red[(0 * TT + tt) * 64 + v] + red[(1 * TT + tt) * 64 + v]) + (red[(2 * TT + tt) * 64 + v] + red[(3 * TT + tt) * 64 + v]);
                VO[(size_t)(b * SEQ + t0 + tt) * RET_V + h * 512 + vg * 64 + v] = (h16)o; }
        }
        __syncthreads();
    }
}


typedef short v4i16 __attribute__((__vector_size__(8)));
__device__ __forceinline__ h16x4 lds_tr_read(LAS unsigned char* p) { const v4i16 v = __builtin_amdgcn_ds_read_tr16_b64_v4i16((LAS v4i16*)p); return __builtin_bit_cast(h16x4, v); }
__device__ __forceinline__ int off_b(int row, int ch) { return 256 * row + 16 * (ch ^ (((row & 3) << 2) | ((row >> 2) & 3))); }
__device__ __forceinline__ int tr_addr16(int lane, int c, int ks, int t) { const int g = lane >> 4, q = (lane & 15) >> 2, p = lane & 3; return off_b(32 * ks + 8 * g + 4 * t + q, 2 * c + (p >> 1)) + 8 * (p & 1); }
__device__ __forceinline__ h16x8 cat8(h16x4 a, h16x4 b) { return __builtin_shufflevector(a, b, 0, 1, 2, 3, 4, 5, 6, 7); }
__device__ __forceinline__ void fill_piece(LAS unsigned char* tile, const h16* g0, size_t pitch_elems, int piece, int lane) {
    const int rr = lane >> 4, cp = lane & 15, row = 4 * piece + rr, ch = cp ^ ((rr << 2) | (piece & 3));
    __builtin_amdgcn_global_load_lds((const unsigned*)(g0 + (size_t)row * pitch_elems + ch * 8), (LAS unsigned*)(tile + piece * 1024), 16, 0, 0);
}
constexpr int R_Q = 0, R_K = 32768, R_V = 65536, R_SC = 81920, SC_PITCH = 144;
__device__ __forceinline__ void phase_retention(const h16* Q, const h16* K, h16* VO, LAS unsigned char* L, int bid, int G) {
    const int tid = opaque_tid(), w = __builtin_amdgcn_readfirstlane(tid >> 6), lane = tid & 63, r = lane & 15, g = lane >> 4;
    for (int item = bid; item < BATCH * RET_HEADS * 4; item += G) {
        const int bh = (item & 7) | ((item >> 5) << 3), vs = (item >> 3) & 3, b = bh >> 3, h = bh & 7;
        const float l2g = log2f(1.0f - exp2f(-5.0f - (float)h));
        const int mt = w >> 1, nt0 = (w & 1) * 2;
        float mk[2][4], qd[4];
#pragma unroll
        for (int t = 0; t < 2; ++t)
#pragma unroll
            for (int i = 0; i < 4; ++i) { const int n = 16 * (nt0 + t) + r, m = 16 * mt + 4 * g + i; mk[t][i] = (n >= m) ? exp2f((float)(n - m) * l2g) : 0.0f; }
#pragma unroll
        for (int nt = 0; nt < 4; ++nt) qd[nt] = exp2f((float)(16 * nt + r + 1) * l2g);
        h16x8 kd[2];
#pragma unroll
        for (int ks = 0; ks < 2; ++ks)
#pragma unroll
            for (int j = 0; j < 8; ++j) kd[ks][j] = (h16)exp2f((float)(63 - (32 * ks + 8 * g + j)) * l2g);
        const float gC = exp2f(64.0f * l2g);
        f32x4 S[16];
#pragma unroll
        for (int dt = 0; dt < 16; ++dt) S[dt] = (f32x4){0.f, 0.f, 0.f, 0.f};
        const h16* Qg = Q + (size_t)b * SEQ * RET_QK + h * 256;
        const h16* Kg = K + (size_t)b * SEQ * RET_QK + h * 256;
        h16* Vg = VO + (size_t)b * SEQ * RET_V + h * 512 + vs * 128;
        for (int c = 0; c < SEQ / 64; ++c) {
            { const int hf = w >> 2, p0 = (w & 3) * 4;
#pragma unroll
                for (int i = 0; i < 4; ++i) { fill_piece(L + R_Q + hf * 16384, Qg + (size_t)c * 64 * RET_QK + hf * 128, RET_QK, p0 + i, lane);
                                              fill_piece(L + R_K + hf * 16384, Kg + (size_t)c * 64 * RET_QK + hf * 128, RET_QK, p0 + i, lane); }
#pragma unroll
                for (int i = 0; i < 2; ++i) fill_piece(L + R_V, Vg + (size_t)c * 64 * RET_V, RET_V, 2 * w + i, lane); }
            asm volatile("s_waitcnt vmcnt(0)" ::: "memory"); __builtin_amdgcn_s_barrier(); asm volatile("" ::: "memory");
            { f32x4 sc[2] = {(f32x4){0.f, 0.f, 0.f, 0.f}, (f32x4){0.f, 0.f, 0.f, 0.f}};
#pragma unroll
                for (int hf = 0; hf < 2; ++hf)
#pragma unroll
                    for (int s = 0; s < 4; ++s) {
                        const h16x8 a = *(const LAS h16x8*)(L + R_K + hf * 16384 + off_b(16 * mt + r, 4 * s + g));
                        const h16x8 b0 = *(const LAS h16x8*)(L + R_Q + hf * 16384 + off_b(16 * nt0 + r, 4 * s + g));
                        const h16x8 b1 = *(const LAS h16x8*)(L + R_Q + hf * 16384 + off_b(16 * (nt0 + 1) + r, 4 * s + g));
                        sc[0] = __builtin_amdgcn_mfma_f32_16x16x32_f16(a, b0, sc[0], 0, 0, 0);
                        sc[1] = __builtin_amdgcn_mfma_f32_16x16x32_f16(a, b1, sc[1], 0, 0, 0); }
#pragma unroll
                for (int t = 0; t < 2; ++t) { u32x2 wv; wv.x = pk_h2(sc[t][0] * mk[t][0], sc[t][1] * mk[t][1]); wv.y = pk_h2(sc[t][2] * mk[t][2], sc[t][3] * mk[t][3]);
                    *(LAS u32x2*)(L + R_SC + (16 * (nt0 + t) + r) * SC_PITCH + 2 * (16 * mt + 4 * g)) = wv; } }
            f32x4 o3[4];
#pragma unroll
            for (int nt = 0; nt < 4; ++nt) o3[nt] = (f32x4){0.f, 0.f, 0.f, 0.f};
#pragma unroll
            for (int s = 0; s < 8; ++s) {
                const f32x4 s0 = S[2 * s], s1 = S[2 * s + 1];
                h16x8 af; af[0] = (h16)s0[0]; af[1] = (h16)s0[1]; af[2] = (h16)s0[2]; af[3] = (h16)s0[3]; af[4] = (h16)s1[0]; af[5] = (h16)s1[1]; af[6] = (h16)s1[2]; af[7] = (h16)s1[3];
                const int hf = s >> 2, ss = s & 3;
#pragma unroll
                for (int nt = 0; nt < 4; ++nt) {
                    const h16x4 lo = *(const LAS h16x4*)(L + R_Q + hf * 16384 + off_b(16 * nt + r, 4 * ss + (g >> 1)) + 8 * (g & 1));
                    const h16x4 hi = *(const LAS h16x4*)(L + R_Q + hf * 16384 + off_b(16 * nt + r, 4 * ss + 2 + (g >> 1)) + 8 * (g & 1));
                    o3[nt] = __builtin_amdgcn_mfma_f32_16x16x32_f16(af, cat8(lo, hi), o3[nt], 0, 0, 0); }
            }
            asm volatile("s_waitcnt lgkmcnt(0)" ::: "memory"); __builtin_amdgcn_s_barrier(); asm volatile("" ::: "memory");
            h16x8 vf[2];
#pragma unroll
            for (int ks = 0; ks < 2; ++ks) vf[ks] = cat8(lds_tr_read(L + R_V + tr_addr16(lane, w, ks, 0)), lds_tr_read(L + R_V + tr_addr16(lane, w, ks, 1)));
#pragma unroll
            for (int nt = 0; nt < 4; ++nt) {
                f32x4 o2 = (f32x4){0.f, 0.f, 0.f, 0.f};
#pragma unroll
                for (int ks = 0; ks < 2; ++ks) { const h16x8 bf = *(const LAS h16x8*)(L + R_SC + (16 * nt + r) * SC_PITCH + 2 * (32 * ks + 8 * g));
                    o2 = __builtin_amdgcn_mfma_f32_16x16x32_f16(vf[ks], bf, o2, 0, 0, 0); }
                const f32x4 o = o2 + o3[nt] * qd[nt];
                u32x2 wv; wv.x = pk_h2(o[0], o[1]); wv.y = pk_h2(o[2], o[3]);
                *(u32x2*)(Vg + (size_t)(c * 64 + 16 * nt + r) * RET_V + 16 * w + 4 * g) = wv; }
            const h16x8 vk0 = vf[0] * kd[0], vk1 = vf[1] * kd[1];
#pragma unroll
            for (int dt = 0; dt < 16; ++dt) {
                const int hf = dt >> 3, c8 = dt & 7;
                const h16x8 a0 = cat8(lds_tr_read(L + R_K + hf * 16384 + tr_addr16(lane, c8, 0, 0)), lds_tr_read(L + R_K + hf * 16384 + tr_addr16(lane, c8, 0, 1)));
                const h16x8 a1 = cat8(lds_tr_read(L + R_K + hf * 16384 + tr_addr16(lane, c8, 1, 0)), lds_tr_read(L + R_K + hf * 16384 + tr_addr16(lane, c8, 1, 1)));
                f32x4 acc = S[dt] * gC;
                acc = __builtin_amdgcn_mfma_f32_16x16x32_f16(a0, vk0, acc, 0, 0, 0);
                acc = __builtin_amdgcn_mfma_f32_16x16x32_f16(a1, vk1, acc, 0, 0, 0);
                S[dt] = acc; }
            asm volatile("s_waitcnt lgkmcnt(0)" ::: "memory"); __builtin_amdgcn_s_barrier(); asm volatile("" ::: "memory");
        }
    }
    asm volatile("s_waitcnt vmcnt(0)" ::: "memory"); __syncthreads();
}

__device__ __forceinline__ void phase_kmean(const h16* K, float* kmean, int bid, int G) {
    const int tid_ = opaque_tid();
    for (int i = bid * NT + tid_; i < BATCH * NBLK * MOBA_W; i += G * NT) {
        const int col = i % MOBA_W, bb = i / MOBA_W;
        float s = 0.f; for (int t = 0; t < MOBA_BLOCK; ++t) s += (float)K[((size_t)bb * MOBA_BLOCK + t) * MOBA_W + col];
        kmean[i] = s * (1.0f / MOBA_BLOCK); }
}
__device__ __forceinline__ void phase_moba_naive(const h16* Q, const h16* K, const h16* V, const h16* Gt, const float* kmean, h16* A, int bid, int G) {
    const int tid_ = opaque_tid(); const int half = tid_ >> 8, tid = tid_ & 255, qi = tid >> 2, part = tid & 3;
    for (int vb0 = bid * 2; vb0 < BATCH * MOBA_HEADS * 32; vb0 += 2 * G) {
        const int blk = vb0 + half, qt = blk & 31, h = (blk >> 5) & 15, b = blk >> 9;
        const int t = qt * 64 + qi, own = t >> 8; const size_t row = (size_t)b * SEQ + t;
        float q[32];
#pragma unroll
        for (int j = 0; j < 32; ++j) q[j] = (float)Q[row * MOBA_W + h * 128 + part * 32 + j];
        float gs[NBLK]; unsigned sel = 0u;
#pragma unroll
        for (int n = 0; n < NBLK; ++n) { float a = 0.f;
#pragma unroll
            for (int j = 0; j < 32; ++j) a += q[j] * kmean[((size_t)(b * NBLK + n)) * MOBA_W + h * 128 + part * 32 + j];
            a += __shfl_xor(a, 1); a += __shfl_xor(a, 2); gs[n] = a; }
#pragma unroll
        for (int r = 0; r < 3; ++r) { int best = -1; float bv = -3e38f;
#pragma unroll
            for (int n = 0; n < NBLK; ++n) if (n < own && !((sel >> n) & 1u) && gs[n] > bv) { bv = gs[n]; best = n; }
            if (best >= 0) sel |= 1u << best; }
        const float scale = 0.08838834764831845f;
        float mrun = -1e30f, lrun = 0.f, acc[32];
#pragma unroll
        for (int j = 0; j < 32; ++j) acc[j] = 0.f;
        for (int n = 0; n <= own; ++n) {
            const bool use = (n == own) || ((sel >> n) & 1u);
            if (!use) continue;
            const int kend = (n == own) ? (t & 255) + 1 : MOBA_BLOCK;
            for (int kk = 0; kk < kend; ++kk) {
                const size_t krow = (size_t)b * SEQ + n * MOBA_BLOCK + kk;
                const h16* kp = K + krow * MOBA_W + h * 128 + part * 32; float s = 0.f;
#pragma unroll
                for (int j = 0; j < 32; ++j) s += q[j] * (float)kp[j];
                s += __shfl_xor(s, 1); s += __shfl_xor(s, 2); s *= scale;
                const float mn = fmaxf(mrun, s), al = __expf(mrun - mn), p = __expf(s - mn);
                lrun = lrun * al + p; mrun = mn;
                const h16* vp = V + krow * MOBA_W + h * 128 + part * 32;
#pragma unroll
                for (int j = 0; j < 32; ++j) acc[j] = acc[j] * al + p * (float)vp[j];
            }
        }
        const float inv = 1.0f / lrun;
#pragma unroll
        for (int j = 0; j < 32; ++j) { const size_t o = row * MOBA_W + h * 128 + part * 32 + j; A[o] = (h16)(acc[j] * inv * silu((float)Gt[o])); }
    }
}


__device__ __forceinline__ int off_v(int row, int ch) { return 256 * row + 16 * (ch ^ (2 * (row & 7))); }
__device__ __forceinline__ void fill_piece_v(LAS unsigned char* tile, const h16* g0, size_t pitch_elems, int piece, int lane) {
    const int rr = lane >> 4, cp = lane & 15, row = 4 * piece + rr, ch = cp ^ (2 * (row & 7));
    __builtin_amdgcn_global_load_lds((const unsigned*)(g0 + (size_t)row * pitch_elems + ch * 8), (LAS unsigned*)(tile + piece * 1024), 16, 0, 0);
}
__device__ __forceinline__ void phase_moba(const h16* Q, const h16* K, const h16* V, const h16* Gt, const float* kmean, h16* A, LAS unsigned char* L, int bid, int G) {
    const int tid = opaque_tid(), w = __builtin_amdgcn_readfirstlane(tid >> 6), lane = tid & 63, r = lane & 15, g = lane >> 4;
    const float NEG_INF = -__builtin_inff();
    for (int vb = bid; vb < BATCH * MOBA_HEADS * 4; vb += G) {
        const int xcd = vb & 7, jj = vb >> 3, pr = jj & 3, bh = xcd + 8 * (jj >> 2), b = bh >> 4, h = bh & 15;
        const h16* Kg = K + (size_t)b * SEQ * MOBA_W + h * 128;
        const h16* Vg = V + (size_t)b * SEQ * MOBA_W + h * 128;
        for (int half = 0; half < 2; ++half) {
            const int qb = half ? 7 - pr : pr;
            const size_t row0 = (size_t)b * SEQ + qb * 256 + 32 * w;
            h16x8 qf[2][4];
#pragma unroll
            for (int qt = 0; qt < 2; ++qt)
#pragma unroll
                for (int s = 0; s < 4; ++s) qf[qt][s] = *(const h16x8*)(Q + (row0 + 16 * qt + r) * MOBA_W + h * 128 + 32 * s + 8 * g);
            unsigned sel[2] = {0u, 0u};
            if (qb > 0) {
                f32x4 gt[2] = {(f32x4){0.f, 0.f, 0.f, 0.f}, (f32x4){0.f, 0.f, 0.f, 0.f}};
#pragma unroll
                for (int s = 0; s < 4; ++s) {
                    h16x8 hi, lo;
                    const float* kp = kmean + ((size_t)(b * NBLK + (r & 7))) * MOBA_W + h * 128 + 32 * s + 8 * g;
                    const f32x4 k0 = *(const f32x4*)kp, k1 = *(const f32x4*)(kp + 4);
#pragma unroll
                    for (int j = 0; j < 8; ++j) { const float kv = (r < 8) ? (j < 4 ? k0[j & 3] : k1[j & 3]) : 0.0f; const h16 hh = (h16)kv; hi[j] = hh; lo[j] = (h16)(kv - (float)hh); }
#pragma unroll
                    for (int qt = 0; qt < 2; ++qt) { gt[qt] = __builtin_amdgcn_mfma_f32_16x16x32_f16(hi, qf[qt][s], gt[qt], 0, 0, 0); gt[qt] = __builtin_amdgcn_mfma_f32_16x16x32_f16(lo, qf[qt][s], gt[qt], 0, 0, 0); }
                }
#pragma unroll
                for (int qt = 0; qt < 2; ++qt) {
                    float gs[8];
#pragma unroll
                    for (int i = 0; i < 4; ++i) { gs[i] = __shfl(gt[qt][i], r); gs[4 + i] = __shfl(gt[qt][i], r + 16); }
                    unsigned sm = 0u;
#pragma unroll
                    for (int rr = 0; rr < 3; ++rr) { int best = -1; float bv = -3e38f;
#pragma unroll
                        for (int n = 0; n < NBLK; ++n) if (n < qb && !((sm >> n) & 1u) && gs[n] > bv) { bv = gs[n]; best = n; }
                        if (best >= 0) sm |= 1u << best; }
                    sel[qt] = sm;
                }
            }
            f32x4 o[8][2];
#pragma unroll
            for (int dt = 0; dt < 8; ++dt) { o[dt][0] = (f32x4){0.f, 0.f, 0.f, 0.f}; o[dt][1] = (f32x4){0.f, 0.f, 0.f, 0.f}; }
            float mrun[2] = {NEG_INF, NEG_INF}, lrun[2] = {0.f, 0.f};
            const int ntiles = 4 * (qb + 1);
#define MOBA_FILL(it_, buf_) do { const int n_ = (it_) < 4 ? qb : (((it_) - 4) >> 2); const size_t k0_ = (size_t)n_ * 256 + 64 * ((it_) & 3); \
                LAS unsigned char* kb_ = L + (buf_) * 32768; \
                fill_piece(kb_, Kg + k0_ * MOBA_W, MOBA_W, 2 * w, lane); fill_piece(kb_, Kg + k0_ * MOBA_W, MOBA_W, 2 * w + 1, lane); \
                fill_piece_v(kb_ + 16384, Vg + k0_ * MOBA_W, MOBA_W, 2 * w, lane); fill_piece_v(kb_ + 16384, Vg + k0_ * MOBA_W, MOBA_W, 2 * w + 1, lane); } while (0)
            MOBA_FILL(0, 0);
            for (int it = 0; it < ntiles; ++it) {
                asm volatile("s_waitcnt vmcnt(0)" ::: "memory"); __builtin_amdgcn_s_barrier(); asm volatile("" ::: "memory");
                if (it + 1 < ntiles) MOBA_FILL(it + 1, (it + 1) & 1);
                const bool own = it < 4; const int n = own ? qb : ((it - 4) >> 2), t = it & 3;
                const bool need = own ? (t <= (w >> 1)) : (__any((int)(((sel[0] | sel[1]) >> n) & 1u)) != 0);
                if (need) {
                    LAS unsigned char* Kb = L + (it & 1) * 32768; LAS unsigned char* Vb = Kb + 16384;
                    f32x4 st[4][2];
#pragma unroll
                    for (int kt = 0; kt < 4; ++kt) { st[kt][0] = (f32x4){0.f, 0.f, 0.f, 0.f}; st[kt][1] = (f32x4){0.f, 0.f, 0.f, 0.f}; }
#pragma unroll
                    for (int s = 0; s < 4; ++s)
#pragma unroll
                        for (int kt = 0; kt < 4; ++kt) { const h16x8 a = *(const LAS h16x8*)(Kb + off_b(16 * kt + r, 4 * s + g));
                            st[kt][0] = __builtin_amdgcn_mfma_f32_16x16x32_f16(a, qf[0][s], st[kt][0], 0, 0, 0);
                            st[kt][1] = __builtin_amdgcn_mfma_f32_16x16x32_f16(a, qf[1][s], st[kt][1], 0, 0, 0); }
                    const float cs = 0.08838834764831845f * 1.4426950408889634f;
                    const bool diag = own && (t == (w >> 1));
                    h16x8 pf[2][2];
#pragma unroll
                    for (int qt = 0; qt < 2; ++qt) {
                        const bool rowsel = own || (((sel[qt] >> n) & 1u) != 0u);
                        const int qpos = 32 * w + 16 * qt + r;
                        float mx = NEG_INF;
#pragma unroll
                        for (int kt = 0; kt < 4; ++kt)
#pragma unroll
                            for (int i = 0; i < 4; ++i) { const int kpos = 64 * t + 16 * kt + 4 * g + i; const bool ok = rowsel && (!diag || kpos <= qpos);
                                const float sv = ok ? st[kt][qt][i] * cs : NEG_INF; st[kt][qt][i] = sv; mx = fmaxf(mx, sv); }
                        mx = fmaxf(mx, __shfl_xor(mx, 16)); mx = fmaxf(mx, __shfl_xor(mx, 32));
                        const float mn = fmaxf(mrun[qt], mx), al = exp2f(mrun[qt] - mn);
                        float sum = 0.f;
#pragma unroll
                        for (int kt = 0; kt < 4; ++kt)
#pragma unroll
                            for (int i = 0; i < 4; ++i) { const float p = exp2f(st[kt][qt][i] - mn); st[kt][qt][i] = p; sum += p; }
                        sum += __shfl_xor(sum, 16); sum += __shfl_xor(sum, 32);
                        lrun[qt] = lrun[qt] * al + sum; mrun[qt] = mn;
#pragma unroll
                        for (int dt = 0; dt < 8; ++dt) o[dt][qt] = o[dt][qt] * al;
#pragma unroll
                        for (int ks = 0; ks < 2; ++ks) { const f32x4 p0 = st[2 * ks][qt], p1 = st[2 * ks + 1][qt]; h16x8 f;
                            f[0] = (h16)p0[0]; f[1] = (h16)p0[1]; f[2] = (h16)p0[2]; f[3] = (h16)p0[3]; f[4] = (h16)p1[0]; f[5] = (h16)p1[1]; f[6] = (h16)p1[2]; f[7] = (h16)p1[3]; pf[ks][qt] = f; }
                    }
                    const int q4 = (lane & 15) >> 2, p4 = lane & 3;
#pragma unroll
                    for (int dt = 0; dt < 8; ++dt)
#pragma unroll
                        for (int ks = 0; ks < 2; ++ks) {
                            const h16x8 a = cat8(lds_tr_read(Vb + off_v(32 * ks + 4 * g + q4, 2 * dt + (p4 >> 1)) + 8 * (p4 & 1)),
                                                 lds_tr_read(Vb + off_v(32 * ks + 16 + 4 * g + q4, 2 * dt + (p4 >> 1)) + 8 * (p4 & 1)));
                            o[dt][0] = __builtin_amdgcn_mfma_f32_16x16x32_f16(a, pf[ks][0], o[dt][0], 0, 0, 0);
                            o[dt][1] = __builtin_amdgcn_mfma_f32_16x16x32_f16(a, pf[ks][1], o[dt][1], 0, 0, 0); }
                }
            }
#undef MOBA_FILL
#pragma unroll
            for (int qt = 0; qt < 2; ++qt) { const float inv = 1.0f / lrun[qt]; const size_t rowoff = (row0 + 16 * qt + r) * MOBA_W + h * 128 + 4 * g;
#pragma unroll
                for (int dt = 0; dt < 8; ++dt) { const h16x4 gv = *(const h16x4*)(Gt + rowoff + 16 * dt); const f32x4 ov = o[dt][qt] * inv;
                    u32x2 wv; wv.x = pk_h2(ov[0] * silu((float)gv[0]), ov[1] * silu((float)gv[1])); wv.y = pk_h2(ov[2] * silu((float)gv[2]), ov[3] * silu((float)gv[3]));
                    *(u32x2*)(A + rowoff + 16 * dt) = wv; } }
        }
    }
    asm volatile("s_waitcnt vmcnt(0)" ::: "memory"); __syncthreads();
}

struct Args { const void* in[11]; float* out; unsigned char* ws; int ph_lo, ph_hi; };
constexpr int NPHASE = 12;
__global__ void __launch_bounds__(NT, 2) mk_fwd(Args a) {
    extern __shared__ __attribute__((aligned(16))) unsigned char lds[];
    LAS unsigned char* L = (LAS unsigned char*)lds;
    float* ldsf = (float*)lds;
    const int tid = threadIdx.x, bid = blockIdx.x, G = gridDim.x;
    volatile LAS unsigned* MISC = (volatile LAS unsigned*)(L + MISC_OFF);
    if (tid < 32) MISC[tid] = 0u;
    __syncthreads();
    unsigned char* ws = a.ws;
    Ptrs P;
    P.x = (const float*)a.in[0]; P.c = (const float*)a.in[1]; P.pos = (const int*)a.in[2];
    P.ret_w_in = (const float*)a.in[3]; P.ret_w_out = (const float*)a.in[4]; P.moba_w_in = (const float*)a.in[5]; P.moba_w_out = (const float*)a.in[6];
    P.w_ada = (const float*)a.in[7]; P.b_ada = (const float*)a.in[8]; P.ln_g = (const float*)a.in[9]; P.ln_b = (const float*)a.in[10];
    P.out = a.out; P.MOD = (float*)(ws + WS_MOD); P.PART = (float*)(ws + WS_PART); P.KMEAN = (float*)(ws + WS_KMEAN);
    P.RCS0 = (float2*)(ws + WS_RCS0); P.RCS1 = (float2*)(ws + WS_RCS1);
    P.W0IN = (h16*)(ws + WS_W0IN); P.W0OUT = (h16*)(ws + WS_W0OUT); P.W1IN = (h16*)(ws + WS_W1IN); P.W1OUT = (h16*)(ws + WS_W1OUT);
    P.Q0 = (h16*)(ws + WS_Q0); P.K0 = (h16*)(ws + WS_K0); P.V0 = (h16*)(ws + WS_V0); P.G0 = (h16*)(ws + WS_G0); P.H0 = (h16*)a.out;
    P.H1 = (h16*)(ws + WS_H1); P.Q1 = (h16*)(ws + WS_Q1); P.K1 = (h16*)(ws + WS_K1); P.V1 = (h16*)(ws + WS_V1); P.G1 = (h16*)(ws + WS_G1); P.A1 = (h16*)(ws + WS_A1);
    XcdBarrier bar = xcd_barrier_post((unsigned*)(ws + WS_CTL) + CW_BAR, MISC + 8);
    const int lo = a.ph_lo, hi = a.ph_hi;
#define IN(k) (lo <= (k) && (k) < hi)
#define SEAM(k) do { if (IN(k) && IN((k) + 1)) xcd_barrier(bar); } while (0)
    if (IN(0)) phase0(P, ldsf, bid, G);
    SEAM(0);
    if (IN(1)) phase1(P, ldsf, bid, G);
    SEAM(1);
    if (IN(2)) { pg8::Gemm g{P.H0, P.W0IN, M, RET_IN, D, 0}; pg8::StaticOrder S; S.init(M, RET_IN, G, bid); EpiRet E{P.Q0, P.K0, P.V0, P.G0, P.RCS0};
        pg8::gemm_phase<EpiRet, pg8::StaticOrder, true, true>(L, g, S, E); }
    SEAM(2);
    if (IN(3)) phase_retention(P.Q0, P.K0, P.V0, L, bid, G);
    SEAM(3);
    if (IN(4)) phase_norm_gate(P.V0, P.G0, P.G0, bid, G);
    SEAM(4);
    if (IN(5)) { pg8::Gemm g{P.G0, P.W0OUT, M, D, RET_V, 0}; pg8::StaticOrder S; S.init(M, D, G, bid); EpiRes E{P.x, P.out, P.MOD + 2 * D};
        pg8::gemm_phase<EpiRes, pg8::StaticOrder, true, true>(L, g, S, E); }
    SEAM(5);
    if (IN(6)) phase_layernorm(P.out, P.ln_g, P.ln_b, P.MOD + 8 * MODW, P.H1, bid, G);
    SEAM(6);
    if (IN(7)) { pg8::Gemm g{P.H1, P.W1IN, M, MOBA_IN, D, 0}; pg8::StaticOrder S; S.init(M, MOBA_IN, G, bid); EpiMoba E{P.Q1, P.K1, P.V1, P.G1, P.RCS1};
        pg8::gemm_phase<EpiMoba, pg8::StaticOrder, true, true>(L, g, S, E); }
    SEAM(7);
    if (IN(8)) phase_kmean(P.K1, P.KMEAN, bid, G);
    SEAM(8);
    if (IN(9)) phase_moba(P.Q1, P.K1, P.V1, P.G1, P.KMEAN, P.A1, L, bid, G);
    SEAM(9);
    if (IN(10)) { pg8::Gemm g{P.A1, P.W1OUT, M, D, MOBA_W, 0}; pg8::StaticOrder S; S.init(M, D, G, bid); EpiRes E{P.out, P.out, P.MOD + 8 * MODW + 2 * D};
        pg8::gemm_phase<EpiRes, pg8::StaticOrder, true, true>(L, g, S, E); }
    SEAM(10);
    if (IN(11)) phase_layernorm(P.out, P.ln_g + D, P.ln_b + D, nullptr, nullptr, bid, G);
#undef IN
#undef SEAM
}

#ifndef MK_N_LAUNCHES
#define MK_N_LAUNCHES 1
#endif
extern "C" void kernel_launch(void* const* d_in, const int* in_sizes, int n_in, void* d_out, int out_size, void* d_ws, size_t ws_size, hipStream_t stream) {
    static int grid = 0;
    if (grid == 0) {
        if (n_in != 11 || out_size != M * D || ws_size < WS_END) { fprintf(stderr, "kernel_launch: unexpected shapes (n_in %d out %d ws %zu)\n", n_in, out_size, ws_size); grid = -1; return; }
        int dev = 0, cus = 0, per_cu = 0;
        if (hipGetDevice(&dev) != hipSuccess || hipDeviceGetAttribute(&cus, hipDeviceAttributeMultiprocessorCount, dev) != hipSuccess) { grid = -1; return; }
        if (hipFuncSetAttribute((const void*)mk_fwd, hipFuncAttributeMaxDynamicSharedMemorySize, LDS_BYTES) != hipSuccess) { fprintf(stderr, "kernel_launch: hipFuncSetAttribute failed\n"); grid = -1; return; }
        if (hipOccupancyMaxActiveBlocksPerMultiprocessor(&per_cu, (const void*)mk_fwd, NT, LDS_BYTES) != hipSuccess || per_cu < 1) { fprintf(stderr, "kernel_launch: occupancy query says %d\n", per_cu); (void)hipGetLastError(); grid = -1; return; }
        grid = cus;
    }
    if (grid < 0) return;
    if (hipMemsetAsync((char*)d_ws + WS_CTL, 0, CTL_ZERO_BYTES, stream) != hipSuccess) return;
    Args a{};
    for (int i = 0; i < 11; ++i) a.in[i] = d_in[i];
    a.out = (float*)d_out; a.ws = (unsigned char*)d_ws;
    if (MK_N_LAUNCHES == 1) { a.ph_lo = 0; a.ph_hi = NPHASE; hipLaunchKernelGGL(mk_fwd, dim3(grid), dim3(NT), LDS_BYTES, stream, a); }
    else for (int p = 0; p < NPHASE; ++p) { a.ph_lo = p; a.ph_hi = p + 1; hipLaunchKernelGGL(mk_fwd, dim3(grid), dim3(NT), LDS_BYTES, stream, a); }
}
```

```cpp
#include <hip/hip_runtime.h>
#include <cstdio>
#include <cstdint>
#include <cmath>

typedef _Float16 h16;
typedef _Float16 h16x8 __attribute__((ext_vector_type(8)));
typedef _Float16 h16x4 __attribute__((ext_vector_type(4)));
typedef _Float16 h16x2 __attribute__((ext_vector_type(2)));
typedef float f32x4 __attribute__((ext_vector_type(4)));
typedef float f32x2 __attribute__((ext_vector_type(2)));
typedef unsigned u32x4 __attribute__((ext_vector_type(4)));
typedef unsigned u32x2 __attribute__((ext_vector_type(2)));
#define LAS __attribute__((address_space(3)))

constexpr int D = 2048, BATCH = 8, SEQ = 2048, M = BATCH * SEQ;
constexpr int RET_HEADS = 8, RET_DK = 256, RET_DV = 512, RET_QK = 2048, RET_V = 4096, RET_IN = 12288;
constexpr int MOBA_HEADS = 16, MOBA_DH = 128, MOBA_W = 2048, MOBA_IN = 8192, MOBA_BLOCK = 256, NBLK = 8;
constexpr float ALPHA = 1.4142135623730951f;
constexpr float LN_EPS = 1e-5f, GN_EPS = 1e-5f;
constexpr int MODW = 3 * D;
constexpr int KSPLIT = 4;

constexpr size_t MiB = 1u << 20;
constexpr size_t WS_CTL = 0;
constexpr size_t WS_MOD = 1 * MiB;
constexpr size_t WS_KMEAN = WS_MOD + 512 * 1024;
constexpr size_t WS_RCS1 = 2 * MiB;
constexpr size_t WS_W0IN = 4 * MiB;
constexpr size_t WS_W0OUT = 52 * MiB;
constexpr size_t WS_W1IN = 68 * MiB;
constexpr size_t WS_W1OUT = 100 * MiB;
constexpr size_t WS_ACT = 108 * MiB;
constexpr size_t WS_Q0 = WS_ACT, WS_K0 = WS_ACT + 64 * MiB, WS_V0 = WS_ACT + 128 * MiB, WS_G0 = WS_ACT + 256 * MiB;
constexpr size_t WS_H1 = WS_ACT, WS_Q1 = WS_ACT + 64 * MiB, WS_K1 = WS_ACT + 128 * MiB, WS_V1 = WS_ACT + 192 * MiB, WS_G1 = WS_ACT + 256 * MiB, WS_A1 = WS_ACT + 320 * MiB;
constexpr size_t WS_RCS0 = 492 * MiB;
constexpr size_t WS_PART = 508 * MiB;
constexpr size_t WS_END = 512 * MiB;

__device__ __forceinline__ int opaque_tid() { int t = threadIdx.x; asm volatile("" : "+v"(t)); return t; }
__device__ __forceinline__ unsigned pk_h2(float lo, float hi) { h16x2 h = {(h16)lo, (h16)hi}; return __builtin_bit_cast(unsigned, h); }
__device__ __forceinline__ float wave_sum(float v) {
#pragma unroll
    for (int o = 1; o < 64; o <<= 1) v += __shfl_xor(v, o);
    return v;
}
__device__ __forceinline__ float silu(float g) { return g / (1.0f + __expf(-g)); }

namespace pg8 {
typedef __bf16 bf16x8_t __attribute__((ext_vector_type(8)));
constexpr int BM = 256, BK = 64, HALF = 128, HTB = HALF * BK * 2, STAGE_BYTES = 8 * HTB, NXCD = 8, WGM = 8;
__host__ __device__ __forceinline__ int lds_byte(int r, int c) { const int st = (r >> 4) * 2 + (c >> 5), rr = r & 15, cc = c & 31, ob = rr * 64 + cc * 2; return st * 1024 + (ob ^ (((ob >> 9) & 1) << 5)); }
__host__ __device__ __forceinline__ void stage_rc(int b, int& R, int& C) { const int st = b / 1024, sb = b % 1024, swz = sb ^ (((sb >> 9) & 1) << 5); R = (st >> 1) * 16 + swz / 64; C = (st & 1) * 32 + (swz % 64) / 2; }
__host__ __device__ __forceinline__ int perm32(int rho) { const int n = rho >> 4, i = rho & 15; return 8 * (i >> 2) + 4 * n + (i & 3); }
struct Unit { int pm, pn; };
struct Gemm { const h16* A; const h16* Bt; int M, N, K, pad; };
struct StaticOrder {
    int nM, nN, nwg, G, c;
    __host__ __device__ void init(int M_, int N_, int G_, int c_) { nM = M_ / BM; nN = N_ / BM; nwg = nM * nN; G = G_; c = c_; }
    __host__ __device__ bool next(int i, Unit& u) const {
        const long L = (long)i * G + c; if (L >= nwg) return false;
        int wgid = (int)L; { const int q = nwg / NXCD, r = nwg % NXCD, xcd = wgid % NXCD, off = wgid / NXCD; wgid = (xcd < r ? xcd * (q + 1) : r * (q + 1) + (xcd - r) * q) + off; }
        const int nig = WGM * nN, gid = wgid / nig, fm = gid * WGM, gsz = (nM - fm) < WGM ? (nM - fm) : WGM;
        u.pm = fm + ((wgid % nig) % gsz); u.pn = (wgid % nig) / gsz; return true;
    }
    __device__ __forceinline__ void a_ready(const Unit&) const {}
    __device__ __forceinline__ void done(const Unit&) const {}
};

struct FixedOrder : StaticOrder {
    __host__ __device__ bool next(int i, Unit& u) const { Unit t; const bool ok = StaticOrder::next(i, t); u.pm = 0; u.pn = 0; return ok; }
};
template <class Epi, class Sched, bool ALIGN_EPI = false, bool SP2 = false, bool USE_BF16 = false>
__device__ __forceinline__ void gemm_phase(LAS unsigned char* lds, const Gemm g, const Sched& S, const Epi& E) {
    const int tid = opaque_tid(), wid = __builtin_amdgcn_readfirstlane(tid >> 6), lane = tid & 63, wr = wid >> 2, wc = wid & 3, fr = lane & 15, fq = lane >> 4;
    const int K = g.K, nt = K / BK;
    unsigned voffA, voffB;
    { int R, C; stage_rc(tid * 16, R, C); const int Rb = Epi::PERM ? ((R & ~31) + perm32(R & 31)) : R;
        voffA = (unsigned)(R * K + C) * 2u; voffB = (unsigned)(Rb * K + C) * 2u; }
    const size_t pstep = (size_t)64 * K * 2;
    const size_t kstep = (size_t)(BK * 2);
    const size_t hstep = (size_t)HALF * K * 2;
    const size_t tstep = 2 * hstep;
    const unsigned ldsw = (unsigned)wid * 1024u;
    const int aoff = lds_byte(wr * 64 + fr, fq * 8), boff = lds_byte(wc * 32 + fr, fq * 8);
#define PG8_SA(b, h) (((b) * 2 + (h)) * HTB)
#define PG8_SB(b, h) ((4 + (b) * 2 + (h)) * HTB)
#define PG8_STAGE(bufoff, gbase, voff) do { _Pragma("unroll") for (int _i = 0; _i < 2; ++_i) \
        __builtin_amdgcn_global_load_lds((const unsigned*)((const char*)(gbase) + _i * pstep + (voff)), (LAS unsigned*)(lds + (bufoff) + ldsw + _i * 8192), 16, 0, 0); } while (0)
#define PG8_LDA(dst, b, h) do { _Pragma("unroll") for (int m = 0; m < 4; ++m) _Pragma("unroll") for (int k = 0; k < 2; ++k) dst[m][k] = *(const LAS h16x8*)(lds + PG8_SA(b, h) + aoff + m * 2048 + k * 1024); } while (0)
#define PG8_LDB(dst, b, h) do { _Pragma("unroll") for (int n = 0; n < 2; ++n) _Pragma("unroll") for (int k = 0; k < 2; ++k) dst[n][k] = *(const LAS h16x8*)(lds + PG8_SB(b, h) + boff + n * 2048 + k * 1024); } while (0)
#define PG8_MMA(ai, bj, At, Bt) do { __builtin_amdgcn_s_setprio(1); _Pragma("unroll") for (int m = 0; m < 4; ++m) _Pragma("unroll") for (int n = 0; n < 2; ++n) _Pragma("unroll") for (int k = 0; k < 2; ++k) \
        acc[ai][bj][m][n] = USE_BF16 ? __builtin_amdgcn_mfma_f32_16x16x32_bf16(__builtin_bit_cast(bf16x8_t, Bt[n][k]), __builtin_bit_cast(bf16x8_t, At[m][k]), acc[ai][bj][m][n], 0, 0, 0) : __builtin_amdgcn_mfma_f32_16x16x32_f16(Bt[n][k], At[m][k], acc[ai][bj][m][n], 0, 0, 0); __builtin_amdgcn_s_setprio(0); } while (0)
#define PG8_WAIT_V(n) asm volatile("s_waitcnt vmcnt(" #n ")" ::: "memory")
#define PG8_WAIT_L(n) asm volatile("s_waitcnt lgkmcnt(" #n ")" ::: "memory")
#define PG8_BAR __builtin_amdgcn_s_barrier()
#define PG8_SCHED __builtin_amdgcn_sched_barrier(0)
    Unit cur, nxt; int ui = 0;
    if (!S.next(0, cur)) return;
    f32x4 acc[2][2][4][2];
#pragma unroll
    for (int a = 0; a < 2; ++a)
#pragma unroll
        for (int b = 0; b < 2; ++b)
#pragma unroll
            for (int m = 0; m < 4; ++m)
#pragma unroll
                for (int n = 0; n < 2; ++n) acc[a][b][m][n] = (f32x4){0.f, 0.f, 0.f, 0.f};
    h16x8 At[4][2], B0[2][2], B1[2][2];
    const char* cA = (const char*)g.A + (size_t)cur.pm * tstep; const char* cB = (const char*)g.Bt + (size_t)cur.pn * tstep;
    S.a_ready(cur);
    if constexpr (SP2) {
        PG8_STAGE(PG8_SB(0, 0), cB, voffB); PG8_STAGE(PG8_SB(0, 1), cB + hstep, voffB); PG8_STAGE(PG8_SA(0, 0), cA, voffA); PG8_STAGE(PG8_SA(0, 1), cA + hstep, voffA);
        if (wr == 1) PG8_BAR;
        PG8_WAIT_V(2); PG8_BAR;
        PG8_STAGE(PG8_SB(1, 0), cB + kstep, voffB); PG8_STAGE(PG8_SA(1, 0), cA + kstep, voffA); PG8_STAGE(PG8_SB(1, 1), cB + hstep + kstep, voffB);
        PG8_WAIT_V(6); PG8_BAR;
    } else {
        PG8_STAGE(PG8_SB(0, 0), cB, voffB); PG8_STAGE(PG8_SA(0, 0), cA, voffA); PG8_STAGE(PG8_SB(0, 1), cB + hstep, voffB); PG8_STAGE(PG8_SA(0, 1), cA + hstep, voffA);
        if (wr == 1) PG8_BAR;
        PG8_WAIT_V(4); PG8_BAR;
        PG8_STAGE(PG8_SB(1, 0), cB + kstep, voffB); PG8_STAGE(PG8_SA(1, 0), cA + kstep, voffA); PG8_STAGE(PG8_SB(1, 1), cB + hstep + kstep, voffB);
        PG8_WAIT_V(6); PG8_BAR;
    }
    for (;;) {
        const bool has_next = S.next(ui + 1, nxt);
        const char* nA = has_next ? (const char*)g.A + (size_t)nxt.pm * tstep : cA; const char* nB = has_next ? (const char*)g.Bt + (size_t)nxt.pn * tstep : cB;
        for (int t = 0; t < nt; t += 2) {
            const bool last = (t == nt - 2);
            const char* a1 = cA + (size_t)(t + 1) * kstep;
            const char* a2 = last ? nA : cA + (size_t)(t + 2) * kstep; const char* b2 = last ? nB : cB + (size_t)(t + 2) * kstep;
            const char* a3 = a2 + kstep; const char* b3 = b2 + kstep;
            if (last && has_next) S.a_ready(nxt);
            if constexpr (SP2) {
            PG8_LDB(B0, 0, 0); PG8_LDB(B1, 0, 1); PG8_SCHED; PG8_LDA(At, 0, 0); PG8_STAGE(PG8_SA(1, 1), a1 + hstep, voffA);
            PG8_WAIT_V(8); PG8_WAIT_L(0); PG8_BAR; PG8_MMA(0, 0, At, B0); PG8_MMA(0, 1, At, B1); PG8_BAR; PG8_SCHED;
            PG8_LDA(At, 0, 1); PG8_STAGE(PG8_SB(0, 0), b2, voffB); PG8_STAGE(PG8_SB(0, 1), b2 + hstep, voffB); PG8_STAGE(PG8_SA(0, 0), a2, voffA);
            PG8_WAIT_V(8); PG8_WAIT_L(0); PG8_BAR; PG8_MMA(1, 0, At, B0); PG8_MMA(1, 1, At, B1); PG8_BAR; PG8_SCHED;
            PG8_LDB(B0, 1, 0); PG8_LDB(B1, 1, 1); PG8_SCHED; PG8_LDA(At, 1, 0); PG8_STAGE(PG8_SA(0, 1), a2 + hstep, voffA);
            PG8_WAIT_V(8); PG8_WAIT_L(0); PG8_BAR; PG8_MMA(0, 0, At, B0); PG8_MMA(0, 1, At, B1); PG8_BAR; PG8_SCHED;
            PG8_LDA(At, 1, 1); PG8_STAGE(PG8_SB(1, 0), b3, voffB); PG8_STAGE(PG8_SB(1, 1), b3 + hstep, voffB); PG8_STAGE(PG8_SA(1, 0), a3, voffA);
            PG8_WAIT_V(8); PG8_WAIT_L(0); PG8_BAR; PG8_MMA(1, 0, At, B0); PG8_MMA(1, 1, At, B1); PG8_BAR; PG8_SCHED;
            } else {
            PG8_LDB(B0, 0, 0); PG8_SCHED; PG8_LDA(At, 0, 0); PG8_STAGE(PG8_SA(1, 1), a1 + hstep, voffA);
            PG8_WAIT_L(8); PG8_BAR; PG8_WAIT_L(0); PG8_MMA(0, 0, At, B0); PG8_BAR; PG8_SCHED;
            PG8_LDB(B1, 0, 1); PG8_STAGE(PG8_SB(0, 0), b2, voffB);
            PG8_BAR; PG8_WAIT_L(0); PG8_MMA(0, 1, At, B1); PG8_BAR;
            PG8_LDA(At, 0, 1); PG8_STAGE(PG8_SA(0, 0), a2, voffA);
            PG8_BAR; PG8_WAIT_L(0); PG8_MMA(1, 0, At, B0); PG8_BAR; PG8_SCHED;
            PG8_STAGE(PG8_SB(0, 1), b2 + hstep, voffB);
            PG8_WAIT_V(6); PG8_BAR; PG8_MMA(1, 1, At, B1); PG8_BAR;
            PG8_LDB(B0, 1, 0); PG8_SCHED; PG8_LDA(At, 1, 0); PG8_STAGE(PG8_SA(0, 1), a2 + hstep, voffA);
            PG8_WAIT_L(8); PG8_BAR; PG8_WAIT_L(0); PG8_MMA(0, 0, At, B0); PG8_BAR; PG8_SCHED;
            PG8_LDB(B1, 1, 1); PG8_STAGE(PG8_SB(1, 0), b3, voffB);
            PG8_BAR; PG8_WAIT_L(0); PG8_MMA(0, 1, At, B1); PG8_BAR;
            PG8_LDA(At, 1, 1); PG8_STAGE(PG8_SA(1, 0), a3, voffA);
            PG8_BAR; PG8_WAIT_L(0); PG8_MMA(1, 0, At, B0); PG8_BAR; PG8_SCHED;
            PG8_STAGE(PG8_SB(1, 1), b3 + hstep, voffB);
            PG8_WAIT_V(6); PG8_BAR; PG8_MMA(1, 1, At, B1); PG8_BAR;
            }
        }
        if constexpr (ALIGN_EPI) { if (wr == 0) PG8_BAR; }
        if constexpr (!Epi::AFTER_DRAIN) { E(acc, cur, wr, wc, fr, fq); S.done(cur); }
        if (!has_next) break;
#pragma unroll
        for (int a = 0; a < 2; ++a)
#pragma unroll
            for (int b = 0; b < 2; ++b)
#pragma unroll
                for (int m = 0; m < 4; ++m)
#pragma unroll
                    for (int n = 0; n < 2; ++n) acc[a][b][m][n] = (f32x4){0.f, 0.f, 0.f, 0.f};
        cur = nxt; cA = nA; cB = nB; ++ui;
        if constexpr (ALIGN_EPI) { if (wr == 1) PG8_BAR; }
    }
    PG8_WAIT_V(0);
    if constexpr (!ALIGN_EPI) { if (wr == 0) PG8_BAR; }
    PG8_BAR;
#undef PG8_SA
#undef PG8_SB
#undef PG8_STAGE
#undef PG8_LDA
#undef PG8_LDB
#undef PG8_MMA
#undef PG8_WAIT_V
#undef PG8_WAIT_L
#undef PG8_BAR
#undef PG8_SCHED
}
}

struct EpiRet {
    static constexpr bool PERM = true, AFTER_DRAIN = false;
    h16 *Q, *K, *V, *G; const int* pos;
    __device__ __forceinline__ void operator()(const f32x4 (&acc)[2][2][4][2], const pg8::Unit& u, int wr, int wc, int fr, int fq) const {
        const int row0 = u.pm * 256 + wr * 64 + fr;
        if (u.pn < 16) {
            h16* base = (u.pn < 8) ? Q + u.pn * 256 : K + (u.pn - 8) * 256; const float sc = (u.pn < 8) ? 1.0f : 0.0625f;
            const int d0 = wc * 32 + 8 * fq;
            float pf_[8];
#pragma unroll
            for (int ai = 0; ai < 2; ++ai)
#pragma unroll
                for (int m = 0; m < 4; ++m) pf_[ai * 4 + m] = (float)pos[row0 + ai * 128 + m * 16];
            float irev[8];
#pragma unroll
            for (int q = 0; q < 8; ++q) irev[q] = __builtin_amdgcn_exp2f(-(float)(d0 + q) * (2.0f / 256.0f * 13.287712379549449f)) * 0.15915494309189535f;
#pragma unroll
            for (int ai = 0; ai < 2; ++ai)
#pragma unroll
                for (int m = 0; m < 4; ++m) {
                    const int row = row0 + ai * 128 + m * 16; const float pv = pf_[ai * 4 + m];
                    float o1[8], o2[8];
#pragma unroll
                    for (int n = 0; n < 2; ++n) { const f32x4 x1 = acc[ai][0][m][n], x2 = acc[ai][1][m][n];
#pragma unroll
                        for (int j = 0; j < 4; ++j) { const float fr_ = __builtin_amdgcn_fractf(pv * irev[4 * n + j]); const float cc = __builtin_amdgcn_cosf(fr_) * sc, ss = __builtin_amdgcn_sinf(fr_) * sc;
                            o1[4 * n + j] = x1[j] * cc - x2[j] * ss; o2[4 * n + j] = x2[j] * cc + x1[j] * ss; } }
                    u32x4 w1, w2; w1.x = pk_h2(o1[0], o1[1]); w1.y = pk_h2(o1[2], o1[3]); w1.z = pk_h2(o1[4], o1[5]); w1.w = pk_h2(o1[6], o1[7]);
                    w2.x = pk_h2(o2[0], o2[1]); w2.y = pk_h2(o2[2], o2[3]); w2.z = pk_h2(o2[4], o2[5]); w2.w = pk_h2(o2[6], o2[7]);
                    h16* rp = base + (size_t)row * RET_QK + d0;
                    *(u32x4*)rp = w1; *(u32x4*)(rp + 128) = w2;
                }
        } else {
            h16* base = (u.pn < 32) ? V + (u.pn - 16) * 256 : G + (u.pn - 32) * 256;
            const int c0 = wc * 32 + 8 * fq;
#pragma unroll
            for (int ai = 0; ai < 2; ++ai)
#pragma unroll
                for (int m = 0; m < 4; ++m) {
                    h16* rp = base + (size_t)(row0 + ai * 128 + m * 16) * RET_V + c0;
#pragma unroll
                    for (int bj = 0; bj < 2; ++bj) { const f32x4 v0 = acc[ai][bj][m][0], v1 = acc[ai][bj][m][1];
                        u32x4 w; w.x = pk_h2(v0[0], v0[1]); w.y = pk_h2(v0[2], v0[3]); w.z = pk_h2(v1[0], v1[1]); w.w = pk_h2(v1[2], v1[3]);
                        *(u32x4*)(rp + bj * 128) = w; }
                }
        }
    }
};
struct EpiMoba {
    static constexpr bool PERM = true, AFTER_DRAIN = false;
    h16 *Q, *K, *V, *G; const int* pos;
    __device__ __forceinline__ void operator()(const f32x4 (&acc)[2][2][4][2], const pg8::Unit& u, int wr, int wc, int fr, int fq) const {
        const int row0 = u.pm * 256 + wr * 64 + fr; const int sel = u.pn >> 3;
        h16* base = (sel == 0 ? Q : sel == 1 ? K : sel == 2 ? V : G) + (u.pn & 7) * 256 + wc * 32 + 8 * fq;
        const bool rope = (sel < 2) && (wc == 0);
        float irev[8];
#pragma unroll
        for (int q = 0; q < 8; ++q) irev[q] = __builtin_amdgcn_exp2f(-(float)(((8 * fq) & 15) + q) * (2.0f / 32.0f * 18.931568569324174f)) * 0.15915494309189535f;
#pragma unroll
        for (int ai = 0; ai < 2; ++ai)
#pragma unroll
            for (int m = 0; m < 4; ++m) {
                const int row = row0 + ai * 128 + m * 16;
                float cc[8], ss[8];
                if (rope) { const float pv = (float)pos[row];
#pragma unroll
                    for (int q = 0; q < 8; ++q) { const float fr_ = __builtin_amdgcn_fractf(pv * irev[q]); cc[q] = __builtin_amdgcn_cosf(fr_); ss[q] = __builtin_amdgcn_sinf(fr_); } }
#pragma unroll
                for (int bj = 0; bj < 2; ++bj) {
                    float o[8];
#pragma unroll
                    for (int n = 0; n < 2; ++n)
#pragma unroll
                        for (int j = 0; j < 4; ++j) { const float x = acc[ai][bj][m][n][j]; float r = x;
                            if (rope) { const auto sw = __builtin_amdgcn_permlane32_swap(__builtin_bit_cast(unsigned, x), __builtin_bit_cast(unsigned, x), false, false);
                                const float y = __builtin_bit_cast(float, fq < 2 ? sw[1] : sw[0]);
                                r = (fq < 2) ? (x * cc[4 * n + j] - y * ss[4 * n + j]) : (x * cc[4 * n + j] + y * ss[4 * n + j]); }
                            o[4 * n + j] = r; }
                    u32x4 w; w.x = pk_h2(o[0], o[1]); w.y = pk_h2(o[2], o[3]); w.z = pk_h2(o[4], o[5]); w.w = pk_h2(o[6], o[7]);
                    *(u32x4*)(base + (size_t)row * MOBA_W + bj * 128) = w;
                }
            }
    }
};
struct EpiRes {
    static constexpr bool PERM = true, AFTER_DRAIN = false;
    h16* Y; const float* gate;
    __device__ __forceinline__ void operator()(const f32x4 (&acc)[2][2][4][2], const pg8::Unit& u, int wr, int wc, int fr, int fq) const {
        const int row0 = u.pm * 256 + wr * 64 + fr, col0 = u.pn * 256 + wc * 32 + 8 * fq; const int b = u.pm >> 3;
        f32x4 gv[2][2];
#pragma unroll
        for (int bj = 0; bj < 2; ++bj)
#pragma unroll
            for (int n = 0; n < 2; ++n) gv[bj][n] = *(const f32x4*)(gate + (size_t)b * MODW + col0 + bj * 128 + n * 4);
#pragma unroll
        for (int ai = 0; ai < 2; ++ai)
#pragma unroll
            for (int m = 0; m < 4; ++m) { h16* rp = Y + (size_t)(row0 + ai * 128 + m * 16) * D + col0;
#pragma unroll
                for (int bj = 0; bj < 2; ++bj) { const f32x4 v0 = acc[ai][bj][m][0] * gv[bj][0], v1 = acc[ai][bj][m][1] * gv[bj][1];
                    u32x4 w; w.x = pk_h2(v0[0], v0[1]); w.y = pk_h2(v0[2], v0[3]); w.z = pk_h2(v1[0], v1[1]); w.w = pk_h2(v1[2], v1[3]);
                    *(u32x4*)(rp + bj * 128) = w; } }
    }
};


template <int MODE> struct EpiProbe {
    static constexpr bool PERM = true, AFTER_DRAIN = false;
    h16* O;
    __device__ __forceinline__ void operator()(const f32x4 (&acc)[2][2][4][2], const pg8::Unit& u, int wr, int wc, int fr, int fq) const {
        const int lane = fr + 16 * fq;
#pragma unroll
        for (int ai = 0; ai < 2; ++ai)
#pragma unroll
            for (int m = 0; m < 4; ++m)
#pragma unroll
                for (int bj = 0; bj < 2; ++bj) { const f32x4 v0 = acc[ai][bj][m][0], v1 = acc[ai][bj][m][1];
                    u32x4 w; w.x = pk_h2(v0[0], v0[1]); w.y = pk_h2(v0[2], v0[3]); w.z = pk_h2(v1[0], v1[1]); w.w = pk_h2(v1[2], v1[3]);
                    if (MODE == 0) { asm volatile("" :: "v"(w)); }
                    else if (MODE == 1) { const int row = u.pm * 256 + wr * 128 + (ai * 4 + m) * 16 + bj * 8 + (lane >> 3); *(u32x4*)(O + (size_t)row * MOBA_W + (u.pn & 7) * 256 + wc * 64 + (lane & 7) * 8) = w; }
                    else { const int row = u.pm * 256 + wr * 64 + ai * 128 + m * 16 + fr; *(u32x4*)(O + (size_t)row * MOBA_W + (u.pn & 7) * 256 + bj * 128 + wc * 32 + 8 * fq) = w; }
                }
    }
};

constexpr int NWAVES = 8, NT = NWAVES * 64;
constexpr int RING_BYTES = 131072;
constexpr int MISC_OFF = RING_BYTES;
constexpr int LDS_BYTES = 147456;
constexpr int CW_BAR = 4096;
constexpr size_t CTL_ZERO_BYTES = 64 * 1024;

#define GAS __attribute__((address_space(1)))
#define XB_TMO      128
#define XB_XCNT(j)  (256  + 64 * (j))
#define XB_XSUB(j)  (1280 + 64 * (j))
#define XB_XGEN(j)  (2304 + 64 * (j))
#define XB_TOP      3328
#define XB_TOPGEN   3392
#define XCD_BAR_WORDS 3456
#define XB_SPIN_CAP (1u << 22)
__device__ __forceinline__ unsigned xb_ld(unsigned* p)              { return __hip_atomic_load(p, __ATOMIC_RELAXED, __HIP_MEMORY_SCOPE_AGENT); }
__device__ __forceinline__ unsigned xb_add(unsigned* p, unsigned v) { return __hip_atomic_fetch_add(p, v, __ATOMIC_RELAXED, __HIP_MEMORY_SCOPE_AGENT); }
__device__ __forceinline__ unsigned xb_xcc_id() { return (unsigned)__builtin_amdgcn_s_getreg((3 << 11) | 20) & 0xFu; }
#define XB_SPIN(cond, bar) do { unsigned _sp = 0; while (cond) { __builtin_amdgcn_s_sleep(1); \
    if ((++_sp & 255u) == 0u) { if (xb_ld(&(bar)[XB_TMO])) break; if (_sp > XB_SPIN_CAP) { atomicAdd(&(bar)[XB_TMO], 1u); break; } } } } while (0)
struct XcdBarrier { unsigned* bar; unsigned x; volatile LAS unsigned* st; };
__device__ __forceinline__ XcdBarrier xcd_barrier_post(unsigned* bar, volatile LAS unsigned* st) {
    XcdBarrier b; b.bar = bar; b.x = xb_xcc_id(); b.st = st;
    if (threadIdx.x == 0) (void)xb_add(&bar[XB_XCNT(b.x)], 1u);
    return b;
}
__device__ __forceinline__ void xcd_barrier_complete(unsigned* bar, unsigned x, unsigned& nloc, unsigned& nx) {
    const unsigned G = gridDim.x * gridDim.y * gridDim.z;
    unsigned sum, cnt, mine, sp = 0u;
    for (;;) {
        sum = 0u; cnt = 0u; mine = 0u;
#pragma unroll
        for (unsigned j = 0; j < 16; ++j) { const unsigned c = xb_ld(&bar[XB_XCNT(j)]); sum += c; cnt += (c > 0u) ? 1u : 0u; mine = (j == x) ? c : mine; }
        if (sum == G) break;
        __builtin_amdgcn_s_sleep(1);
        if ((++sp & 255u) == 0u) { if (xb_ld(&bar[XB_TMO])) break; if (sp > XB_SPIN_CAP) { atomicAdd(&bar[XB_TMO], 1u); break; } }
    }
    nloc = mine > 0u ? mine : 1u; nx = cnt > 0u ? cnt : 1u;
}
__device__ __forceinline__ void xcd_barrier(const XcdBarrier& b) {
    asm volatile("s_waitcnt vmcnt(0)" ::: "memory");
    __syncthreads();
    if (threadIdx.x == 0) {
        unsigned* bar = b.bar;
        __builtin_amdgcn_s_waitcnt(0);
        unsigned nloc = b.st[0], nx = b.st[1];
        if (nloc == 0u) { xcd_barrier_complete(bar, b.x, nloc, nx); b.st[0] = nloc; b.st[1] = nx; }
        const unsigned old = xb_add(&bar[XB_XSUB(b.x)], 1u);
        const unsigned gen = old / nloc;
        if (old + 1u == (gen + 1u) * nloc) {
            __builtin_amdgcn_fence(__ATOMIC_RELEASE, "agent");
            asm volatile("s_waitcnt vmcnt(0)" ::: "memory");
            const unsigned og = xb_add(&bar[XB_TOP], 1u);
            const unsigned tg = og / nx;
            if (og + 1u == (tg + 1u) * nx) xb_add(&bar[XB_TOPGEN], 1u);
            else XB_SPIN(xb_ld(&bar[XB_TOPGEN]) == tg, bar);
            __builtin_amdgcn_fence(__ATOMIC_ACQUIRE, "agent");
            xb_add(&bar[XB_XGEN(b.x)], 1u);
            asm volatile("s_waitcnt vmcnt(0)" ::: "memory");
        } else {
            XB_SPIN(xb_ld(&bar[XB_XGEN(b.x)]) == gen, bar);
            __builtin_amdgcn_fence(__ATOMIC_ACQUIRE, "agent");
            asm volatile("s_waitcnt vmcnt(0)" ::: "memory");
        }
    }
    __syncthreads();
}

__device__ __forceinline__ void mod_partial_item(int item, const float* c, const float* w_ada, float* part, float* ldsf) {
    constexpr int nks = NT / 16, kper = 512 / nks, nw = NT / 64;
    const int tid = opaque_tid();
    const int l = item / (96 * KSPLIT), r = item % (96 * KSPLIT), cg64 = r / KSPLIT, s = r % KSPLIT, k0 = s * 512, col0 = cg64 * 64;
    float* cs = ldsf;
    float* red = ldsf + 8 * 512;
    for (int i = tid; i < 8 * 512; i += NT) cs[i] = c[(i >> 9) * D + k0 + (i & 511)];
    __syncthreads();
    const int cg = tid & 15, ks = tid >> 4;
    f32x4 acc[8];
#pragma unroll
    for (int b = 0; b < 8; ++b) acc[b] = (f32x4){0.f, 0.f, 0.f, 0.f};
    const float* wp = w_ada + ((size_t)l * D + k0 + ks * kper) * MODW + col0 + cg * 4;
#pragma unroll 4
    for (int kk = 0; kk < kper; ++kk) { const f32x4 w = *(const f32x4*)(wp + (size_t)kk * MODW);
#pragma unroll
        for (int b = 0; b < 8; ++b) acc[b] += w * cs[b * 512 + ks * kper + kk]; }
#pragma unroll
    for (int b = 0; b < 8; ++b)
#pragma unroll
        for (int j = 0; j < 4; ++j) { float v = acc[b][j]; v += __shfl_xor(v, 16); v += __shfl_xor(v, 32); acc[b][j] = v; }
    if ((tid & 63) < 16) {
#pragma unroll
        for (int b = 0; b < 8; ++b) *(f32x4*)(red + ((tid >> 6) * 8 + b) * 64 + cg * 4) = acc[b];
    }
    __syncthreads();
    for (int o = tid; o < 512; o += NT) { float v = 0.f;
#pragma unroll
        for (int w = 0; w < nw; ++w) v += red[w * 512 + o];
        part[(((size_t)l * KSPLIT + s) * 8 + (o >> 6)) * MODW + col0 + (o & 63)] = v; }
    __syncthreads();
}
__device__ __forceinline__ void transpose_item(const float* W, int K, int N, h16* WT, float* scr, int item, int lane) {
    const int nblk = N / 32, kb = item / nblk, nb = item % nblk, k0 = 64 * kb, n0 = 32 * nb;
#pragma unroll 8
    for (int i = 0; i < 32; ++i) { const int kk = 2 * i + (lane >> 5); scr[kk * 33 + (lane & 31)] = W[(size_t)(k0 + kk) * N + n0 + (lane & 31)]; }
    asm volatile("s_waitcnt lgkmcnt(0)" ::: "memory");
    const int c = lane & 7;
#pragma unroll
    for (int j = 0; j < 4; ++j) { const int n = (lane >> 3) + 8 * j; const float* s = scr + (8 * c) * 33 + n;
        u32x4 o; o.x = pk_h2(s[0 * 33], s[1 * 33]); o.y = pk_h2(s[2 * 33], s[3 * 33]); o.z = pk_h2(s[4 * 33], s[5 * 33]); o.w = pk_h2(s[6 * 33], s[7 * 33]);
        *(u32x4*)(WT + (size_t)(n0 + n) * K + k0 + 8 * c) = o; }
    asm volatile("s_waitcnt lgkmcnt(0)" ::: "memory");
}
constexpr int IT_W0IN = (D / 64) * (RET_IN / 32), IT_W0OUT = (RET_V / 64) * (D / 32), IT_W1IN = (D / 64) * (MOBA_IN / 32), IT_W1OUT = (MOBA_W / 64) * (D / 32);
constexpr int IT_WALL = IT_W0IN + IT_W0OUT + IT_W1IN + IT_W1OUT;

struct Ptrs {
    const float *x, *c; const int* pos; const float *ret_w_in, *ret_w_out, *moba_w_in, *moba_w_out, *w_ada, *b_ada, *ln_g, *ln_b;
    float* out; float *MOD, *PART, *KMEAN; float2 *RCS0, *RCS1;
    h16 *W0IN, *W0OUT, *W1IN, *W1OUT, *Q0, *K0, *V0, *G0, *H0, *H1, *Q1, *K1, *V1, *G1, *A1;
};

__device__ __forceinline__ void phase0(const Ptrs& P, float* ldsf, int bid, int G) {
    const int tid = opaque_tid(), wave = tid >> 6, lane = tid & 63;
    for (int it = bid; it < 2 * 96 * KSPLIT; it += G) mod_partial_item(it, P.c, P.w_ada, P.PART, ldsf);
    float* scr = ldsf + wave * (64 * 33);
    for (int it = bid * NWAVES + wave; it < IT_WALL; it += G * NWAVES) { int r = it;
        if (r < IT_W0IN) { transpose_item(P.ret_w_in, D, RET_IN, P.W0IN, scr, r, lane); continue; } r -= IT_W0IN;
        if (r < IT_W0OUT) { transpose_item(P.ret_w_out, RET_V, D, P.W0OUT, scr, r, lane); continue; } r -= IT_W0OUT;
        if (r < IT_W1IN) { transpose_item(P.moba_w_in, D, MOBA_IN, P.W1IN, scr, r, lane); continue; } r -= IT_W1IN;
        transpose_item(P.moba_w_out, MOBA_W, D, P.W1OUT, scr, r, lane); }
}
__device__ __forceinline__ void phase1(const Ptrs& P, float* ldsf, int bid, int G) {
    const int tid = opaque_tid();
    for (int i = bid * NT + tid; i < 2 * 8 * MODW; i += G * NT) { const int l = i / (8 * MODW), r = i % (8 * MODW), b = r / MODW, j = r % MODW;
        float v = P.b_ada[l * MODW + j];
#pragma unroll
        for (int s = 0; s < KSPLIT; ++s) v += P.PART[(((size_t)l * KSPLIT + s) * 8 + b) * MODW + j];
        P.MOD[i] = v; }
    for (int ch = bid; ch < M / 64; ch += G) {
        const int b = ch / (SEQ / 64);
        __syncthreads();
        for (int j = tid; j < 2 * D; j += NT) { float v = P.b_ada[j];
#pragma unroll
            for (int s = 0; s < KSPLIT; ++s) v += P.PART[(((size_t)0 * KSPLIT + s) * 8 + b) * MODW + j];
            ldsf[j] = v; }
        __syncthreads();
        for (int e = tid; e < 64 * D / 4; e += NT) { const int rr = e / (D / 4), j = (e % (D / 4)) * 4; const size_t off = (size_t)(ch * 64 + rr) * D + j;
            const f32x4 xv = *(const f32x4*)(P.x + off), sh = *(const f32x4*)(ldsf + j), sc = *(const f32x4*)(ldsf + D + j);
            const f32x4 h = xv * (sc + 1.0f) + sh; u32x2 w; w.x = pk_h2(h[0], h[1]); w.y = pk_h2(h[2], h[3]); *(u32x2*)(P.H0 + off) = w; }
    }
}
__device__ __forceinline__ void phase_norm_gate(const h16* O, const h16* Gt, h16* A, int bid, int G) {
    const int tid_ = opaque_tid(); const int gw = bid * NWAVES + (tid_ >> 6), lane = tid_ & 63, NGW = G * NWAVES;
    for (int it = gw; it < M * RET_HEADS; it += NGW) {
        const size_t off = (size_t)it * RET_DV + lane * 8;
        const h16x8 ov = *(const h16x8*)(O + off), gv = *(const h16x8*)(Gt + off);
        float o[8]; float s = 0.f;
#pragma unroll
        for (int j = 0; j < 8; ++j) { o[j] = (float)ov[j]; s += o[j]; }
        const float mu = wave_sum(s) * (1.0f / RET_DV); float q = 0.f;
#pragma unroll
        for (int j = 0; j < 8; ++j) { o[j] -= mu; q += o[j] * o[j]; }
        const float rstd = 1.0f / sqrtf(wave_sum(q) * (1.0f / RET_DV) + GN_EPS);
        float r[8];
#pragma unroll
        for (int j = 0; j < 8; ++j) r[j] = o[j] * rstd * silu((float)gv[j]);
        u32x4 w; w.x = pk_h2(r[0], r[1]); w.y = pk_h2(r[2], r[3]); w.z = pk_h2(r[4], r[5]); w.w = pk_h2(r[6], r[7]);
        *(u32x4*)(A + off) = w;
    }
}
__device__ __forceinline__ void phase_layernorm(const float* xin, const h16* Y, float* xout, const float* g, const float* bta, const float* mod_next, h16* H, int bid, int G) {
    const int tid_ = opaque_tid(); const int gw = bid * NWAVES + (tid_ >> 6), lane = tid_ & 63, NGW = G * NWAVES;
    for (int m = gw; m < M; m += NGW) {
        const float* xr = xin + (size_t)m * D; const h16* yr = Y + (size_t)m * D; f32x4 v[8]; float s = 0.f;
#pragma unroll
        for (int j = 0; j < 4; ++j) { const h16x8 yv = *(const h16x8*)(yr + j * 512 + lane * 8); const f32x4 x0 = *(const f32x4*)(xr + j * 512 + lane * 8), x1 = *(const f32x4*)(xr + j * 512 + lane * 8 + 4);
            v[2 * j] = x0 * ALPHA + (f32x4){(float)yv[0], (float)yv[1], (float)yv[2], (float)yv[3]}; v[2 * j + 1] = x1 * ALPHA + (f32x4){(float)yv[4], (float)yv[5], (float)yv[6], (float)yv[7]}; }
#pragma unroll
        for (int j = 0; j < 8; ++j) s += (v[j][0] + v[j][1]) + (v[j][2] + v[j][3]);
        const float mu = wave_sum(s) * (1.0f / D); float q = 0.f;
#pragma unroll
        for (int j = 0; j < 8; ++j) { v[j] = v[j] - mu; q += (v[j][0] * v[j][0] + v[j][1] * v[j][1]) + (v[j][2] * v[j][2] + v[j][3] * v[j][3]); }
        const float rstd = 1.0f / sqrtf(wave_sum(q) * (1.0f / D) + LN_EPS);
        const int b = m / SEQ;
#pragma unroll
        for (int j = 0; j < 8; ++j) { const int c = (j >> 1) * 512 + lane * 8 + (j & 1) * 4;
            const f32x4 xo = v[j] * rstd * *(const f32x4*)(g + c) + *(const f32x4*)(bta + c);
            *(f32x4*)(xout + (size_t)m * D + c) = xo;
            if (H) { const f32x4 sh = *(const f32x4*)(mod_next + (size_t)b * MODW + c), sc = *(const f32x4*)(mod_next + (size_t)b * MODW + D + c);
                const f32x4 h = xo * (sc + 1.0f) + sh; u32x2 w; w.x = pk_h2(h[0], h[1]); w.y = pk_h2(h[2], h[3]); *(u32x2*)(H + (size_t)m * D + c) = w; } }
    }
}

__device__ __forceinline__ void phase_retention_naive(const h16* Q, const h16* K, h16* VO, float* ldsf, int bid, int G) {
    constexpr int TT = 4;
    const int tid_ = opaque_tid(); const int half = tid_ >> 8, tid = tid_ & 255, vi = tid & 63, dq = tid >> 6;
    float* qs = ldsf + half * (3 * TT * 256);
    float* ks = qs + TT * 256;
    float* red = ks + TT * 256;
    for (int vb0 = bid * 2; vb0 < BATCH * RET_HEADS * 8; vb0 += 2 * G) {
        const int blk = vb0 + half, vg = blk & 7, h = (blk >> 3) & 7, b = blk >> 6;
        const float gamma = 1.0f - exp2f(-5.0f - (float)h);
        float S[64];
#pragma unroll
        for (int d = 0; d < 64; ++d) S[d] = 0.f;
        for (int t0 = 0; t0 < SEQ; t0 += TT) {
            __syncthreads();
            for (int i = tid; i < TT * 256; i += 256) { const int tt = i >> 8, d = i & 255; const size_t row = (size_t)(b * SEQ + t0 + tt);
                qs[tt * 256 + d] = (float)Q[row * RET_QK + h * 256 + d]; ks[tt * 256 + d] = (float)K[row * RET_QK + h * 256 + d]; }
            __syncthreads();
            float po[TT];
#pragma unroll
            for (int tt = 0; tt < TT; ++tt) {
                const float v = (float)VO[(size_t)(b * SEQ + t0 + tt) * RET_V + h * 512 + vg * 64 + vi];
                float a = 0.f;
#pragma unroll
                for (int d = 0; d < 64; ++d) { S[d] = gamma * S[d] + ks[tt * 256 + dq * 64 + d] * v; a += qs[tt * 256 + dq * 64 + d] * S[d]; }
                po[tt] = a;
            }
#pragma unroll
            for (int tt = 0; tt < TT; ++tt) red[(dq * TT + tt) * 64 + vi] = po[tt];
            __syncthreads();
            for (int i = tid; i < TT * 64; i += 256) { const int tt = i >> 6, v = i & 63;
                const float o = (red[(0 * TT + tt) * 64 + v] + red[(1 * TT + tt) * 64 + v]) + (red[(2 * TT + tt) * 64 + v] + red[(3 * TT + tt) * 64 + v]);
                VO[(size_t)(b * SEQ + t0 + tt) * RET_V + h * 512 + vg * 64 + v] = (h16)o; }
        }
        __syncthreads();
    }
}


typedef short v4i16 __attribute__((__vector_size__(8)));
__device__ __forceinline__ h16x4 lds_tr_read(LAS unsigned char* p) { const v4i16 v = __builtin_amdgcn_ds_read_tr16_b64_v4i16((LAS v4i16*)p); return __builtin_bit_cast(h16x4, v); }
__device__ __forceinline__ int off_b(int row, int ch) { return 256 * row + 16 * (ch ^ (((row & 3) << 2) | ((row >> 2) & 3))); }
__device__ __forceinline__ int tr_addr16(int lane, int c, int ks, int t) { const int g = lane >> 4, q = (lane & 15) >> 2, p = lane & 3; return off_b(32 * ks + 8 * g + 4 * t + q, 2 * c + (p >> 1)) + 8 * (p & 1); }
__device__ __forceinline__ h16x8 cat8(h16x4 a, h16x4 b) { return __builtin_shufflevector(a, b, 0, 1, 2, 3, 4, 5, 6, 7); }
__device__ __forceinline__ void fill_piece(LAS unsigned char* tile, const h16* g0, size_t pitch_elems, int piece, int lane) {
    const int rr = lane >> 4, cp = lane & 15, row = 4 * piece + rr, ch = cp ^ ((rr << 2) | (piece & 3));
    __builtin_amdgcn_global_load_lds((const unsigned*)(g0 + (size_t)row * pitch_elems + ch * 8), (LAS unsigned*)(tile + piece * 1024), 16, 0, 0);
}
constexpr int R_Q = 0, R_K = 32768, R_V = 65536, R_SC = 81920, SC_PITCH = 144;
__device__ __forceinline__ void phase_retention(const h16* Q, const h16* K, h16* VO, LAS unsigned char* L, int bid, int G) {
    const int tid = opaque_tid(), w = __builtin_amdgcn_readfirstlane(tid >> 6), lane = tid & 63, r = lane & 15, g = lane >> 4;
    for (int item = bid; item < BATCH * RET_HEADS * 4; item += G) {
        const int bh = (item & 7) | ((item >> 5) << 3), vs = (item >> 3) & 3, b = bh >> 3, h = bh & 7;
        const float l2g = log2f(1.0f - exp2f(-5.0f - (float)h));
        const int mt = w >> 1, nt0 = (w & 1) * 2;
        float mk[2][4], qd[4];
#pragma unroll
        for (int t = 0; t < 2; ++t)
#pragma unroll
            for (int i = 0; i < 4; ++i) { const int n = 16 * (nt0 + t) + r, m = 16 * mt + 4 * g + i; mk[t][i] = (n >= m) ? exp2f((float)(n - m) * l2g) : 0.0f; }
#pragma unroll
        for (int nt = 0; nt < 4; ++nt) qd[nt] = exp2f((float)(16 * nt + r + 1) * l2g);
        h16x8 kd[2];
#pragma unroll
        for (int ks = 0; ks < 2; ++ks)
#pragma unroll
            for (int j = 0; j < 8; ++j) kd[ks][j] = (h16)exp2f((float)(63 - (32 * ks + 8 * g + j)) * l2g);
        const float gC = exp2f(64.0f * l2g);
        f32x4 S[16];
#pragma unroll
        for (int dt = 0; dt < 16; ++dt) S[dt] = (f32x4){0.f, 0.f, 0.f, 0.f};
        const h16* Qg = Q + (size_t)b * SEQ * RET_QK + h * 256;
        const h16* Kg = K + (size_t)b * SEQ * RET_QK + h * 256;
        h16* Vg = VO + (size_t)b * SEQ * RET_V + h * 512 + vs * 128;
        for (int c = 0; c < SEQ / 64; ++c) {
            { const int hf = w >> 2, p0 = (w & 3) * 4;
#pragma unroll
                for (int i = 0; i < 4; ++i) { fill_piece(L + R_Q + hf * 16384, Qg + (size_t)c * 64 * RET_QK + hf * 128, RET_QK, p0 + i, lane);
                                              fill_piece(L + R_K + hf * 16384, Kg + (size_t)c * 64 * RET_QK + hf * 128, RET_QK, p0 + i, lane); }
#pragma unroll
                for (int i = 0; i < 2; ++i) fill_piece(L + R_V, Vg + (size_t)c * 64 * RET_V, RET_V, 2 * w + i, lane); }
            asm volatile("s_waitcnt vmcnt(0)" ::: "memory"); __builtin_amdgcn_s_barrier(); asm volatile("" ::: "memory");
            { f32x4 sc[2] = {(f32x4){0.f, 0.f, 0.f, 0.f}, (f32x4){0.f, 0.f, 0.f, 0.f}};
#pragma unroll
                for (int hf = 0; hf < 2; ++hf)
#pragma unroll
                    for (int s = 0; s < 4; ++s) {
                        const h16x8 a = *(const LAS h16x8*)(L + R_K + hf * 16384 + off_b(16 * mt + r, 4 * s + g));
                        const h16x8 b0 = *(const LAS h16x8*)(L + R_Q + hf * 16384 + off_b(16 * nt0 + r, 4 * s + g));
                        const h16x8 b1 = *(const LAS h16x8*)(L + R_Q + hf * 16384 + off_b(16 * (nt0 + 1) + r, 4 * s + g));
                        sc[0] = __builtin_amdgcn_mfma_f32_16x16x32_f16(a, b0, sc[0], 0, 0, 0);
                        sc[1] = __builtin_amdgcn_mfma_f32_16x16x32_f16(a, b1, sc[1], 0, 0, 0); }
#pragma unroll
                for (int t = 0; t < 2; ++t) { u32x2 wv; wv.x = pk_h2(sc[t][0] * mk[t][0], sc[t][1] * mk[t][1]); wv.y = pk_h2(sc[t][2] * mk[t][2], sc[t][3] * mk[t][3]);
                    *(LAS u32x2*)(L + R_SC + (16 * (nt0 + t) + r) * SC_PITCH + 2 * (16 * mt + 4 * g)) = wv; } }
            f32x4 o3[4];
#pragma unroll
            for (int nt = 0; nt < 4; ++nt) o3[nt] = (f32x4){0.f, 0.f, 0.f, 0.f};
#pragma unroll
            for (int s = 0; s < 8; ++s) {
                const f32x4 s0 = S[2 * s], s1 = S[2 * s + 1];
                h16x8 af; af[0] = (h16)s0[0]; af[1] = (h16)s0[1]; af[2] = (h16)s0[2]; af[3] = (h16)s0[3]; af[4] = (h16)s1[0]; af[5] = (h16)s1[1]; af[6] = (h16)s1[2]; af[7] = (h16)s1[3];
                const int hf = s >> 2, ss = s & 3;
#pragma unroll
                for (int nt = 0; nt < 4; ++nt) {
                    const h16x4 lo = *(const LAS h16x4*)(L + R_Q + hf * 16384 + off_b(16 * nt + r, 4 * ss + (g >> 1)) + 8 * (g & 1));
                    const h16x4 hi = *(const LAS h16x4*)(L + R_Q + hf * 16384 + off_b(16 * nt + r, 4 * ss + 2 + (g >> 1)) + 8 * (g & 1));
                    o3[nt] = __builtin_amdgcn_mfma_f32_16x16x32_f16(af, cat8(lo, hi), o3[nt], 0, 0, 0); }
            }
            asm volatile("s_waitcnt lgkmcnt(0)" ::: "memory"); __builtin_amdgcn_s_barrier(); asm volatile("" ::: "memory");
            h16x8 vf[2];
#pragma unroll
            for (int ks = 0; ks < 2; ++ks) vf[ks] = cat8(lds_tr_read(L + R_V + tr_addr16(lane, w, ks, 0)), lds_tr_read(L + R_V + tr_addr16(lane, w, ks, 1)));
#pragma unroll
            for (int nt = 0; nt < 4; ++nt) {
                f32x4 o2 = (f32x4){0.f, 0.f, 0.f, 0.f};
#pragma unroll
                for (int ks = 0; ks < 2; ++ks) { const h16x8 bf = *(const LAS h16x8*)(L + R_SC + (16 * nt + r) * SC_PITCH + 2 * (32 * ks + 8 * g));
                    o2 = __builtin_amdgcn_mfma_f32_16x16x32_f16(vf[ks], bf, o2, 0, 0, 0); }
                const f32x4 o = o2 + o3[nt] * qd[nt];
                u32x2 wv; wv.x = pk_h2(o[0], o[1]); wv.y = pk_h2(o[2], o[3]);
                *(u32x2*)(Vg + (size_t)(c * 64 + 16 * nt + r) * RET_V + 16 * w + 4 * g) = wv; }
            const h16x8 vk0 = vf[0] * kd[0], vk1 = vf[1] * kd[1];
#pragma unroll
            for (int dt = 0; dt < 16; ++dt) {
                const int hf = dt >> 3, c8 = dt & 7;
                const h16x8 a0 = cat8(lds_tr_read(L + R_K + hf * 16384 + tr_addr16(lane, c8, 0, 0)), lds_tr_read(L + R_K + hf * 16384 + tr_addr16(lane, c8, 0, 1)));
                const h16x8 a1 = cat8(lds_tr_read(L + R_K + hf * 16384 + tr_addr16(lane, c8, 1, 0)), lds_tr_read(L + R_K + hf * 16384 + tr_addr16(lane, c8, 1, 1)));
                f32x4 acc = S[dt] * gC;
                acc = __builtin_amdgcn_mfma_f32_16x16x32_f16(a0, vk0, acc, 0, 0, 0);
                acc = __builtin_amdgcn_mfma_f32_16x16x32_f16(a1, vk1, acc, 0, 0, 0);
                S[dt] = acc; }
            asm volatile("s_waitcnt lgkmcnt(0)" ::: "memory"); __builtin_amdgcn_s_barrier(); asm volatile("" ::: "memory");
        }
    }
    asm volatile("s_waitcnt vmcnt(0)" ::: "memory"); __syncthreads();
}

__device__ __forceinline__ void phase_kmean(const h16* K, float* kmean, int bid, int G) {
    const int tid_ = opaque_tid();
    for (int i = bid * NT + tid_; i < BATCH * NBLK * MOBA_W; i += G * NT) {
        const int col = i % MOBA_W, bb = i / MOBA_W;
        float s = 0.f; for (int t = 0; t < MOBA_BLOCK; ++t) s += (float)K[((size_t)bb * MOBA_BLOCK + t) * MOBA_W + col];
        kmean[i] = s * (1.0f / MOBA_BLOCK); }
}
__device__ __forceinline__ void phase_moba_naive(const h16* Q, const h16* K, const h16* V, const h16* Gt, const float* kmean, h16* A, int bid, int G) {
    const int tid_ = opaque_tid(); const int half = tid_ >> 8, tid = tid_ & 255, qi = tid >> 2, part = tid & 3;
    for (int vb0 = bid * 2; vb0 < BATCH * MOBA_HEADS * 32; vb0 += 2 * G) {
        const int blk = vb0 + half, qt = blk & 31, h = (blk >> 5) & 15, b = blk >> 9;
        const int t = qt * 64 + qi, own = t >> 8; const size_t row = (size_t)b * SEQ + t;
        float q[32];
#pragma unroll
        for (int j = 0; j < 32; ++j) q[j] = (float)Q[row * MOBA_W + h * 128 + part * 32 + j];
        float gs[NBLK]; unsigned sel = 0u;
#pragma unroll
        for (int n = 0; n < NBLK; ++n) { float a = 0.f;
#pragma unroll
            for (int j = 0; j < 32; ++j) a += q[j] * kmean[((size_t)(b * NBLK + n)) * MOBA_W + h * 128 + part * 32 + j];
            a += __shfl_xor(a, 1); a += __shfl_xor(a, 2); gs[n] = a; }
#pragma unroll
        for (int r = 0; r < 3; ++r) { int best = -1; float bv = -3e38f;
#pragma unroll
            for (int n = 0; n < NBLK; ++n) if (n < own && !((sel >> n) & 1u) && gs[n] > bv) { bv = gs[n]; best = n; }
            if (best >= 0) sel |= 1u << best; }
        const float scale = 0.08838834764831845f;
        float mrun = -1e30f, lrun = 0.f, acc[32];
#pragma unroll
        for (int j = 0; j < 32; ++j) acc[j] = 0.f;
        for (int n = 0; n <= own; ++n) {
            const bool use = (n == own) || ((sel >> n) & 1u);
            if (!use) continue;
            const int kend = (n == own) ? (t & 255) + 1 : MOBA_BLOCK;
            for (int kk = 0; kk < kend; ++kk) {
                const size_t krow = (size_t)b * SEQ + n * MOBA_BLOCK + kk;
                const h16* kp = K + krow * MOBA_W + h * 128 + part * 32; float s = 0.f;
#pragma unroll
                for (int j = 0; j < 32; ++j) s += q[j] * (float)kp[j];
                s += __shfl_xor(s, 1); s += __shfl_xor(s, 2); s *= scale;
                const float mn = fmaxf(mrun, s), al = __expf(mrun - mn), p = __expf(s - mn);
                lrun = lrun * al + p; mrun = mn;
                const h16* vp = V + krow * MOBA_W + h * 128 + part * 32;
#pragma unroll
                for (int j = 0; j < 32; ++j) acc[j] = acc[j] * al + p * (float)vp[j];
            }
        }
        const float inv = 1.0f / lrun;
#pragma unroll
        for (int j = 0; j < 32; ++j) { const size_t o = row * MOBA_W + h * 128 + part * 32 + j; A[o] = (h16)(acc[j] * inv * silu((float)Gt[o])); }
    }
}


#define TR_READ(dst, addr, off) asm volatile("ds_read_b64_tr_b16 %0, %1 offset:%2" : "=v"(dst) : "v"(addr), "i"(off))
__device__ __forceinline__ int off_v(int row, int ch) { return 256 * row + 16 * (ch ^ (2 * (row & 7))); }
#define LDS_READ128(dst, addr, off) asm volatile("ds_read_b128 %0, %1 offset:%2" : "=v"(dst) : "v"(addr), "i"(off))
__device__ __forceinline__ void fill_piece_k(LAS unsigned char* tile, const h16* g0, size_t pitch_elems, int piece, int lane) {
    const int rr = lane >> 4, cp = lane & 15, row = 4 * piece + rr, ch = cp ^ (row & 15);
    __builtin_amdgcn_global_load_lds((const unsigned*)(g0 + (size_t)row * pitch_elems + ch * 8), (LAS unsigned*)(tile + piece * 1024), 16, 0, 0);
}
__device__ __forceinline__ void fill_piece_v(LAS unsigned char* tile, const h16* g0, size_t pitch_elems, int piece, int lane) {
    const int rr = lane >> 4, cp = lane & 15, row = 4 * piece + rr, ch = cp ^ (2 * (row & 7));
    __builtin_amdgcn_global_load_lds((const unsigned*)(g0 + (size_t)row * pitch_elems + ch * 8), (LAS unsigned*)(tile + piece * 1024), 16, 0, 0);
}
__device__ __forceinline__ float xmax16(float x) { const auto r_ = __builtin_amdgcn_permlane16_swap(__builtin_bit_cast(unsigned, x), __builtin_bit_cast(unsigned, x), false, false); return fmaxf(__builtin_bit_cast(float, r_[0]), __builtin_bit_cast(float, r_[1])); }
__device__ __forceinline__ float xmax32(float x) { const auto r_ = __builtin_amdgcn_permlane32_swap(__builtin_bit_cast(unsigned, x), __builtin_bit_cast(unsigned, x), false, false); return fmaxf(__builtin_bit_cast(float, r_[0]), __builtin_bit_cast(float, r_[1])); }
template <int VAR>
__device__ __forceinline__ void phase_moba(const h16* Q, const h16* K, const h16* V, const h16* Gt, const float* kmean, h16* A, LAS unsigned char* L, int bid, int G) {
    const int tid = opaque_tid(), w = __builtin_amdgcn_readfirstlane(tid >> 6), lane = tid & 63, r = lane & 15, g = lane >> 4;
    const float NEG_INF = -__builtin_inff();
    const float cs = 0.08838834764831845f * 1.4426950408889634f;
    const bool lead = w < 4;
    for (int vb = bid; vb < BATCH * MOBA_HEADS * 4; vb += G) {
        const int xcd = vb & 7, jj = vb >> 3, pr = jj & 3, bh = xcd + 8 * (jj >> 2), b = bh >> 4, h = bh & 15;
        const h16* Kg = K + (size_t)b * SEQ * MOBA_W + h * 128;
        const h16* Vg = V + (size_t)b * SEQ * MOBA_W + h * 128;
        for (int half = 0; half < 2; ++half) {
            const int qb = half ? 7 - pr : pr;
            const size_t row0 = (size_t)b * SEQ + qb * 256 + 32 * w;
            h16x8 qf[2][4];
#pragma unroll
            for (int qt = 0; qt < 2; ++qt)
#pragma unroll
                for (int s = 0; s < 4; ++s) qf[qt][s] = *(const h16x8*)(Q + (row0 + 16 * qt + r) * MOBA_W + h * 128 + 32 * s + 8 * g);
            unsigned sel[2] = {0u, 0u};
            if (qb > 0) {
                f32x4 gt[2] = {(f32x4){0.f, 0.f, 0.f, 0.f}, (f32x4){0.f, 0.f, 0.f, 0.f}};
#pragma unroll
                for (int s = 0; s < 4; ++s) {
                    h16x8 hi, lo;
                    const float* kp = kmean + ((size_t)(b * NBLK + (r & 7))) * MOBA_W + h * 128 + 32 * s + 8 * g;
                    const f32x4 k0 = *(const f32x4*)kp, k1 = *(const f32x4*)(kp + 4);
#pragma unroll
                    for (int j = 0; j < 8; ++j) { const float kv = (r < 8) ? (j < 4 ? k0[j & 3] : k1[j & 3]) : 0.0f; const h16 hh = (h16)kv; hi[j] = hh; lo[j] = (h16)(kv - (float)hh); }
#pragma unroll
                    for (int qt = 0; qt < 2; ++qt) { gt[qt] = __builtin_amdgcn_mfma_f32_16x16x32_f16(hi, qf[qt][s], gt[qt], 0, 0, 0); gt[qt] = __builtin_amdgcn_mfma_f32_16x16x32_f16(lo, qf[qt][s], gt[qt], 0, 0, 0); }
                }
#pragma unroll
                for (int qt = 0; qt < 2; ++qt) {
                    float gs[8];
#pragma unroll
                    for (int i = 0; i < 4; ++i) { gs[i] = __shfl(gt[qt][i], r); gs[4 + i] = __shfl(gt[qt][i], r + 16); }
                    unsigned sm = 0u;
#pragma unroll
                    for (int rr = 0; rr < 3; ++rr) { int best = -1; float bv = -3e38f;
#pragma unroll
                        for (int n = 0; n < NBLK; ++n) if (n < qb && !((sm >> n) & 1u) && gs[n] > bv) { bv = gs[n]; best = n; }
                        if (best >= 0) sm |= 1u << best; }
                    sel[qt] = sm;
                }
            }
            f32x4 o[8][2];
#pragma unroll
            for (int dt = 0; dt < 8; ++dt) { o[dt][0] = (f32x4){0.f, 0.f, 0.f, 0.f}; o[dt][1] = (f32x4){0.f, 0.f, 0.f, 0.f}; }
            float mrun[2] = {NEG_INF, NEG_INF}, lrun[2] = {0.f, 0.f};
            const int ntiles = 4 * (qb + 1);
            f32x4 st[4][2]; float marg[2] = {0.f, 0.f}, alr[2] = {1.f, 1.f}; bool chg = false, needB = false; int slotB = 0;
#pragma unroll
            for (int kt = 0; kt < 4; ++kt) { st[kt][0] = (f32x4){0.f, 0.f, 0.f, 0.f}; st[kt][1] = (f32x4){0.f, 0.f, 0.f, 0.f}; }
#define MOBA_FILL(it_, slot_) do { const int n_ = (it_) < 4 ? qb : (((it_) - 4) >> 2); const size_t k0_ = (size_t)n_ * 256 + 64 * ((it_) & 3); \
                LAS unsigned char* kb_ = L + (slot_) * 32768; int ln_ = lane; asm volatile("" : "+v"(ln_)); \
                fill_piece_k(kb_, Kg + k0_ * MOBA_W, MOBA_W, 2 * w, ln_); fill_piece_k(kb_, Kg + k0_ * MOBA_W, MOBA_W, 2 * w + 1, ln_); \
                fill_piece_v(kb_ + 16384, Vg + k0_ * MOBA_W, MOBA_W, 2 * w, ln_); fill_piece_v(kb_ + 16384, Vg + k0_ * MOBA_W, MOBA_W, 2 * w + 1, ln_); } while (0)
#define MOBA_A(it_) do { const int ita_ = (it_); const bool own_ = ita_ < 4; const int n_ = own_ ? qb : ((ita_ - 4) >> 2), t_ = ita_ & 3; \
                needB = (VAR != 1) && (own_ ? (t_ <= (w >> 1)) : (__any((int)(((sel[0] | sel[1]) >> n_) & 1u)) != 0)); slotB = ita_ & 3; \
                if (needB) { \
                    unsigned kslot_ = (unsigned)(ita_ & 3) * 32768u; asm volatile("" : "+s"(kslot_));     \
                    h16x8 kf[4][4]; unsigned ka_[4]; \
                    { int ln_ = lane; asm volatile("" : "+v"(ln_)); const int r_ = ln_ & 15, g_ = ln_ >> 4; const unsigned kbase = (unsigned)(size_t)L + kslot_ + (unsigned)(256 * r_); \
                        _Pragma("unroll") for (int s = 0; s < 4; ++s) ka_[s] = kbase + (unsigned)(16 * ((4 * s + g_) ^ r_)); } \
                    _Pragma("unroll") for (int kt = 0; kt < 4; ++kt) { st[kt][0] = (f32x4){0.f, 0.f, 0.f, 0.f}; st[kt][1] = (f32x4){0.f, 0.f, 0.f, 0.f}; } \
                      \
                    LDS_READ128(kf[0][0], ka_[0], 0); LDS_READ128(kf[1][0], ka_[0], 4096); LDS_READ128(kf[2][0], ka_[0], 8192); LDS_READ128(kf[3][0], ka_[0], 12288); \
                    LDS_READ128(kf[0][1], ka_[1], 0); LDS_READ128(kf[1][1], ka_[1], 4096); LDS_READ128(kf[2][1], ka_[1], 8192); LDS_READ128(kf[3][1], ka_[1], 12288); \
                    asm volatile("s_waitcnt lgkmcnt(4)" ::: "memory"); __builtin_amdgcn_sched_barrier(0); \
                    _Pragma("unroll") for (int kt = 0; kt < 4; ++kt) { \
                            st[kt][0] = __builtin_amdgcn_mfma_f32_16x16x32_f16(kf[kt][0], qf[0][0], st[kt][0], 0, 0, 0); \
                            st[kt][1] = __builtin_amdgcn_mfma_f32_16x16x32_f16(kf[kt][0], qf[1][0], st[kt][1], 0, 0, 0); } \
                    __builtin_amdgcn_sched_barrier(0); \
                    LDS_READ128(kf[0][2], ka_[2], 0); LDS_READ128(kf[1][2], ka_[2], 4096); LDS_READ128(kf[2][2], ka_[2], 8192); LDS_READ128(kf[3][2], ka_[2], 12288); \
                    asm volatile("s_waitcnt lgkmcnt(4)" ::: "memory"); __builtin_amdgcn_sched_barrier(0); \
                    _Pragma("unroll") for (int kt = 0; kt < 4; ++kt) { \
                            st[kt][0] = __builtin_amdgcn_mfma_f32_16x16x32_f16(kf[kt][1], qf[0][1], st[kt][0], 0, 0, 0); \
                            st[kt][1] = __builtin_amdgcn_mfma_f32_16x16x32_f16(kf[kt][1], qf[1][1], st[kt][1], 0, 0, 0); } \
                    __builtin_amdgcn_sched_barrier(0); \
                    LDS_READ128(kf[0][3], ka_[3], 0); LDS_READ128(kf[1][3], ka_[3], 4096); LDS_READ128(kf[2][3], ka_[3], 8192); LDS_READ128(kf[3][3], ka_[3], 12288); \
                    asm volatile("s_waitcnt lgkmcnt(4)" ::: "memory"); __builtin_amdgcn_sched_barrier(0); \
                    _Pragma("unroll") for (int kt = 0; kt < 4; ++kt) { \
                            st[kt][0] = __builtin_amdgcn_mfma_f32_16x16x32_f16(kf[kt][2], qf[0][2], st[kt][0], 0, 0, 0); \
                            st[kt][1] = __builtin_amdgcn_mfma_f32_16x16x32_f16(kf[kt][2], qf[1][2], st[kt][1], 0, 0, 0); } \
                    __builtin_amdgcn_sched_barrier(0); asm volatile("s_waitcnt lgkmcnt(0)" ::: "memory"); __builtin_amdgcn_sched_barrier(0); \
                    _Pragma("unroll") for (int kt = 0; kt < 4; ++kt) { \
                            st[kt][0] = __builtin_amdgcn_mfma_f32_16x16x32_f16(kf[kt][3], qf[0][3], st[kt][0], 0, 0, 0); \
                            st[kt][1] = __builtin_amdgcn_mfma_f32_16x16x32_f16(kf[kt][3], qf[1][3], st[kt][1], 0, 0, 0); } \
                    const bool diag_ = own_ && (t_ == (w >> 1)); chg = false; \
                    _Pragma("unroll") for (int qt = 0; qt < 2; ++qt) { \
                        const bool rowsel = own_ || (((sel[qt] >> n_) & 1u) != 0u); \
                        if (diag_) { const int qpos = 32 * w + 16 * qt + r; \
                            _Pragma("unroll") for (int kt = 0; kt < 4; ++kt) _Pragma("unroll") for (int i = 0; i < 4; ++i) { const int kpos = 64 * t_ + 16 * kt + 4 * g + i; if (kpos > qpos) st[kt][qt][i] = NEG_INF; } } \
                        float mx = NEG_INF; \
                        _Pragma("unroll") for (int kt = 0; kt < 4; ++kt) { mx = fmaxf(fmaxf(mx, st[kt][qt][0]), st[kt][qt][1]); mx = fmaxf(fmaxf(mx, st[kt][qt][2]), st[kt][qt][3]); } \
                        mx = xmax32(xmax16(mx)); \
                        mx = rowsel ? mx * cs : NEG_INF; \
                        const float mold = mrun[qt]; \
                        const float mn = (mx > mold + 6.0f) ? mx : mold;            \
                        marg[qt] = rowsel ? mn : __builtin_inff();                     \
                        alr[qt] = __builtin_amdgcn_exp2f(mold - mn); chg = chg || (mn != mold); mrun[qt] = mn; } \
                } } while (0)
#define MOBA_B() do { if (needB) { \
                    unsigned vslot_ = (unsigned)slotB * 32768u + 16384u; asm volatile("" : "+s"(vslot_)); \
                    int lnb_ = lane; asm volatile("" : "+v"(lnb_)); const int q4 = (lnb_ & 15) >> 2, p4 = lnb_ & 3, gb_ = lnb_ >> 4; \
                    const unsigned x32 = (unsigned)(((4 * gb_ + q4) & 7) * 32); \
                    const unsigned vbase = (unsigned)(size_t)L + vslot_ + (unsigned)(256 * (4 * gb_ + q4) + 16 * (p4 >> 1) + 8 * (p4 & 1)); \
                    h16x4 vr[8][2][2]; \
                    _Pragma("unroll") for (int dt = 0; dt < 4; ++dt) { const unsigned va = vbase + (((unsigned)dt * 32u) ^ x32); \
                        TR_READ(vr[dt][0][0], va, 0); TR_READ(vr[dt][0][1], va, 4096); TR_READ(vr[dt][1][0], va, 8192); TR_READ(vr[dt][1][1], va, 12288); } \
                    if (__any((int)chg)) { _Pragma("unroll") for (int dt = 0; dt < 8; ++dt) { o[dt][0] = o[dt][0] * alr[0]; o[dt][1] = o[dt][1] * alr[1]; } } \
                    h16x8 pf[2][2]; \
                    _Pragma("unroll") for (int qt = 0; qt < 2; ++qt) { float sum = 0.f; \
                        _Pragma("unroll") for (int kt = 0; kt < 4; ++kt) _Pragma("unroll") for (int i = 0; i < 4; ++i) { const float p = __builtin_amdgcn_exp2f(__builtin_fmaf(st[kt][qt][i], cs, -marg[qt])); st[kt][qt][i] = p; sum += p; } \
                        lrun[qt] = lrun[qt] * alr[qt] + sum; \
                        _Pragma("unroll") for (int ks = 0; ks < 2; ++ks) { const f32x4 p0 = st[2 * ks][qt], p1 = st[2 * ks + 1][qt]; h16x8 f; \
                            f[0] = (h16)p0[0]; f[1] = (h16)p0[1]; f[2] = (h16)p0[2]; f[3] = (h16)p0[3]; f[4] = (h16)p1[0]; f[5] = (h16)p1[1]; f[6] = (h16)p1[2]; f[7] = (h16)p1[3]; pf[ks][qt] = f; } } \
                    __builtin_amdgcn_sched_barrier(0); \
                    _Pragma("unroll") for (int dt = 4; dt < 8; ++dt) { const unsigned va = vbase + (((unsigned)dt * 32u) ^ x32); \
                        TR_READ(vr[dt][0][0], va, 0); TR_READ(vr[dt][0][1], va, 4096); TR_READ(vr[dt][1][0], va, 8192); TR_READ(vr[dt][1][1], va, 12288); } \
                    asm volatile("s_waitcnt lgkmcnt(15)" ::: "memory"); __builtin_amdgcn_sched_barrier(0);     \
                    _Pragma("unroll") for (int dt = 0; dt < 4; ++dt) _Pragma("unroll") for (int ks = 0; ks < 2; ++ks) { const h16x8 a = cat8(vr[dt][ks][0], vr[dt][ks][1]); \
                            o[dt][0] = __builtin_amdgcn_mfma_f32_16x16x32_f16(a, pf[ks][0], o[dt][0], 0, 0, 0); \
                            o[dt][1] = __builtin_amdgcn_mfma_f32_16x16x32_f16(a, pf[ks][1], o[dt][1], 0, 0, 0); } \
                    __builtin_amdgcn_sched_barrier(0); asm volatile("s_waitcnt lgkmcnt(0)" ::: "memory"); __builtin_amdgcn_sched_barrier(0); \
                    _Pragma("unroll") for (int dt = 4; dt < 8; ++dt) _Pragma("unroll") for (int ks = 0; ks < 2; ++ks) { const h16x8 a = cat8(vr[dt][ks][0], vr[dt][ks][1]); \
                            o[dt][0] = __builtin_amdgcn_mfma_f32_16x16x32_f16(a, pf[ks][0], o[dt][0], 0, 0, 0); \
                            o[dt][1] = __builtin_amdgcn_mfma_f32_16x16x32_f16(a, pf[ks][1], o[dt][1], 0, 0, 0); } \
                } } while (0)
#define MOBA_TOP(it_) do { if ((it_) + 1 < ntiles) asm volatile("s_waitcnt vmcnt(4)" ::: "memory"); else asm volatile("s_waitcnt vmcnt(0)" ::: "memory");     \
                asm volatile("s_waitcnt lgkmcnt(0)" ::: "memory"); __builtin_amdgcn_s_barrier(); asm volatile("" ::: "memory"); \
                if ((it_) + 2 < ntiles) MOBA_FILL((it_) + 2, ((it_) + 2) & 3); } while (0)
#define MOBA_MID() do { asm volatile("s_waitcnt lgkmcnt(0)" ::: "memory"); __builtin_amdgcn_s_barrier(); asm volatile("" ::: "memory"); } while (0)
            MOBA_FILL(0, 0); MOBA_FILL(1, 1);
            if (lead) {
                for (int it = 0; it < ntiles; ++it) { MOBA_TOP(it); MOBA_A(it); MOBA_MID(); MOBA_B(); }
                MOBA_MID();
            } else {
                for (int it = 0; it < ntiles; ++it) { MOBA_TOP(it); MOBA_B(); MOBA_MID(); MOBA_A(it); }
                MOBA_MID();
                MOBA_B();
            }
#undef MOBA_FILL
#undef MOBA_A
#undef MOBA_B
#undef MOBA_TOP
#undef MOBA_MID
#pragma unroll
            for (int qt = 0; qt < 2; ++qt) { float lt = lrun[qt]; lt += __shfl_xor(lt, 16); lt += __shfl_xor(lt, 32); const float inv = 1.0f / lt; const size_t rowoff = (row0 + 16 * qt + r) * MOBA_W + h * 128 + 4 * g;
#pragma unroll
                for (int dt = 0; dt < 8; ++dt) { const h16x4 gv = *(const h16x4*)(Gt + rowoff + 16 * dt); const f32x4 ov = o[dt][qt] * inv;
                    u32x2 wv; wv.x = pk_h2(ov[0] * silu((float)gv[0]), ov[1] * silu((float)gv[1])); wv.y = pk_h2(ov[2] * silu((float)gv[2]), ov[3] * silu((float)gv[3]));
                    *(u32x2*)(A + rowoff + 16 * dt) = wv; } }
        }
    }
    asm volatile("s_waitcnt vmcnt(0)" ::: "memory"); __syncthreads();
}

struct Args { const void* in[11]; float* out; unsigned char* ws; int ph_lo, ph_hi; };
constexpr int NPHASE = 12;
#ifndef PROBE_DUP
#define PROBE_DUP 0u
#endif
#ifndef PROBE_MOBA_VAR
#define PROBE_MOBA_VAR -1
#endif
#ifndef PROBE_DUMMY_GEMM
#define PROBE_DUMMY_GEMM 0
#define PROBE_DG_N 3072
#define PROBE_DG_K 1024
#define PROBE_DG_BF16 false
#define PROBE_DG_FIXED 0
#define PROBE_DG_EPI -1
#endif
#ifndef PROBE_CLOCK_PHASE
#define PROBE_CLOCK_PHASE -1
#endif
#ifndef PROBE_XCC
#define PROBE_XCC 0
#endif
#ifndef PROBE_BAR2
#define PROBE_BAR2 0
#endif
__global__ void __launch_bounds__(NT, 2) mk_fwd(Args a) {
    extern __shared__ __attribute__((aligned(16))) unsigned char lds[];
    LAS unsigned char* L = (LAS unsigned char*)lds;
    float* ldsf = (float*)lds;
    const int tid = threadIdx.x, bid = blockIdx.x, G = gridDim.x;
    volatile LAS unsigned* MISC = (volatile LAS unsigned*)(L + MISC_OFF);
    if (tid < 32) MISC[tid] = 0u;
    __syncthreads();
    unsigned char* ws = a.ws;
    Ptrs P;
    P.x = (const float*)a.in[0]; P.c = (const float*)a.in[1]; P.pos = (const int*)a.in[2];
    P.ret_w_in = (const float*)a.in[3]; P.ret_w_out = (const float*)a.in[4]; P.moba_w_in = (const float*)a.in[5]; P.moba_w_out = (const float*)a.in[6];
    P.w_ada = (const float*)a.in[7]; P.b_ada = (const float*)a.in[8]; P.ln_g = (const float*)a.in[9]; P.ln_b = (const float*)a.in[10];
    P.out = a.out; P.MOD = (float*)(ws + WS_MOD); P.PART = (float*)(ws + WS_PART); P.KMEAN = (float*)(ws + WS_KMEAN);
    P.RCS0 = (float2*)(ws + WS_RCS0); P.RCS1 = (float2*)(ws + WS_RCS1);
    P.W0IN = (h16*)(ws + WS_W0IN); P.W0OUT = (h16*)(ws + WS_W0OUT); P.W1IN = (h16*)(ws + WS_W1IN); P.W1OUT = (h16*)(ws + WS_W1OUT);
    P.Q0 = (h16*)(ws + WS_Q0); P.K0 = (h16*)(ws + WS_K0); P.V0 = (h16*)(ws + WS_V0); P.G0 = (h16*)(ws + WS_G0); P.H0 = (h16*)a.out;
    P.H1 = (h16*)(ws + WS_H1); P.Q1 = (h16*)(ws + WS_Q1); P.K1 = (h16*)(ws + WS_K1); P.V1 = (h16*)(ws + WS_V1); P.G1 = (h16*)(ws + WS_G1); P.A1 = (h16*)(ws + WS_A1);
    if (PROBE_XCC && tid == 0) ((unsigned*)(ws + WS_CTL))[3000 + bid] = xb_xcc_id() + 1u;
    XcdBarrier bar = xcd_barrier_post((unsigned*)(ws + WS_CTL) + CW_BAR, MISC + 8);
    const int lo = a.ph_lo, hi = a.ph_hi;
#define IN(k) (lo <= (k) && (k) < hi)
#define CLK0(k) do { if (PROBE_CLOCK_PHASE == (k) && bid == 0 && tid == 0) { ((unsigned long long*)(ws + WS_CTL))[1024] = __builtin_amdgcn_s_memtime(); ((unsigned long long*)(ws + WS_CTL))[1025] = __builtin_amdgcn_s_memrealtime(); } } while (0)
#define CLK1(k) do { if (PROBE_CLOCK_PHASE == (k) && bid == 0 && tid == 0) { ((unsigned long long*)(ws + WS_CTL))[1026] = __builtin_amdgcn_s_memtime(); ((unsigned long long*)(ws + WS_CTL))[1027] = __builtin_amdgcn_s_memrealtime(); } } while (0)
#define SEAM(k) do { if (IN(k) && IN((k) + 1)) { xcd_barrier(bar); if (PROBE_BAR2) xcd_barrier(bar); } } while (0)
#define REP(k) for (int rep_ = 0; rep_ < (((PROBE_DUP >> (k)) & 1u) ? 2 : 1); ++rep_)
    if (IN(0)) REP(0) { if (rep_) xcd_barrier(bar); phase0(P, ldsf, bid, G); }
    SEAM(0);
    if (IN(1)) REP(1) { if (rep_) xcd_barrier(bar); phase1(P, ldsf, bid, G); }
    SEAM(1);
    CLK0(2);
    if (IN(2)) REP(2) { if (rep_) xcd_barrier(bar); pg8::Gemm g{P.H0, P.W0IN, M, RET_IN, D, 0}; pg8::StaticOrder S; S.init(M, RET_IN, G, bid); EpiRet E{P.Q0, P.K0, P.V0, P.G0, P.pos};
        pg8::gemm_phase<EpiRet, pg8::StaticOrder, true, true>(L, g, S, E); }
    CLK1(2);
    SEAM(2);
    if (IN(3)) phase_retention(P.Q0, P.K0, P.V0, L, bid, G);
    SEAM(3);
    if (IN(4)) phase_norm_gate(P.V0, P.G0, P.G0, bid, G);
    SEAM(4);
    if (IN(5)) REP(5) { if (rep_) xcd_barrier(bar); pg8::Gemm g{P.G0, P.W0OUT, M, D, RET_V, 0}; pg8::StaticOrder S; S.init(M, D, G, bid); EpiRes E{P.V0, P.MOD + 2 * D};
        pg8::gemm_phase<EpiRes, pg8::StaticOrder, true, true>(L, g, S, E); }
    SEAM(5);
    if (IN(6)) phase_layernorm(P.x, P.V0, P.out, P.ln_g, P.ln_b, P.MOD + 8 * MODW, P.H1, bid, G);
    SEAM(6);
    if (IN(7)) REP(7) { if (rep_) xcd_barrier(bar); pg8::Gemm g{P.H1, P.W1IN, M, MOBA_IN, D, 0}; pg8::StaticOrder S; S.init(M, MOBA_IN, G, bid); EpiMoba E{P.Q1, P.K1, P.V1, P.G1, P.pos};
        pg8::gemm_phase<EpiMoba, pg8::StaticOrder, true, true>(L, g, S, E); }
    SEAM(7);
    if (IN(8)) REP(8) { if (rep_) xcd_barrier(bar); phase_kmean(P.K1, P.KMEAN, bid, G); }
    SEAM(8);
    CLK0(9);
    if (IN(9)) { phase_moba<0>(P.Q1, P.K1, P.V1, P.G1, P.KMEAN, P.A1, L, bid, G);
        if (PROBE_MOBA_VAR >= 0) { xcd_barrier(bar); phase_moba<(PROBE_MOBA_VAR < 0 ? 0 : PROBE_MOBA_VAR)>(P.Q1, P.K1, P.V1, P.G1, P.KMEAN, P.H1, L, bid, G); } }
    CLK1(9);
    SEAM(9);
    if (IN(10)) { pg8::Gemm g{P.A1, P.W1OUT, M, D, MOBA_W, 0}; pg8::StaticOrder S; S.init(M, D, G, bid); EpiRes E{P.H1, P.MOD + 8 * MODW + 2 * D};
        pg8::gemm_phase<EpiRes, pg8::StaticOrder, true, true>(L, g, S, E); }
    SEAM(10);
    if (IN(11)) phase_layernorm(P.out, P.H1, P.out, P.ln_g + D, P.ln_b + D, nullptr, nullptr, bid, G);
    if (PROBE_XCC && bid == 0) { __syncthreads(); if (tid == 0) { const unsigned* xp = (const unsigned*)(ws + WS_CTL) + 3000; int bad = 0; for (int i2 = 0; i2 < G; ++i2) bad += (xp[i2] != xp[i2 & 7]) ? 1 : 0; P.out[0] += 1.0f + (float)bad; } }
    if (PROBE_CLOCK_PHASE >= 0 && bid == 0) { __syncthreads(); if (tid == 0) { const unsigned long long* tsp = (const unsigned long long*)(ws + WS_CTL) + 1024;
        const float ghz = (float)(tsp[2] - tsp[0]) / ((float)(tsp[3] - tsp[1]) * 10.0f); __threadfence(); P.out[0] += ghz; } }
#if PROBE_DUMMY_GEMM
    { xcd_barrier(bar); pg8::Gemm g{P.H1, P.W1IN, M, PROBE_DG_N, PROBE_DG_K, 0}; pg8::StaticOrder S; S.init(M, PROBE_DG_N, G, bid); EpiMoba E{P.Q1, P.K1, P.V1, P.G1, P.pos};
        if (PROBE_DG_EPI >= 0) { EpiProbe<(PROBE_DG_EPI < 0 ? 0 : PROBE_DG_EPI)> E2{P.Q1}; pg8::gemm_phase<EpiProbe<(PROBE_DG_EPI < 0 ? 0 : PROBE_DG_EPI)>, pg8::StaticOrder, true, true>(L, g, S, E2); }
        else pg8::gemm_phase<EpiMoba, pg8::StaticOrder, true, true, PROBE_DG_BF16>(L, g, S, E); }
#endif
#undef IN
#undef SEAM
}

#ifndef MK_N_LAUNCHES
#define MK_N_LAUNCHES 1
#endif
extern "C" void kernel_launch(void* const* d_in, const int* in_sizes, int n_in, void* d_out, int out_size, void* d_ws, size_t ws_size, hipStream_t stream) {
    static int grid = 0;
    if (grid == 0) {
        if (n_in != 11 || out_size != M * D || ws_size < WS_END) { fprintf(stderr, "kernel_launch: unexpected shapes (n_in %d out %d ws %zu)\n", n_in, out_size, ws_size); grid = -1; return; }
        int dev = 0, cus = 0, per_cu = 0;
        if (hipGetDevice(&dev) != hipSuccess || hipDeviceGetAttribute(&cus, hipDeviceAttributeMultiprocessorCount, dev) != hipSuccess) { grid = -1; return; }
        if (hipFuncSetAttribute((const void*)mk_fwd, hipFuncAttributeMaxDynamicSharedMemorySize, LDS_BYTES) != hipSuccess) { fprintf(stderr, "kernel_launch: hipFuncSetAttribute failed\n"); grid = -1; return; }
        if (hipOccupancyMaxActiveBlocksPerMultiprocessor(&per_cu, (const void*)mk_fwd, NT, LDS_BYTES) != hipSuccess || per_cu < 1) { fprintf(stderr, "kernel_launch: occupancy query says %d\n", per_cu); (void)hipGetLastError(); grid = -1; return; }
        grid = cus;
    }
    if (grid < 0) return;
    if (hipMemsetAsync((char*)d_ws + WS_CTL, 0, CTL_ZERO_BYTES, stream) != hipSuccess) return;
    Args a{};
    for (int i = 0; i < 11; ++i) a.in[i] = d_in[i];
    a.out = (float*)d_out; a.ws = (unsigned char*)d_ws;
    if (MK_N_LAUNCHES == 1) { a.ph_lo = 0; a.ph_hi = NPHASE; hipLaunchKernelGGL(mk_fwd, dim3(grid), dim3(NT), LDS_BYTES, stream, a); }
    else for (int p = 0; p < NPHASE; ++p) { a.ph_lo = p; a.ph_hi = p + 1; hipLaunchKernelGGL(mk_fwd, dim3(grid), dim3(NT), LDS_BYTES, stream, a); }
}
```

```cpp
#include <hip/hip_runtime.h>
#include <cstdio>
#include <cstdint>
#include <cmath>

#ifndef PROBE_ATT_STAMP
#define PROBE_ATT_STAMP -1
#define PROBE_ATT_WAVE 0
#endif
#ifndef PROBE_GEMM_STAMP
#define PROBE_GEMM_STAMP -1
#define PROBE_GEMM_WAVE 0
#endif
typedef _Float16 h16;
typedef _Float16 h16x8 __attribute__((ext_vector_type(8)));
typedef _Float16 h16x4 __attribute__((ext_vector_type(4)));
typedef _Float16 h16x2 __attribute__((ext_vector_type(2)));
typedef float f32x4 __attribute__((ext_vector_type(4)));
typedef float f32x2 __attribute__((ext_vector_type(2)));
typedef unsigned u32x4 __attribute__((ext_vector_type(4)));
typedef unsigned u32x2 __attribute__((ext_vector_type(2)));
#define LAS __attribute__((address_space(3)))

constexpr int D = 2048, BATCH = 8, SEQ = 2048, M = BATCH * SEQ;
constexpr int RET_HEADS = 8, RET_DK = 256, RET_DV = 512, RET_QK = 2048, RET_V = 4096, RET_IN = 12288;
constexpr int MOBA_HEADS = 16, MOBA_DH = 128, MOBA_W = 2048, MOBA_IN = 8192, MOBA_BLOCK = 256, NBLK = 8;
constexpr float ALPHA = 1.4142135623730951f;
constexpr float LN_EPS = 1e-5f, GN_EPS = 1e-5f;
constexpr int MODW = 3 * D;
constexpr int KSPLIT = 4;

constexpr size_t MiB = 1u << 20;
constexpr size_t WS_CTL = 0;
constexpr size_t WS_MOD = 1 * MiB;
constexpr size_t WS_KMEAN = WS_MOD + 512 * 1024;
constexpr size_t WS_RCS1 = 2 * MiB;
constexpr size_t WS_W0IN = 4 * MiB;
constexpr size_t WS_W0OUT = 52 * MiB;
constexpr size_t WS_W1IN = 68 * MiB;
constexpr size_t WS_W1OUT = 100 * MiB;
constexpr size_t WS_ACT = 108 * MiB;
constexpr size_t WS_Q0 = WS_ACT, WS_K0 = WS_ACT + 64 * MiB, WS_V0 = WS_ACT + 128 * MiB, WS_G0 = WS_ACT + 256 * MiB;
constexpr size_t WS_H1 = WS_ACT, WS_Q1 = WS_ACT + 64 * MiB, WS_K1 = WS_ACT + 128 * MiB, WS_V1 = WS_ACT + 192 * MiB, WS_G1 = WS_ACT + 256 * MiB, WS_A1 = WS_ACT + 320 * MiB;
constexpr size_t WS_RCS0 = 492 * MiB;
constexpr size_t WS_PART = 508 * MiB;
constexpr size_t WS_END = 512 * MiB;

__device__ __forceinline__ int opaque_tid() { int t = threadIdx.x; asm volatile("" : "+v"(t)); return t; }
__device__ __forceinline__ unsigned pk_h2(float lo, float hi) { h16x2 h = {(h16)lo, (h16)hi}; return __builtin_bit_cast(unsigned, h); }
__device__ __forceinline__ float wave_sum(float v) {
#pragma unroll
    for (int o = 1; o < 64; o <<= 1) v += __shfl_xor(v, o);
    return v;
}
__device__ __forceinline__ float silu(float g) { return g / (1.0f + __expf(-g)); }

namespace pg8 {
typedef __bf16 bf16x8_t __attribute__((ext_vector_type(8)));
constexpr int BM = 256, BK = 64, HALF = 128, HTB = HALF * BK * 2, STAGE_BYTES = 8 * HTB, NXCD = 8, WGM = 8;
__host__ __device__ __forceinline__ int lds_byte(int r, int c) { const int st = (r >> 4) * 2 + (c >> 5), rr = r & 15, cc = c & 31, ob = rr * 64 + cc * 2; return st * 1024 + (ob ^ (((ob >> 9) & 1) << 5)); }
__host__ __device__ __forceinline__ void stage_rc(int b, int& R, int& C) { const int st = b / 1024, sb = b % 1024, swz = sb ^ (((sb >> 9) & 1) << 5); R = (st >> 1) * 16 + swz / 64; C = (st & 1) * 32 + (swz % 64) / 2; }
__host__ __device__ __forceinline__ int perm32(int rho) { const int n = rho >> 4, i = rho & 15; return 8 * (i >> 2) + 4 * n + (i & 3); }
struct Unit { int pm, pn; };
struct Gemm { const h16* A; const h16* Bt; int M, N, K, pad; };
struct StaticOrder {
    int nM, nN, nwg, G, c;
    __host__ __device__ void init(int M_, int N_, int G_, int c_) { nM = M_ / BM; nN = N_ / BM; nwg = nM * nN; G = G_; c = c_; }
    __host__ __device__ bool next(int i, Unit& u) const {
        const long L = (long)i * G + c; if (L >= nwg) return false;
        int wgid = (int)L; { const int q = nwg / NXCD, r = nwg % NXCD, xcd = wgid % NXCD, off = wgid / NXCD; wgid = (xcd < r ? xcd * (q + 1) : r * (q + 1) + (xcd - r) * q) + off; }
        const int nig = WGM * nN, gid = wgid / nig, fm = gid * WGM, gsz = (nM - fm) < WGM ? (nM - fm) : WGM;
        u.pm = fm + ((wgid % nig) % gsz); u.pn = (wgid % nig) / gsz; return true;
    }
    __device__ __forceinline__ void a_ready(const Unit&) const {}
    __device__ __forceinline__ void done(const Unit&) const {}
};

struct FixedOrder : StaticOrder {
    __host__ __device__ bool next(int i, Unit& u) const { Unit t; const bool ok = StaticOrder::next(i, t); u.pm = 0; u.pn = 0; return ok; }
};
template <class Epi, class Sched, bool ALIGN_EPI = false, bool SP2 = false, bool USE_BF16 = false, bool SIM = false>
__device__ __forceinline__ void gemm_phase(LAS unsigned char* lds, const Gemm g, const Sched& S, const Epi& E) {
    const int tid = opaque_tid(), wid = __builtin_amdgcn_readfirstlane(tid >> 6), lane = tid & 63, wr = wid >> 2, wc = wid & 3, fr = lane & 15, fq = lane >> 4;
    const int K = g.K, nt = K / BK;
    unsigned voffA, voffB;
    { int R, C; stage_rc(tid * 16, R, C); const int Rb = Epi::PERM ? ((R & ~31) + perm32(R & 31)) : R;
        voffA = (unsigned)(R * K + C) * 2u; voffB = (unsigned)(Rb * K + C) * 2u; }
    const size_t pstep = (size_t)64 * K * 2;
    const size_t kstep = (size_t)(BK * 2);
    const size_t hstep = (size_t)HALF * K * 2;
    const size_t tstep = 2 * hstep;
    const unsigned ldsw = (unsigned)wid * 1024u;
    const int aoff = lds_byte(wr * 64 + fr, fq * 8), boff = lds_byte(wc * 32 + fr, fq * 8);
#define PG8_SA(b, h) (((b) * 2 + (h)) * HTB)
#define PG8_SB(b, h) ((4 + (b) * 2 + (h)) * HTB)
#define PG8_STAGE(bufoff, gbase, voff) do { _Pragma("unroll") for (int _i = 0; _i < 2; ++_i) \
        __builtin_amdgcn_global_load_lds((const unsigned*)((const char*)(gbase) + _i * pstep + (voff)), (LAS unsigned*)(lds + (bufoff) + ldsw + _i * 8192), 16, 0, 0); } while (0)
#define PG8_LDA(dst, b, h) do { _Pragma("unroll") for (int m = 0; m < 4; ++m) _Pragma("unroll") for (int k = 0; k < 2; ++k) dst[m][k] = *(const LAS h16x8*)(lds + PG8_SA(b, h) + aoff + m * 2048 + k * 1024); } while (0)
#define PG8_LDB(dst, b, h) do { _Pragma("unroll") for (int n = 0; n < 2; ++n) _Pragma("unroll") for (int k = 0; k < 2; ++k) dst[n][k] = *(const LAS h16x8*)(lds + PG8_SB(b, h) + boff + n * 2048 + k * 1024); } while (0)
#define PG8_MMA(ai, bj, At, Bt) do { __builtin_amdgcn_s_setprio(1); _Pragma("unroll") for (int m = 0; m < 4; ++m) _Pragma("unroll") for (int n = 0; n < 2; ++n) _Pragma("unroll") for (int k = 0; k < 2; ++k) \
        acc[ai][bj][m][n] = USE_BF16 ? __builtin_amdgcn_mfma_f32_16x16x32_bf16(__builtin_bit_cast(bf16x8_t, Bt[n][k]), __builtin_bit_cast(bf16x8_t, At[m][k]), acc[ai][bj][m][n], 0, 0, 0) : __builtin_amdgcn_mfma_f32_16x16x32_f16(Bt[n][k], At[m][k], acc[ai][bj][m][n], 0, 0, 0); __builtin_amdgcn_s_setprio(0); } while (0)
#define PG8_MMAQ(ai, bj, mlo, At, Bt) do { __builtin_amdgcn_s_setprio(1); _Pragma("unroll") for (int m = (mlo); m < (mlo) + 2; ++m) _Pragma("unroll") for (int n = 0; n < 2; ++n) _Pragma("unroll") for (int k = 0; k < 2; ++k) \
        acc[ai][bj][m][n] = __builtin_amdgcn_mfma_f32_16x16x32_f16(Bt[n][k], At[m][k], acc[ai][bj][m][n], 0, 0, 0); __builtin_amdgcn_s_setprio(0); __builtin_amdgcn_sched_barrier(0); } while (0)
#define PG8_STAGE_P(bufoff, gbase, voff) do { PG8_STAGE(bufoff, gbase, voff); __builtin_amdgcn_sched_barrier(0); } while (0)
#define PG8_WAIT_V(n) asm volatile("s_waitcnt vmcnt(" #n ")" ::: "memory")
#define PG8_WAIT_L(n) asm volatile("s_waitcnt lgkmcnt(" #n ")" ::: "memory")
#define PG8_BAR __builtin_amdgcn_s_barrier()
#define PG8_SCHED __builtin_amdgcn_sched_barrier(0)
#define GS0() do { if (PROBE_GEMM_STAMP >= 0 && Epi::STAMPED) { __builtin_amdgcn_sched_barrier(0); gs_t = __builtin_amdgcn_s_memtime(); __builtin_amdgcn_s_waitcnt(0xC07F); __builtin_amdgcn_sched_barrier(0); } } while (0)
#define GS(k) do { if (PROBE_GEMM_STAMP >= 0 && Epi::STAMPED) { __builtin_amdgcn_sched_barrier(0); const unsigned long long t2_ = __builtin_amdgcn_s_memtime(); __builtin_amdgcn_s_waitcnt(0xC07F); if (PROBE_GEMM_STAMP == (k)) { gs_sum += t2_ - gs_t; gs_n += 1; } gs_t = t2_; __builtin_amdgcn_sched_barrier(0); } } while (0)
    unsigned long long gs_t = 0, gs_sum = 0; int gs_n = 0;
    Unit cur, nxt; int ui = 0;
    if (!S.next(0, cur)) return;
    f32x4 acc[2][2][4][2];
#pragma unroll
    for (int a = 0; a < 2; ++a)
#pragma unroll
        for (int b = 0; b < 2; ++b)
#pragma unroll
            for (int m = 0; m < 4; ++m)
#pragma unroll
                for (int n = 0; n < 2; ++n) acc[a][b][m][n] = (f32x4){0.f, 0.f, 0.f, 0.f};
    h16x8 At[4][2], B0[2][2], B1[2][2];
    const char* cA = (const char*)g.A + (size_t)cur.pm * tstep; const char* cB = (const char*)g.Bt + (size_t)cur.pn * tstep;
    S.a_ready(cur);
    if constexpr (SP2) {
        PG8_STAGE(PG8_SB(0, 0), cB, voffB); PG8_STAGE(PG8_SB(0, 1), cB + hstep, voffB); PG8_STAGE(PG8_SA(0, 0), cA, voffA); PG8_STAGE(PG8_SA(0, 1), cA + hstep, voffA);
        if (wr == 1) PG8_BAR;
        PG8_WAIT_V(2); PG8_BAR;
        PG8_STAGE(PG8_SB(1, 0), cB + kstep, voffB); PG8_STAGE(PG8_SA(1, 0), cA + kstep, voffA); PG8_STAGE(PG8_SB(1, 1), cB + hstep + kstep, voffB);
        PG8_WAIT_V(6); PG8_BAR;
    } else {
        PG8_STAGE(PG8_SB(0, 0), cB, voffB); PG8_STAGE(PG8_SA(0, 0), cA, voffA); PG8_STAGE(PG8_SB(0, 1), cB + hstep, voffB); PG8_STAGE(PG8_SA(0, 1), cA + hstep, voffA);
        if (wr == 1) PG8_BAR;
        PG8_WAIT_V(4); PG8_BAR;
        PG8_STAGE(PG8_SB(1, 0), cB + kstep, voffB); PG8_STAGE(PG8_SA(1, 0), cA + kstep, voffA); PG8_STAGE(PG8_SB(1, 1), cB + hstep + kstep, voffB);
        PG8_WAIT_V(6); PG8_BAR;
    }
    for (;;) {
        const bool has_next = S.next(ui + 1, nxt);
        const char* nA = has_next ? (const char*)g.A + (size_t)nxt.pm * tstep : cA; const char* nB = has_next ? (const char*)g.Bt + (size_t)nxt.pn * tstep : cB;
        for (int t = 0; t < nt; t += 2) {
            const bool last = (t == nt - 2);
            const char* a1 = cA + (size_t)(t + 1) * kstep;
            const char* a2 = last ? nA : cA + (size_t)(t + 2) * kstep; const char* b2 = last ? nB : cB + (size_t)(t + 2) * kstep;
            const char* a3 = a2 + kstep; const char* b3 = b2 + kstep;
            if (last && has_next) S.a_ready(nxt);
            if constexpr (SP2 && SIM) {
            PG8_LDB(B0, 0, 0); PG8_LDB(B1, 0, 1); PG8_SCHED; PG8_LDA(At, 0, 0);
            PG8_WAIT_V(6); PG8_WAIT_L(0); PG8_BAR; PG8_SCHED;
            PG8_MMAQ(0, 0, 0, At, B0); PG8_STAGE_P(PG8_SA(1, 1), a1 + hstep, voffA); PG8_MMAQ(0, 0, 2, At, B0); PG8_MMAQ(0, 1, 0, At, B1); PG8_MMAQ(0, 1, 2, At, B1); PG8_BAR; PG8_SCHED;
            PG8_LDA(At, 0, 1);
            PG8_WAIT_V(2); PG8_WAIT_L(0); PG8_BAR; PG8_SCHED;
            PG8_MMAQ(1, 0, 0, At, B0); PG8_STAGE_P(PG8_SB(0, 0), b2, voffB); PG8_MMAQ(1, 0, 2, At, B0); PG8_STAGE_P(PG8_SB(0, 1), b2 + hstep, voffB); PG8_MMAQ(1, 1, 0, At, B1); PG8_STAGE_P(PG8_SA(0, 0), a2, voffA); PG8_MMAQ(1, 1, 2, At, B1); PG8_BAR; PG8_SCHED;
            PG8_LDB(B0, 1, 0); PG8_LDB(B1, 1, 1); PG8_SCHED; PG8_LDA(At, 1, 0);
            PG8_WAIT_V(6); PG8_WAIT_L(0); PG8_BAR; PG8_SCHED;
            PG8_MMAQ(0, 0, 0, At, B0); PG8_STAGE_P(PG8_SA(0, 1), a2 + hstep, voffA); PG8_MMAQ(0, 0, 2, At, B0); PG8_MMAQ(0, 1, 0, At, B1); PG8_MMAQ(0, 1, 2, At, B1); PG8_BAR; PG8_SCHED;
            PG8_LDA(At, 1, 1);
            PG8_WAIT_V(2); PG8_WAIT_L(0); PG8_BAR; PG8_SCHED;
            PG8_MMAQ(1, 0, 0, At, B0); PG8_STAGE_P(PG8_SB(1, 0), b3, voffB); PG8_MMAQ(1, 0, 2, At, B0); PG8_STAGE_P(PG8_SB(1, 1), b3 + hstep, voffB); PG8_MMAQ(1, 1, 0, At, B1); PG8_STAGE_P(PG8_SA(1, 0), a3, voffA); PG8_MMAQ(1, 1, 2, At, B1); PG8_BAR; PG8_SCHED;
            } else if constexpr (SP2) {
            GS0(); PG8_LDB(B0, 0, 0); PG8_LDB(B1, 0, 1); PG8_SCHED; PG8_LDA(At, 0, 0); PG8_STAGE(PG8_SA(1, 1), a1 + hstep, voffA);
            PG8_WAIT_V(8); PG8_WAIT_L(0); PG8_BAR; GS(0); PG8_MMA(0, 0, At, B0); PG8_MMA(0, 1, At, B1); GS(1); PG8_BAR; GS(2); PG8_SCHED;
            GS0(); PG8_LDA(At, 0, 1); PG8_STAGE(PG8_SB(0, 0), b2, voffB); PG8_STAGE(PG8_SB(0, 1), b2 + hstep, voffB); PG8_STAGE(PG8_SA(0, 0), a2, voffA);
            PG8_WAIT_V(8); PG8_WAIT_L(0); PG8_BAR; GS(3); PG8_MMA(1, 0, At, B0); PG8_MMA(1, 1, At, B1); GS(1); PG8_BAR; GS(2); PG8_SCHED;
            PG8_LDB(B0, 1, 0); PG8_LDB(B1, 1, 1); PG8_SCHED; PG8_LDA(At, 1, 0); PG8_STAGE(PG8_SA(0, 1), a2 + hstep, voffA);
            PG8_WAIT_V(8); PG8_WAIT_L(0); PG8_BAR; PG8_MMA(0, 0, At, B0); PG8_MMA(0, 1, At, B1); PG8_BAR; PG8_SCHED;
            PG8_LDA(At, 1, 1); PG8_STAGE(PG8_SB(1, 0), b3, voffB); PG8_STAGE(PG8_SB(1, 1), b3 + hstep, voffB); PG8_STAGE(PG8_SA(1, 0), a3, voffA);
            PG8_WAIT_V(8); PG8_WAIT_L(0); PG8_BAR; PG8_MMA(1, 0, At, B0); PG8_MMA(1, 1, At, B1); PG8_BAR; PG8_SCHED;
            } else {
            PG8_LDB(B0, 0, 0); PG8_SCHED; PG8_LDA(At, 0, 0); PG8_STAGE(PG8_SA(1, 1), a1 + hstep, voffA);
            PG8_WAIT_L(8); PG8_BAR; PG8_WAIT_L(0); PG8_MMA(0, 0, At, B0); PG8_BAR; PG8_SCHED;
            PG8_LDB(B1, 0, 1); PG8_STAGE(PG8_SB(0, 0), b2, voffB);
            PG8_BAR; PG8_WAIT_L(0); PG8_MMA(0, 1, At, B1); PG8_BAR;
            PG8_LDA(At, 0, 1); PG8_STAGE(PG8_SA(0, 0), a2, voffA);
            PG8_BAR; PG8_WAIT_L(0); PG8_MMA(1, 0, At, B0); PG8_BAR; PG8_SCHED;
            PG8_STAGE(PG8_SB(0, 1), b2 + hstep, voffB);
            PG8_WAIT_V(6); PG8_BAR; PG8_MMA(1, 1, At, B1); PG8_BAR;
            PG8_LDB(B0, 1, 0); PG8_SCHED; PG8_LDA(At, 1, 0); PG8_STAGE(PG8_SA(0, 1), a2 + hstep, voffA);
            PG8_WAIT_L(8); PG8_BAR; PG8_WAIT_L(0); PG8_MMA(0, 0, At, B0); PG8_BAR; PG8_SCHED;
            PG8_LDB(B1, 1, 1); PG8_STAGE(PG8_SB(1, 0), b3, voffB);
            PG8_BAR; PG8_WAIT_L(0); PG8_MMA(0, 1, At, B1); PG8_BAR;
            PG8_LDA(At, 1, 1); PG8_STAGE(PG8_SA(1, 0), a3, voffA);
            PG8_BAR; PG8_WAIT_L(0); PG8_MMA(1, 0, At, B0); PG8_BAR; PG8_SCHED;
            PG8_STAGE(PG8_SB(1, 1), b3 + hstep, voffB);
            PG8_WAIT_V(6); PG8_BAR; PG8_MMA(1, 1, At, B1); PG8_BAR;
            }
        }
        if constexpr (ALIGN_EPI) { if (wr == 0) PG8_BAR; }
        if constexpr (!Epi::AFTER_DRAIN) { E(acc, cur, wr, wc, fr, fq); S.done(cur); }
        if (!has_next) break;
#pragma unroll
        for (int a = 0; a < 2; ++a)
#pragma unroll
            for (int b = 0; b < 2; ++b)
#pragma unroll
                for (int m = 0; m < 4; ++m)
#pragma unroll
                    for (int n = 0; n < 2; ++n) acc[a][b][m][n] = (f32x4){0.f, 0.f, 0.f, 0.f};
        cur = nxt; cA = nA; cB = nB; ++ui;
        if constexpr (ALIGN_EPI) { if (wr == 1) PG8_BAR; }
    }
    PG8_WAIT_V(0);
    if constexpr (!ALIGN_EPI) { if (wr == 0) PG8_BAR; }
    PG8_BAR;
    if (PROBE_GEMM_STAMP >= 0 && Epi::STAMPED && blockIdx.x == 0 && wid == PROBE_GEMM_WAVE && lane == 0) E.park((float)gs_sum / (float)(gs_n > 0 ? gs_n : 1) * 0.01f);
#undef PG8_SA
#undef PG8_SB
#undef PG8_STAGE
#undef PG8_LDA
#undef PG8_LDB
#undef PG8_MMA
#undef PG8_MMAQ
#undef PG8_STAGE_P
#undef PG8_WAIT_V
#undef PG8_WAIT_L
#undef PG8_BAR
#undef PG8_SCHED
}
}

struct EpiRet {
    static constexpr bool PERM = true, AFTER_DRAIN = false, STAMPED = true;
    __device__ __forceinline__ void park(float v) const { *stamp_dst = v; }
    h16 *Q, *K, *V, *G; const int* pos; float* stamp_dst;
    __device__ __forceinline__ void operator()(const f32x4 (&acc)[2][2][4][2], const pg8::Unit& u, int wr, int wc, int fr, int fq) const {
        const int row0 = u.pm * 256 + wr * 64 + fr;
        if (u.pn < 16) {
            h16* base = (u.pn < 8) ? Q + u.pn * 256 : K + (u.pn - 8) * 256; const float sc = (u.pn < 8) ? 1.0f : 0.0625f;
            const int d0 = wc * 32 + 8 * fq;
            float pf_[8];
#pragma unroll
            for (int ai = 0; ai < 2; ++ai)
#pragma unroll
                for (int m = 0; m < 4; ++m) pf_[ai * 4 + m] = (float)pos[row0 + ai * 128 + m * 16];
            float irev[8];
#pragma unroll
            for (int q = 0; q < 8; ++q) irev[q] = __builtin_amdgcn_exp2f(-(float)(d0 + q) * (2.0f / 256.0f * 13.287712379549449f)) * 0.15915494309189535f;
#pragma unroll
            for (int ai = 0; ai < 2; ++ai)
#pragma unroll
                for (int m = 0; m < 4; ++m) {
                    const int row = row0 + ai * 128 + m * 16; const float pv = pf_[ai * 4 + m];
                    float o1[8], o2[8];
#pragma unroll
                    for (int n = 0; n < 2; ++n) { const f32x4 x1 = acc[ai][0][m][n], x2 = acc[ai][1][m][n];
#pragma unroll
                        for (int j = 0; j < 4; ++j) { const float fr_ = __builtin_amdgcn_fractf(pv * irev[4 * n + j]); const float cc = __builtin_amdgcn_cosf(fr_) * sc, ss = __builtin_amdgcn_sinf(fr_) * sc;
                            o1[4 * n + j] = x1[j] * cc - x2[j] * ss; o2[4 * n + j] = x2[j] * cc + x1[j] * ss; } }
                    u32x4 w1, w2; w1.x = pk_h2(o1[0], o1[1]); w1.y = pk_h2(o1[2], o1[3]); w1.z = pk_h2(o1[4], o1[5]); w1.w = pk_h2(o1[6], o1[7]);
                    w2.x = pk_h2(o2[0], o2[1]); w2.y = pk_h2(o2[2], o2[3]); w2.z = pk_h2(o2[4], o2[5]); w2.w = pk_h2(o2[6], o2[7]);
                    h16* rp = base + (size_t)row * RET_QK + d0;
                    *(u32x4*)rp = w1; *(u32x4*)(rp + 128) = w2;
                }
        } else {
            h16* base = (u.pn < 32) ? V + (u.pn - 16) * 256 : G + (u.pn - 32) * 256;
            const int c0 = wc * 32 + 8 * fq;
#pragma unroll
            for (int ai = 0; ai < 2; ++ai)
#pragma unroll
                for (int m = 0; m < 4; ++m) {
                    h16* rp = base + (size_t)(row0 + ai * 128 + m * 16) * RET_V + c0;
#pragma unroll
                    for (int bj = 0; bj < 2; ++bj) { const f32x4 v0 = acc[ai][bj][m][0], v1 = acc[ai][bj][m][1];
                        u32x4 w; w.x = pk_h2(v0[0], v0[1]); w.y = pk_h2(v0[2], v0[3]); w.z = pk_h2(v1[0], v1[1]); w.w = pk_h2(v1[2], v1[3]);
                        *(u32x4*)(rp + bj * 128) = w; }
                }
        }
    }
};
struct EpiMoba {
    static constexpr bool PERM = true, AFTER_DRAIN = false, STAMPED = false;
    __device__ __forceinline__ void park(float) const {}
    h16 *Q, *K, *V, *G; const int* pos;
    __device__ __forceinline__ void operator()(const f32x4 (&acc)[2][2][4][2], const pg8::Unit& u, int wr, int wc, int fr, int fq) const {
        const int row0 = u.pm * 256 + wr * 64 + fr; const int sel = u.pn >> 3;
        h16* base = (sel == 0 ? Q : sel == 1 ? K : sel == 2 ? V : G) + (u.pn & 7) * 256 + wc * 32 + 8 * fq;
        const bool rope = (sel < 2) && (wc == 0);
        float irev[8];
#pragma unroll
        for (int q = 0; q < 8; ++q) irev[q] = __builtin_amdgcn_exp2f(-(float)(((8 * fq) & 15) + q) * (2.0f / 32.0f * 18.931568569324174f)) * 0.15915494309189535f;
#pragma unroll
        for (int ai = 0; ai < 2; ++ai)
#pragma unroll
            for (int m = 0; m < 4; ++m) {
                const int row = row0 + ai * 128 + m * 16;
                float cc[8], ss[8];
                if (rope) { const float pv = (float)pos[row];
#pragma unroll
                    for (int q = 0; q < 8; ++q) { const float fr_ = __builtin_amdgcn_fractf(pv * irev[q]); cc[q] = __builtin_amdgcn_cosf(fr_); ss[q] = __builtin_amdgcn_sinf(fr_); } }
#pragma unroll
                for (int bj = 0; bj < 2; ++bj) {
                    float o[8];
#pragma unroll
                    for (int n = 0; n < 2; ++n)
#pragma unroll
                        for (int j = 0; j < 4; ++j) { const float x = acc[ai][bj][m][n][j]; float r = x;
                            if (rope) { const auto sw = __builtin_amdgcn_permlane32_swap(__builtin_bit_cast(unsigned, x), __builtin_bit_cast(unsigned, x), false, false);
                                const float y = __builtin_bit_cast(float, fq < 2 ? sw[1] : sw[0]);
                                r = (fq < 2) ? (x * cc[4 * n + j] - y * ss[4 * n + j]) : (x * cc[4 * n + j] + y * ss[4 * n + j]); }
                            o[4 * n + j] = r; }
                    u32x4 w; w.x = pk_h2(o[0], o[1]); w.y = pk_h2(o[2], o[3]); w.z = pk_h2(o[4], o[5]); w.w = pk_h2(o[6], o[7]);
                    *(u32x4*)(base + (size_t)row * MOBA_W + bj * 128) = w;
                }
            }
    }
};
struct EpiRes {
    static constexpr bool PERM = true, AFTER_DRAIN = false, STAMPED = false;
    __device__ __forceinline__ void park(float) const {}
    h16* Y; const float* gate;
    __device__ __forceinline__ void operator()(const f32x4 (&acc)[2][2][4][2], const pg8::Unit& u, int wr, int wc, int fr, int fq) const {
        const int row0 = u.pm * 256 + wr * 64 + fr, col0 = u.pn * 256 + wc * 32 + 8 * fq; const int b = u.pm >> 3;
        f32x4 gv[2][2];
#pragma unroll
        for (int bj = 0; bj < 2; ++bj)
#pragma unroll
            for (int n = 0; n < 2; ++n) gv[bj][n] = *(const f32x4*)(gate + (size_t)b * MODW + col0 + bj * 128 + n * 4);
#pragma unroll
        for (int ai = 0; ai < 2; ++ai)
#pragma unroll
            for (int m = 0; m < 4; ++m) { h16* rp = Y + (size_t)(row0 + ai * 128 + m * 16) * D + col0;
#pragma unroll
                for (int bj = 0; bj < 2; ++bj) { const f32x4 v0 = acc[ai][bj][m][0] * gv[bj][0], v1 = acc[ai][bj][m][1] * gv[bj][1];
                    u32x4 w; w.x = pk_h2(v0[0], v0[1]); w.y = pk_h2(v0[2], v0[3]); w.z = pk_h2(v1[0], v1[1]); w.w = pk_h2(v1[2], v1[3]);
                    *(u32x4*)(rp + bj * 128) = w; } }
    }
};


template <int MODE> struct EpiProbe {
    static constexpr bool PERM = true, AFTER_DRAIN = false, STAMPED = false;
    __device__ __forceinline__ void park(float) const {}
    h16* O;
    __device__ __forceinline__ void operator()(const f32x4 (&acc)[2][2][4][2], const pg8::Unit& u, int wr, int wc, int fr, int fq) const {
        const int lane = fr + 16 * fq;
#pragma unroll
        for (int ai = 0; ai < 2; ++ai)
#pragma unroll
            for (int m = 0; m < 4; ++m)
#pragma unroll
                for (int bj = 0; bj < 2; ++bj) { const f32x4 v0 = acc[ai][bj][m][0], v1 = acc[ai][bj][m][1];
                    u32x4 w; w.x = pk_h2(v0[0], v0[1]); w.y = pk_h2(v0[2], v0[3]); w.z = pk_h2(v1[0], v1[1]); w.w = pk_h2(v1[2], v1[3]);
                    if (MODE == 0) { asm volatile("" :: "v"(w)); }
                    else if (MODE == 1) { const int row = u.pm * 256 + wr * 128 + (ai * 4 + m) * 16 + bj * 8 + (lane >> 3); *(u32x4*)(O + (size_t)row * MOBA_W + (u.pn & 7) * 256 + wc * 64 + (lane & 7) * 8) = w; }
                    else { const int row = u.pm * 256 + wr * 64 + ai * 128 + m * 16 + fr; *(u32x4*)(O + (size_t)row * MOBA_W + (u.pn & 7) * 256 + bj * 128 + wc * 32 + 8 * fq) = w; }
                }
    }
};

constexpr int NWAVES = 8, NT = NWAVES * 64;
constexpr int RING_BYTES = 131072;
constexpr int MISC_OFF = RING_BYTES;
constexpr int LDS_BYTES = 147456;
constexpr int CW_BAR = 4096;
constexpr size_t CTL_ZERO_BYTES = 64 * 1024;

#define GAS __attribute__((address_space(1)))
#define XB_TMO      128
#define XB_XCNT(j)  (256  + 64 * (j))
#define XB_XSUB(j)  (1280 + 64 * (j))
#define XB_XGEN(j)  (2304 + 64 * (j))
#define XB_TOP      3328
#define XB_TOPGEN   3392
#define XCD_BAR_WORDS 3456
#define XB_SPIN_CAP (1u << 22)
__device__ __forceinline__ unsigned xb_ld(unsigned* p)              { return __hip_atomic_load(p, __ATOMIC_RELAXED, __HIP_MEMORY_SCOPE_AGENT); }
__device__ __forceinline__ unsigned xb_add(unsigned* p, unsigned v) { return __hip_atomic_fetch_add(p, v, __ATOMIC_RELAXED, __HIP_MEMORY_SCOPE_AGENT); }
__device__ __forceinline__ unsigned xb_xcc_id() { return (unsigned)__builtin_amdgcn_s_getreg((3 << 11) | 20) & 0xFu; }
#define XB_SPIN(cond, bar) do { unsigned _sp = 0; while (cond) { __builtin_amdgcn_s_sleep(1); \
    if ((++_sp & 255u) == 0u) { if (xb_ld(&(bar)[XB_TMO])) break; if (_sp > XB_SPIN_CAP) { atomicAdd(&(bar)[XB_TMO], 1u); break; } } } } while (0)
struct XcdBarrier { unsigned* bar; unsigned x; volatile LAS unsigned* st; };
__device__ __forceinline__ XcdBarrier xcd_barrier_post(unsigned* bar, volatile LAS unsigned* st) {
    XcdBarrier b; b.bar = bar; b.x = xb_xcc_id(); b.st = st;
    if (threadIdx.x == 0) (void)xb_add(&bar[XB_XCNT(b.x)], 1u);
    return b;
}
__device__ __forceinline__ void xcd_barrier_complete(unsigned* bar, unsigned x, unsigned& nloc, unsigned& nx) {
    const unsigned G = gridDim.x * gridDim.y * gridDim.z;
    unsigned sum, cnt, mine, sp = 0u;
    for (;;) {
        sum = 0u; cnt = 0u; mine = 0u;
#pragma unroll
        for (unsigned j = 0; j < 16; ++j) { const unsigned c = xb_ld(&bar[XB_XCNT(j)]); sum += c; cnt += (c > 0u) ? 1u : 0u; mine = (j == x) ? c : mine; }
        if (sum == G) break;
        __builtin_amdgcn_s_sleep(1);
        if ((++sp & 255u) == 0u) { if (xb_ld(&bar[XB_TMO])) break; if (sp > XB_SPIN_CAP) { atomicAdd(&bar[XB_TMO], 1u); break; } }
    }
    nloc = mine > 0u ? mine : 1u; nx = cnt > 0u ? cnt : 1u;
}
__device__ __forceinline__ void xcd_barrier(const XcdBarrier& b) {
    asm volatile("s_waitcnt vmcnt(0)" ::: "memory");
    __syncthreads();
    if (threadIdx.x == 0) {
        unsigned* bar = b.bar;
        __builtin_amdgcn_s_waitcnt(0);
        unsigned nloc = b.st[0], nx = b.st[1];
        if (nloc == 0u) { xcd_barrier_complete(bar, b.x, nloc, nx); b.st[0] = nloc; b.st[1] = nx; }
        const unsigned old = xb_add(&bar[XB_XSUB(b.x)], 1u);
        const unsigned gen = old / nloc;
        if (old + 1u == (gen + 1u) * nloc) {
            __builtin_amdgcn_fence(__ATOMIC_RELEASE, "agent");
            asm volatile("s_waitcnt vmcnt(0)" ::: "memory");
            const unsigned og = xb_add(&bar[XB_TOP], 1u);
            const unsigned tg = og / nx;
            if (og + 1u == (tg + 1u) * nx) xb_add(&bar[XB_TOPGEN], 1u);
            else XB_SPIN(xb_ld(&bar[XB_TOPGEN]) == tg, bar);
            __builtin_amdgcn_fence(__ATOMIC_ACQUIRE, "agent");
            xb_add(&bar[XB_XGEN(b.x)], 1u);
            asm volatile("s_waitcnt vmcnt(0)" ::: "memory");
        } else {
            XB_SPIN(xb_ld(&bar[XB_XGEN(b.x)]) == gen, bar);
            __builtin_amdgcn_fence(__ATOMIC_ACQUIRE, "agent");
            asm volatile("s_waitcnt vmcnt(0)" ::: "memory");
        }
    }
    __syncthreads();
}

__device__ __forceinline__ void mod_partial_item(int item, const float* c, const float* w_ada, float* part, float* ldsf) {
    constexpr int nks = NT / 16, kper = 512 / nks, nw = NT / 64;
    const int tid = opaque_tid();
    const int l = item / (96 * KSPLIT), r = item % (96 * KSPLIT), cg64 = r / KSPLIT, s = r % KSPLIT, k0 = s * 512, col0 = cg64 * 64;
    float* cs = ldsf;
    float* red = ldsf + 8 * 512;
    for (int i = tid; i < 8 * 512; i += NT) cs[i] = c[(i >> 9) * D + k0 + (i & 511)];
    __syncthreads();
    const int cg = tid & 15, ks = tid >> 4;
    f32x4 acc[8];
#pragma unroll
    for (int b = 0; b < 8; ++b) acc[b] = (f32x4){0.f, 0.f, 0.f, 0.f};
    const float* wp = w_ada + ((size_t)l * D + k0 + ks * kper) * MODW + col0 + cg * 4;
#pragma unroll 4
    for (int kk = 0; kk < kper; ++kk) { const f32x4 w = *(const f32x4*)(wp + (size_t)kk * MODW);
#pragma unroll
        for (int b = 0; b < 8; ++b) acc[b] += w * cs[b * 512 + ks * kper + kk]; }
#pragma unroll
    for (int b = 0; b < 8; ++b)
#pragma unroll
        for (int j = 0; j < 4; ++j) { float v = acc[b][j]; v += __shfl_xor(v, 16); v += __shfl_xor(v, 32); acc[b][j] = v; }
    if ((tid & 63) < 16) {
#pragma unroll
        for (int b = 0; b < 8; ++b) *(f32x4*)(red + ((tid >> 6) * 8 + b) * 64 + cg * 4) = acc[b];
    }
    __syncthreads();
    for (int o = tid; o < 512; o += NT) { float v = 0.f;
#pragma unroll
        for (int w = 0; w < nw; ++w) v += red[w * 512 + o];
        part[(((size_t)l * KSPLIT + s) * 8 + (o >> 6)) * MODW + col0 + (o & 63)] = v; }
    __syncthreads();
}
__device__ __forceinline__ void transpose_item(const float* W, int K, int N, h16* WT, float* scr, int item, int lane) {
    const int nblk = N / 32, kb = item / nblk, nb = item % nblk, k0 = 64 * kb, n0 = 32 * nb;
#pragma unroll 8
    for (int i = 0; i < 32; ++i) { const int kk = 2 * i + (lane >> 5); scr[kk * 33 + (lane & 31)] = W[(size_t)(k0 + kk) * N + n0 + (lane & 31)]; }
    asm volatile("s_waitcnt lgkmcnt(0)" ::: "memory");
    const int c = lane & 7;
#pragma unroll
    for (int j = 0; j < 4; ++j) { const int n = (lane >> 3) + 8 * j; const float* s = scr + (8 * c) * 33 + n;
        u32x4 o; o.x = pk_h2(s[0 * 33], s[1 * 33]); o.y = pk_h2(s[2 * 33], s[3 * 33]); o.z = pk_h2(s[4 * 33], s[5 * 33]); o.w = pk_h2(s[6 * 33], s[7 * 33]);
        *(u32x4*)(WT + (size_t)(n0 + n) * K + k0 + 8 * c) = o; }
    asm volatile("s_waitcnt lgkmcnt(0)" ::: "memory");
}
constexpr int IT_W0IN = (D / 64) * (RET_IN / 32), IT_W0OUT = (RET_V / 64) * (D / 32), IT_W1IN = (D / 64) * (MOBA_IN / 32), IT_W1OUT = (MOBA_W / 64) * (D / 32);
constexpr int IT_WALL = IT_W0IN + IT_W0OUT + IT_W1IN + IT_W1OUT;

struct Ptrs {
    const float *x, *c; const int* pos; const float *ret_w_in, *ret_w_out, *moba_w_in, *moba_w_out, *w_ada, *b_ada, *ln_g, *ln_b;
    float* out; float *MOD, *PART, *KMEAN; float2 *RCS0, *RCS1;
    h16 *W0IN, *W0OUT, *W1IN, *W1OUT, *X1H, *Q0, *K0, *V0, *G0, *H0, *H1, *Q1, *K1, *V1, *G1, *A1;
};

__device__ __forceinline__ void phase0(const Ptrs& P, float* ldsf, int bid, int G) {
    const int tid = opaque_tid(), wave = tid >> 6, lane = tid & 63;
    for (int it = bid; it < 2 * 96 * KSPLIT; it += G) mod_partial_item(it, P.c, P.w_ada, P.PART, ldsf);
    float* scr = ldsf + wave * (64 * 33);
    for (int it = bid * NWAVES + wave; it < IT_WALL; it += G * NWAVES) { int r = it;
        if (r < IT_W0IN) { transpose_item(P.ret_w_in, D, RET_IN, P.W0IN, scr, r, lane); continue; } r -= IT_W0IN;
        if (r < IT_W0OUT) { transpose_item(P.ret_w_out, RET_V, D, P.W0OUT, scr, r, lane); continue; } r -= IT_W0OUT;
        if (r < IT_W1IN) { transpose_item(P.moba_w_in, D, MOBA_IN, P.W1IN, scr, r, lane); continue; } r -= IT_W1IN;
        transpose_item(P.moba_w_out, MOBA_W, D, P.W1OUT, scr, r, lane); }
}
__device__ __forceinline__ void phase1(const Ptrs& P, float* ldsf, int bid, int G) {
    const int tid = opaque_tid();
    for (int i = bid * NT + tid; i < 2 * 8 * MODW; i += G * NT) { const int l = i / (8 * MODW), r = i % (8 * MODW), b = r / MODW, j = r % MODW;
        float v = P.b_ada[l * MODW + j];
#pragma unroll
        for (int s = 0; s < KSPLIT; ++s) v += P.PART[(((size_t)l * KSPLIT + s) * 8 + b) * MODW + j];
        P.MOD[i] = v; }
    for (int ch = bid; ch < M / 64; ch += G) {
        const int b = ch / (SEQ / 64);
        __syncthreads();
        for (int j = tid; j < 2 * D; j += NT) { float v = P.b_ada[j];
#pragma unroll
            for (int s = 0; s < KSPLIT; ++s) v += P.PART[(((size_t)0 * KSPLIT + s) * 8 + b) * MODW + j];
            ldsf[j] = v; }
        __syncthreads();
        for (int e = tid; e < 64 * D / 4; e += NT) { const int rr = e / (D / 4), j = (e % (D / 4)) * 4; const size_t off = (size_t)(ch * 64 + rr) * D + j;
            const f32x4 xv = *(const f32x4*)(P.x + off), sh = *(const f32x4*)(ldsf + j), sc = *(const f32x4*)(ldsf + D + j);
            const f32x4 h = xv * (sc + 1.0f) + sh; u32x2 w; w.x = pk_h2(h[0], h[1]); w.y = pk_h2(h[2], h[3]); *(u32x2*)(P.H0 + off) = w; }
    }
}
__device__ __forceinline__ void phase_norm_gate(const h16* O, const h16* Gt, h16* A, int bid, int G) {
    const int tid_ = opaque_tid(); const int gw = bid * NWAVES + (tid_ >> 6), lane = tid_ & 63, NGW = G * NWAVES;
    for (int it = gw; it < M * RET_HEADS; it += NGW) {
        const size_t off = (size_t)it * RET_DV + lane * 8;
        const h16x8 ov = *(const h16x8*)(O + off), gv = *(const h16x8*)(Gt + off);
        float o[8]; float s = 0.f;
#pragma unroll
        for (int j = 0; j < 8; ++j) { o[j] = (float)ov[j]; s += o[j]; }
        const float mu = wave_sum(s) * (1.0f / RET_DV); float q = 0.f;
#pragma unroll
        for (int j = 0; j < 8; ++j) { o[j] -= mu; q += o[j] * o[j]; }
        const float rstd = 1.0f / sqrtf(wave_sum(q) * (1.0f / RET_DV) + GN_EPS);
        float r[8];
#pragma unroll
        for (int j = 0; j < 8; ++j) r[j] = o[j] * rstd * silu((float)gv[j]);
        u32x4 w; w.x = pk_h2(r[0], r[1]); w.y = pk_h2(r[2], r[3]); w.z = pk_h2(r[4], r[5]); w.w = pk_h2(r[6], r[7]);
        *(u32x4*)(A + off) = w;
    }
}
template <bool XIN_H>
__device__ __forceinline__ void phase_layernorm(const void* xin_, const h16* Y, float* xout_f, h16* xout_h, const float* g, const float* bta, const float* mod_next, h16* H, int bid, int G) {
    const int tid_ = opaque_tid(); const int gw = bid * NWAVES + (tid_ >> 6), lane = tid_ & 63, NGW = G * NWAVES;
    for (int m = gw; m < M; m += NGW) {
        const h16* yr = Y + (size_t)m * D; f32x4 v[8]; float s = 0.f;
#pragma unroll
        for (int j = 0; j < 4; ++j) { const h16x8 yv = *(const h16x8*)(yr + j * 512 + lane * 8); f32x4 x0, x1;
            if (XIN_H) { const h16x8 xv = *(const h16x8*)((const h16*)xin_ + (size_t)m * D + j * 512 + lane * 8); x0 = (f32x4){(float)xv[0], (float)xv[1], (float)xv[2], (float)xv[3]}; x1 = (f32x4){(float)xv[4], (float)xv[5], (float)xv[6], (float)xv[7]}; }
            else { const float* xr = (const float*)xin_ + (size_t)m * D + j * 512 + lane * 8; x0 = *(const f32x4*)xr; x1 = *(const f32x4*)(xr + 4); }
            v[2 * j] = x0 * ALPHA + (f32x4){(float)yv[0], (float)yv[1], (float)yv[2], (float)yv[3]}; v[2 * j + 1] = x1 * ALPHA + (f32x4){(float)yv[4], (float)yv[5], (float)yv[6], (float)yv[7]}; }
#pragma unroll
        for (int j = 0; j < 8; ++j) s += (v[j][0] + v[j][1]) + (v[j][2] + v[j][3]);
        const float mu = wave_sum(s) * (1.0f / D); float q = 0.f;
#pragma unroll
        for (int j = 0; j < 8; ++j) { v[j] = v[j] - mu; q += (v[j][0] * v[j][0] + v[j][1] * v[j][1]) + (v[j][2] * v[j][2] + v[j][3] * v[j][3]); }
        const float rstd = 1.0f / sqrtf(wave_sum(q) * (1.0f / D) + LN_EPS);
        const int b = m / SEQ;
#pragma unroll
        for (int j = 0; j < 4; ++j) { const int c = j * 512 + lane * 8;
            const f32x4 xo0 = v[2 * j] * rstd * *(const f32x4*)(g + c) + *(const f32x4*)(bta + c), xo1 = v[2 * j + 1] * rstd * *(const f32x4*)(g + c + 4) + *(const f32x4*)(bta + c + 4);
            if (xout_f) { *(f32x4*)(xout_f + (size_t)m * D + c) = xo0; *(f32x4*)(xout_f + (size_t)m * D + c + 4) = xo1; }
            if (xout_h) { u32x4 w; w.x = pk_h2(xo0[0], xo0[1]); w.y = pk_h2(xo0[2], xo0[3]); w.z = pk_h2(xo1[0], xo1[1]); w.w = pk_h2(xo1[2], xo1[3]); *(u32x4*)(xout_h + (size_t)m * D + c) = w; }
            if (H) { const float* mp = mod_next + (size_t)b * MODW + c; const f32x4 sh0 = *(const f32x4*)mp, sh1 = *(const f32x4*)(mp + 4), sc0 = *(const f32x4*)(mp + D), sc1 = *(const f32x4*)(mp + D + 4);
                const f32x4 h0 = xo0 * (sc0 + 1.0f) + sh0, h1 = xo1 * (sc1 + 1.0f) + sh1; u32x4 w; w.x = pk_h2(h0[0], h0[1]); w.y = pk_h2(h0[2], h0[3]); w.z = pk_h2(h1[0], h1[1]); w.w = pk_h2(h1[2], h1[3]); *(u32x4*)(H + (size_t)m * D + c) = w; } }
    }
}

__device__ __forceinline__ void phase_retention_naive(const h16* Q, const h16* K, h16* VO, float* ldsf, int bid, int G) {
    constexpr int TT = 4;
    const int tid_ = opaque_tid(); const int half = tid_ >> 8, tid = tid_ & 255, vi = tid & 63, dq = tid >> 6;
    float* qs = ldsf + half * (3 * TT * 256);
    float* ks = qs + TT * 256;
    float* red = ks + TT * 256;
    for (int vb0 = bid * 2; vb0 < BATCH * RET_HEADS * 8; vb0 += 2 * G) {
        const int blk = vb0 + half, vg = blk & 7, h = (blk >> 3) & 7, b = blk >> 6;
        const float gamma = 1.0f - exp2f(-5.0f - (float)h);
        float S[64];
#pragma unroll
        for (int d = 0; d < 64; ++d) S[d] = 0.f;
        for (int t0 = 0; t0 < SEQ; t0 += TT) {
            __syncthreads();
            for (int i = tid; i < TT * 256; i += 256) { const int tt = i >> 8, d = i & 255; const size_t row = (size_t)(b * SEQ + t0 + tt);
                qs[tt * 256 + d] = (float)Q[row * RET_QK + h * 256 + d]; ks[tt * 256 + d] = (float)K[row * RET_QK + h * 256 + d]; }
            __syncthreads();
            float po[TT];
#pragma unroll
            for (int tt = 0; tt < TT; ++tt) {
                const float v = (float)VO[(size_t)(b * SEQ + t0 + tt) * RET_V + h * 512 + vg * 64 + vi];
                float a = 0.f;
#pragma unroll
                for (int d = 0; d < 64; ++d) { S[d] = gamma * S[d] + ks[tt * 256 + dq * 64 + d] * v; a += qs[tt * 256 + dq * 64 + d] * S[d]; }
                po[tt] = a;
            }
#pragma unroll
            for (int tt = 0; tt < TT; ++tt) red[(dq * TT + tt) * 64 + vi] = po[tt];
            __syncthreads();
            for (int i = tid; i < TT * 64; i += 256) { const int tt = i >> 6, v = i & 63;
                const float o = (red[(0 * TT + tt) * 64 + v] + red[(1 * TT + tt) * 64 + v]) + (red[(2 * TT + tt) * 64 + v] + red[(3 * TT + tt) * 64 + v]);
                VO[(size_t)(b * SEQ + t0 + tt) * RET_V + h * 512 + vg * 64 + v] = (h16)o; }
        }
        __syncthreads();
    }
}


typedef short v4i16 __attribute__((__vector_size__(8)));
__device__ __forceinline__ h16x4 lds_tr_read(LAS unsigned char* p) { const v4i16 v = __builtin_amdgcn_ds_read_tr16_b64_v4i16((LAS v4i16*)p); return __builtin_bit_cast(h16x4, v); }
__device__ __forceinline__ int off_b(int row, int ch) { return 256 * row + 16 * (ch ^ (((row & 3) << 2) | ((row >> 2) & 3))); }
__device__ __forceinline__ int tr_addr16(int lane, int c, int ks, int t) { const int g = lane >> 4, q = (lane & 15) >> 2, p = lane & 3; return off_b(32 * ks + 8 * g + 4 * t + q, 2 * c + (p >> 1)) + 8 * (p & 1); }
__device__ __forceinline__ h16x8 cat8(h16x4 a, h16x4 b) { return __builtin_shufflevector(a, b, 0, 1, 2, 3, 4, 5, 6, 7); }
__device__ __forceinline__ void fill_piece(LAS unsigned char* tile, const h16* g0, size_t pitch_elems, int piece, int lane) {
    const int rr = lane >> 4, cp = lane & 15, row = 4 * piece + rr, ch = cp ^ ((rr << 2) | (piece & 3));
    __builtin_amdgcn_global_load_lds((const unsigned*)(g0 + (size_t)row * pitch_elems + ch * 8), (LAS unsigned*)(tile + piece * 1024), 16, 0, 0);
}
constexpr int R_Q = 0, R_K = 32768, R_V = 65536, R_SC = 81920, SC_PITCH = 144;
__device__ __forceinline__ void phase_retention(const h16* Q, const h16* K, h16* VO, LAS unsigned char* L, int bid, int G) {
    const int tid = opaque_tid(), w = __builtin_amdgcn_readfirstlane(tid >> 6), lane = tid & 63, r = lane & 15, g = lane >> 4;
    for (int item = bid; item < BATCH * RET_HEADS * 4; item += G) {
        const int bh = (item & 7) | ((item >> 5) << 3), vs = (item >> 3) & 3, b = bh >> 3, h = bh & 7;
        const float l2g = log2f(1.0f - exp2f(-5.0f - (float)h));
        const int mt = w >> 1, nt0 = (w & 1) * 2;
        float mk[2][4], qd[4];
#pragma unroll
        for (int t = 0; t < 2; ++t)
#pragma unroll
            for (int i = 0; i < 4; ++i) { const int n = 16 * (nt0 + t) + r, m = 16 * mt + 4 * g + i; mk[t][i] = (n >= m) ? exp2f((float)(n - m) * l2g) : 0.0f; }
#pragma unroll
        for (int nt = 0; nt < 4; ++nt) qd[nt] = exp2f((float)(16 * nt + r + 1) * l2g);
        h16x8 kd[2];
#pragma unroll
        for (int ks = 0; ks < 2; ++ks)
#pragma unroll
            for (int j = 0; j < 8; ++j) kd[ks][j] = (h16)exp2f((float)(63 - (32 * ks + 8 * g + j)) * l2g);
        const float gC = exp2f(64.0f * l2g);
        f32x4 S[16];
#pragma unroll
        for (int dt = 0; dt < 16; ++dt) S[dt] = (f32x4){0.f, 0.f, 0.f, 0.f};
        const h16* Qg = Q + (size_t)b * SEQ * RET_QK + h * 256;
        const h16* Kg = K + (size_t)b * SEQ * RET_QK + h * 256;
        h16* Vg = VO + (size_t)b * SEQ * RET_V + h * 512 + vs * 128;
        for (int c = 0; c < SEQ / 64; ++c) {
            { const int hf = w >> 2, p0 = (w & 3) * 4;
#pragma unroll
                for (int i = 0; i < 4; ++i) { fill_piece(L + R_Q + hf * 16384, Qg + (size_t)c * 64 * RET_QK + hf * 128, RET_QK, p0 + i, lane);
                                              fill_piece(L + R_K + hf * 16384, Kg + (size_t)c * 64 * RET_QK + hf * 128, RET_QK, p0 + i, lane); }
#pragma unroll
                for (int i = 0; i < 2; ++i) fill_piece(L + R_V, Vg + (size_t)c * 64 * RET_V, RET_V, 2 * w + i, lane); }
            asm volatile("s_waitcnt vmcnt(0)" ::: "memory"); __builtin_amdgcn_s_barrier(); asm volatile("" ::: "memory");
            { f32x4 sc[2] = {(f32x4){0.f, 0.f, 0.f, 0.f}, (f32x4){0.f, 0.f, 0.f, 0.f}};
#pragma unroll
                for (int hf = 0; hf < 2; ++hf)
#pragma unroll
                    for (int s = 0; s < 4; ++s) {
                        const h16x8 a = *(const LAS h16x8*)(L + R_K + hf * 16384 + off_b(16 * mt + r, 4 * s + g));
                        const h16x8 b0 = *(const LAS h16x8*)(L + R_Q + hf * 16384 + off_b(16 * nt0 + r, 4 * s + g));
                        const h16x8 b1 = *(const LAS h16x8*)(L + R_Q + hf * 16384 + off_b(16 * (nt0 + 1) + r, 4 * s + g));
                        sc[0] = __builtin_amdgcn_mfma_f32_16x16x32_f16(a, b0, sc[0], 0, 0, 0);
                        sc[1] = __builtin_amdgcn_mfma_f32_16x16x32_f16(a, b1, sc[1], 0, 0, 0); }
#pragma unroll
                for (int t = 0; t < 2; ++t) { u32x2 wv; wv.x = pk_h2(sc[t][0] * mk[t][0], sc[t][1] * mk[t][1]); wv.y = pk_h2(sc[t][2] * mk[t][2], sc[t][3] * mk[t][3]);
                    *(LAS u32x2*)(L + R_SC + (16 * (nt0 + t) + r) * SC_PITCH + 2 * (16 * mt + 4 * g)) = wv; } }
            f32x4 o3[4];
#pragma unroll
            for (int nt = 0; nt < 4; ++nt) o3[nt] = (f32x4){0.f, 0.f, 0.f, 0.f};
#pragma unroll
            for (int s = 0; s < 8; ++s) {
                const f32x4 s0 = S[2 * s], s1 = S[2 * s + 1];
                h16x8 af; af[0] = (h16)s0[0]; af[1] = (h16)s0[1]; af[2] = (h16)s0[2]; af[3] = (h16)s0[3]; af[4] = (h16)s1[0]; af[5] = (h16)s1[1]; af[6] = (h16)s1[2]; af[7] = (h16)s1[3];
                const int hf = s >> 2, ss = s & 3;
#pragma unroll
                for (int nt = 0; nt < 4; ++nt) {
                    const h16x4 lo = *(const LAS h16x4*)(L + R_Q + hf * 16384 + off_b(16 * nt + r, 4 * ss + (g >> 1)) + 8 * (g & 1));
                    const h16x4 hi = *(const LAS h16x4*)(L + R_Q + hf * 16384 + off_b(16 * nt + r, 4 * ss + 2 + (g >> 1)) + 8 * (g & 1));
                    o3[nt] = __builtin_amdgcn_mfma_f32_16x16x32_f16(af, cat8(lo, hi), o3[nt], 0, 0, 0); }
            }
            asm volatile("s_waitcnt lgkmcnt(0)" ::: "memory"); __builtin_amdgcn_s_barrier(); asm volatile("" ::: "memory");
            h16x8 vf[2];
#pragma unroll
            for (int ks = 0; ks < 2; ++ks) vf[ks] = cat8(lds_tr_read(L + R_V + tr_addr16(lane, w, ks, 0)), lds_tr_read(L + R_V + tr_addr16(lane, w, ks, 1)));
#pragma unroll
            for (int nt = 0; nt < 4; ++nt) {
                f32x4 o2 = (f32x4){0.f, 0.f, 0.f, 0.f};
#pragma unroll
                for (int ks = 0; ks < 2; ++ks) { const h16x8 bf = *(const LAS h16x8*)(L + R_SC + (16 * nt + r) * SC_PITCH + 2 * (32 * ks + 8 * g));
                    o2 = __builtin_amdgcn_mfma_f32_16x16x32_f16(vf[ks], bf, o2, 0, 0, 0); }
                const f32x4 o = o2 + o3[nt] * qd[nt];
                u32x2 wv; wv.x = pk_h2(o[0], o[1]); wv.y = pk_h2(o[2], o[3]);
                *(u32x2*)(Vg + (size_t)(c * 64 + 16 * nt + r) * RET_V + 16 * w + 4 * g) = wv; }
            const h16x8 vk0 = vf[0] * kd[0], vk1 = vf[1] * kd[1];
#pragma unroll
            for (int dt = 0; dt < 16; ++dt) {
                const int hf = dt >> 3, c8 = dt & 7;
                const h16x8 a0 = cat8(lds_tr_read(L + R_K + hf * 16384 + tr_addr16(lane, c8, 0, 0)), lds_tr_read(L + R_K + hf * 16384 + tr_addr16(lane, c8, 0, 1)));
                const h16x8 a1 = cat8(lds_tr_read(L + R_K + hf * 16384 + tr_addr16(lane, c8, 1, 0)), lds_tr_read(L + R_K + hf * 16384 + tr_addr16(lane, c8, 1, 1)));
                f32x4 acc = S[dt] * gC;
                acc = __builtin_amdgcn_mfma_f32_16x16x32_f16(a0, vk0, acc, 0, 0, 0);
                acc = __builtin_amdgcn_mfma_f32_16x16x32_f16(a1, vk1, acc, 0, 0, 0);
                S[dt] = acc; }
            asm volatile("s_waitcnt lgkmcnt(0)" ::: "memory"); __builtin_amdgcn_s_barrier(); asm volatile("" ::: "memory");
        }
    }
    asm volatile("s_waitcnt vmcnt(0)" ::: "memory"); __syncthreads();
}

__device__ __forceinline__ void phase_kmean(const h16* K, float* kmean, int bid, int G) {
    const int tid_ = opaque_tid();
    for (int i = bid * NT + tid_; i < BATCH * NBLK * MOBA_W; i += G * NT) {
        const int col = i % MOBA_W, bb = i / MOBA_W;
        float s = 0.f; for (int t = 0; t < MOBA_BLOCK; ++t) s += (float)K[((size_t)bb * MOBA_BLOCK + t) * MOBA_W + col];
        kmean[i] = s * (1.0f / MOBA_BLOCK); }
}
__device__ __forceinline__ void phase_moba_naive(const h16* Q, const h16* K, const h16* V, const h16* Gt, const float* kmean, h16* A, int bid, int G) {
    const int tid_ = opaque_tid(); const int half = tid_ >> 8, tid = tid_ & 255, qi = tid >> 2, part = tid & 3;
    for (int vb0 = bid * 2; vb0 < BATCH * MOBA_HEADS * 32; vb0 += 2 * G) {
        const int blk = vb0 + half, qt = blk & 31, h = (blk >> 5) & 15, b = blk >> 9;
        const int t = qt * 64 + qi, own = t >> 8; const size_t row = (size_t)b * SEQ + t;
        float q[32];
#pragma unroll
        for (int j = 0; j < 32; ++j) q[j] = (float)Q[row * MOBA_W + h * 128 + part * 32 + j];
        float gs[NBLK]; unsigned sel = 0u;
#pragma unroll
        for (int n = 0; n < NBLK; ++n) { float a = 0.f;
#pragma unroll
            for (int j = 0; j < 32; ++j) a += q[j] * kmean[((size_t)(b * NBLK + n)) * MOBA_W + h * 128 + part * 32 + j];
            a += __shfl_xor(a, 1); a += __shfl_xor(a, 2); gs[n] = a; }
#pragma unroll
        for (int r = 0; r < 3; ++r) { int best = -1; float bv = -3e38f;
#pragma unroll
            for (int n = 0; n < NBLK; ++n) if (n < own && !((sel >> n) & 1u) && gs[n] > bv) { bv = gs[n]; best = n; }
            if (best >= 0) sel |= 1u << best; }
        const float scale = 0.08838834764831845f;
        float mrun = -1e30f, lrun = 0.f, acc[32];
#pragma unroll
        for (int j = 0; j < 32; ++j) acc[j] = 0.f;
        for (int n = 0; n <= own; ++n) {
            const bool use = (n == own) || ((sel >> n) & 1u);
            if (!use) continue;
            const int kend = (n == own) ? (t & 255) + 1 : MOBA_BLOCK;
            for (int kk = 0; kk < kend; ++kk) {
                const size_t krow = (size_t)b * SEQ + n * MOBA_BLOCK + kk;
                const h16* kp = K + krow * MOBA_W + h * 128 + part * 32; float s = 0.f;
#pragma unroll
                for (int j = 0; j < 32; ++j) s += q[j] * (float)kp[j];
                s += __shfl_xor(s, 1); s += __shfl_xor(s, 2); s *= scale;
                const float mn = fmaxf(mrun, s), al = __expf(mrun - mn), p = __expf(s - mn);
                lrun = lrun * al + p; mrun = mn;
                const h16* vp = V + krow * MOBA_W + h * 128 + part * 32;
#pragma unroll
                for (int j = 0; j < 32; ++j) acc[j] = acc[j] * al + p * (float)vp[j];
            }
        }
        const float inv = 1.0f / lrun;
#pragma unroll
        for (int j = 0; j < 32; ++j) { const size_t o = row * MOBA_W + h * 128 + part * 32 + j; A[o] = (h16)(acc[j] * inv * silu((float)Gt[o])); }
    }
}


#define TR_READ(dst, addr, off) asm volatile("ds_read_b64_tr_b16 %0, %1 offset:%2" : "=v"(dst) : "v"(addr), "i"(off))
__device__ __forceinline__ int off_v(int row, int ch) { return 256 * row + 16 * (ch ^ (2 * (row & 7))); }
#define LDS_READ128(dst, addr, off) asm volatile("ds_read_b128 %0, %1 offset:%2" : "=v"(dst) : "v"(addr), "i"(off))
__device__ __forceinline__ void fill_piece_k(LAS unsigned char* tile, const h16* g0, size_t pitch_elems, int piece, int lane) {
    const int rr = lane >> 4, cp = lane & 15, row = 4 * piece + rr, ch = cp ^ (row & 15);
    __builtin_amdgcn_global_load_lds((const unsigned*)(g0 + (size_t)row * pitch_elems + ch * 8), (LAS unsigned*)(tile + piece * 1024), 16, 0, 0);
}
__device__ __forceinline__ void fill_piece_v(LAS unsigned char* tile, const h16* g0, size_t pitch_elems, int piece, int lane) {
    const int rr = lane >> 4, cp = lane & 15, row = 4 * piece + rr, ch = cp ^ (2 * (row & 7));
    __builtin_amdgcn_global_load_lds((const unsigned*)(g0 + (size_t)row * pitch_elems + ch * 8), (LAS unsigned*)(tile + piece * 1024), 16, 0, 0);
}
__device__ __forceinline__ float xmax16(float x) { const auto r_ = __builtin_amdgcn_permlane16_swap(__builtin_bit_cast(unsigned, x), __builtin_bit_cast(unsigned, x), false, false); return fmaxf(__builtin_bit_cast(float, r_[0]), __builtin_bit_cast(float, r_[1])); }
__device__ __forceinline__ float xmax32(float x) { const auto r_ = __builtin_amdgcn_permlane32_swap(__builtin_bit_cast(unsigned, x), __builtin_bit_cast(unsigned, x), false, false); return fmaxf(__builtin_bit_cast(float, r_[0]), __builtin_bit_cast(float, r_[1])); }
template <int VAR>
__device__ __forceinline__ void phase_moba(const h16* Q, const h16* K, const h16* V, const h16* Gt, const float* kmean, h16* A, LAS unsigned char* L, int bid, int G) {
    const int tid = opaque_tid(), w = __builtin_amdgcn_readfirstlane(tid >> 6), lane = tid & 63, r = lane & 15, g = lane >> 4;
    const float NEG_INF = -__builtin_inff();
    const float cs = 0.08838834764831845f * 1.4426950408889634f;
    const bool lead = w < 4;
    unsigned long long stamp_t = 0, stamp_sum = 0; int stamp_n = 0;
    for (int vb = bid; vb < BATCH * MOBA_HEADS * 4; vb += G) {
        const int xcd = vb & 7, jj = vb >> 3, pr = jj & 3, bh = xcd + 8 * (jj >> 2), b = bh >> 4, h = bh & 15;
        const h16* Kg = K + (size_t)b * SEQ * MOBA_W + h * 128;
        const h16* Vg = V + (size_t)b * SEQ * MOBA_W + h * 128;
        for (int half = 0; half < 2; ++half) {
            const int qb = half ? 7 - pr : pr;
            const size_t row0 = (size_t)b * SEQ + qb * 256 + 32 * w;
            h16x8 qf[2][4];
#pragma unroll
            for (int qt = 0; qt < 2; ++qt)
#pragma unroll
                for (int s = 0; s < 4; ++s) qf[qt][s] = *(const h16x8*)(Q + (row0 + 16 * qt + r) * MOBA_W + h * 128 + 32 * s + 8 * g);
            unsigned sel[2] = {0u, 0u};
            if (qb > 0) {
                f32x4 gt[2] = {(f32x4){0.f, 0.f, 0.f, 0.f}, (f32x4){0.f, 0.f, 0.f, 0.f}};
#pragma unroll
                for (int s = 0; s < 4; ++s) {
                    h16x8 hi, lo;
                    const float* kp = kmean + ((size_t)(b * NBLK + (r & 7))) * MOBA_W + h * 128 + 32 * s + 8 * g;
                    const f32x4 k0 = *(const f32x4*)kp, k1 = *(const f32x4*)(kp + 4);
#pragma unroll
                    for (int j = 0; j < 8; ++j) { const float kv = (r < 8) ? (j < 4 ? k0[j & 3] : k1[j & 3]) : 0.0f; const h16 hh = (h16)kv; hi[j] = hh; lo[j] = (h16)(kv - (float)hh); }
#pragma unroll
                    for (int qt = 0; qt < 2; ++qt) { gt[qt] = __builtin_amdgcn_mfma_f32_16x16x32_f16(hi, qf[qt][s], gt[qt], 0, 0, 0); gt[qt] = __builtin_amdgcn_mfma_f32_16x16x32_f16(lo, qf[qt][s], gt[qt], 0, 0, 0); }
                }
#pragma unroll
                for (int qt = 0; qt < 2; ++qt) {
                    float gs[8];
#pragma unroll
                    for (int i = 0; i < 4; ++i) { gs[i] = __shfl(gt[qt][i], r); gs[4 + i] = __shfl(gt[qt][i], r + 16); }
                    unsigned sm = 0u;
#pragma unroll
                    for (int rr = 0; rr < 3; ++rr) { int best = -1; float bv = -3e38f;
#pragma unroll
                        for (int n = 0; n < NBLK; ++n) if (n < qb && !((sm >> n) & 1u) && gs[n] > bv) { bv = gs[n]; best = n; }
                        if (best >= 0) sm |= 1u << best; }
                    sel[qt] = sm;
                }
            }
            f32x4 o[8][2];
#pragma unroll
            for (int dt = 0; dt < 8; ++dt) { o[dt][0] = (f32x4){0.f, 0.f, 0.f, 0.f}; o[dt][1] = (f32x4){0.f, 0.f, 0.f, 0.f}; }
            float mrun[2] = {NEG_INF, NEG_INF}, lrun[2] = {0.f, 0.f};
            const int ntiles = 4 * (qb + 1);
            f32x4 st[4][2]; float marg[2] = {0.f, 0.f}, alr[2] = {1.f, 1.f}; bool chg = false, needB = false; int slotB = 0;
#pragma unroll
            for (int kt = 0; kt < 4; ++kt) { st[kt][0] = (f32x4){0.f, 0.f, 0.f, 0.f}; st[kt][1] = (f32x4){0.f, 0.f, 0.f, 0.f}; }
#define MOBA_FILL(it_, slot_) do { const int n_ = (it_) < 4 ? qb : (((it_) - 4) >> 2); const size_t k0_ = (size_t)n_ * 256 + 64 * ((it_) & 3); \
                LAS unsigned char* kb_ = L + (slot_) * 32768; int ln_ = lane; asm volatile("" : "+v"(ln_)); \
                fill_piece_k(kb_, Kg + k0_ * MOBA_W, MOBA_W, 2 * w, ln_); fill_piece_k(kb_, Kg + k0_ * MOBA_W, MOBA_W, 2 * w + 1, ln_); \
                fill_piece_v(kb_ + 16384, Vg + k0_ * MOBA_W, MOBA_W, 2 * w, ln_); fill_piece_v(kb_ + 16384, Vg + k0_ * MOBA_W, MOBA_W, 2 * w + 1, ln_); } while (0)
#define MOBA_A(it_) do { const int ita_ = (it_); const bool own_ = ita_ < 4; const int n_ = own_ ? qb : ((ita_ - 4) >> 2), t_ = ita_ & 3; \
                needB = (VAR != 1) && (own_ ? (t_ <= (w >> 1)) : (__any((int)(((sel[0] | sel[1]) >> n_) & 1u)) != 0)); slotB = ita_ & 3; \
                if (needB) { \
                    unsigned kslot_ = (unsigned)(ita_ & 3) * 32768u; asm volatile("" : "+s"(kslot_));     \
                    h16x8 kf[4][4]; unsigned ka_[4]; \
                    { int ln_ = lane; asm volatile("" : "+v"(ln_)); const int r_ = ln_ & 15, g_ = ln_ >> 4; const unsigned kbase = (unsigned)(size_t)L + kslot_ + (unsigned)(256 * r_); \
                        _Pragma("unroll") for (int s = 0; s < 4; ++s) ka_[s] = kbase + (unsigned)(16 * ((4 * s + g_) ^ r_)); } \
                    _Pragma("unroll") for (int kt = 0; kt < 4; ++kt) { st[kt][0] = (f32x4){0.f, 0.f, 0.f, 0.f}; st[kt][1] = (f32x4){0.f, 0.f, 0.f, 0.f}; } \
                      \
                    LDS_READ128(kf[0][0], ka_[0], 0); LDS_READ128(kf[1][0], ka_[0], 4096); LDS_READ128(kf[2][0], ka_[0], 8192); LDS_READ128(kf[3][0], ka_[0], 12288); \
                    LDS_READ128(kf[0][1], ka_[1], 0); LDS_READ128(kf[1][1], ka_[1], 4096); LDS_READ128(kf[2][1], ka_[1], 8192); LDS_READ128(kf[3][1], ka_[1], 12288); \
                    asm volatile("s_waitcnt lgkmcnt(4)" ::: "memory"); __builtin_amdgcn_sched_barrier(0); \
                    _Pragma("unroll") for (int kt = 0; kt < 4; ++kt) { \
                            st[kt][0] = __builtin_amdgcn_mfma_f32_16x16x32_f16(kf[kt][0], qf[0][0], st[kt][0], 0, 0, 0); \
                            st[kt][1] = __builtin_amdgcn_mfma_f32_16x16x32_f16(kf[kt][0], qf[1][0], st[kt][1], 0, 0, 0); } \
                    __builtin_amdgcn_sched_barrier(0); \
                    LDS_READ128(kf[0][2], ka_[2], 0); LDS_READ128(kf[1][2], ka_[2], 4096); LDS_READ128(kf[2][2], ka_[2], 8192); LDS_READ128(kf[3][2], ka_[2], 12288); \
                    asm volatile("s_waitcnt lgkmcnt(4)" ::: "memory"); __builtin_amdgcn_sched_barrier(0); \
                    _Pragma("unroll") for (int kt = 0; kt < 4; ++kt) { \
                            st[kt][0] = __builtin_amdgcn_mfma_f32_16x16x32_f16(kf[kt][1], qf[0][1], st[kt][0], 0, 0, 0); \
                            st[kt][1] = __builtin_amdgcn_mfma_f32_16x16x32_f16(kf[kt][1], qf[1][1], st[kt][1], 0, 0, 0); } \
                    __builtin_amdgcn_sched_barrier(0); \
                    LDS_READ128(kf[0][3], ka_[3], 0); LDS_READ128(kf[1][3], ka_[3], 4096); LDS_READ128(kf[2][3], ka_[3], 8192); LDS_READ128(kf[3][3], ka_[3], 12288); \
                    asm volatile("s_waitcnt lgkmcnt(4)" ::: "memory"); __builtin_amdgcn_sched_barrier(0); \
                    _Pragma("unroll") for (int kt = 0; kt < 4; ++kt) { \
                            st[kt][0] = __builtin_amdgcn_mfma_f32_16x16x32_f16(kf[kt][2], qf[0][2], st[kt][0], 0, 0, 0); \
                            st[kt][1] = __builtin_amdgcn_mfma_f32_16x16x32_f16(kf[kt][2], qf[1][2], st[kt][1], 0, 0, 0); } \
                    __builtin_amdgcn_sched_barrier(0); asm volatile("s_waitcnt lgkmcnt(0)" ::: "memory"); __builtin_amdgcn_sched_barrier(0); \
                    _Pragma("unroll") for (int kt = 0; kt < 4; ++kt) { \
                            st[kt][0] = __builtin_amdgcn_mfma_f32_16x16x32_f16(kf[kt][3], qf[0][3], st[kt][0], 0, 0, 0); \
                            st[kt][1] = __builtin_amdgcn_mfma_f32_16x16x32_f16(kf[kt][3], qf[1][3], st[kt][1], 0, 0, 0); } \
                    const bool diag_ = own_ && (t_ == (w >> 1)); chg = false; \
                    _Pragma("unroll") for (int qt = 0; qt < 2; ++qt) { \
                        const bool rowsel = own_ || (((sel[qt] >> n_) & 1u) != 0u); \
                        if (diag_) { const int qpos = 32 * w + 16 * qt + r; \
                            _Pragma("unroll") for (int kt = 0; kt < 4; ++kt) _Pragma("unroll") for (int i = 0; i < 4; ++i) { const int kpos = 64 * t_ + 16 * kt + 4 * g + i; if (kpos > qpos) st[kt][qt][i] = NEG_INF; } } \
                        float mx = NEG_INF; \
                        _Pragma("unroll") for (int kt = 0; kt < 4; ++kt) { mx = fmaxf(fmaxf(mx, st[kt][qt][0]), st[kt][qt][1]); mx = fmaxf(fmaxf(mx, st[kt][qt][2]), st[kt][qt][3]); } \
                        mx = xmax32(xmax16(mx)); \
                        mx = rowsel ? mx * cs : NEG_INF; \
                        const float mold = mrun[qt]; \
                        const float mn = (mx > mold + 6.0f) ? mx : mold;            \
                        marg[qt] = rowsel ? mn : __builtin_inff();                     \
                        alr[qt] = __builtin_amdgcn_exp2f(mold - mn); chg = chg || (mn != mold); mrun[qt] = mn; } \
                    { float sum0 = 0.f;     \
                        _Pragma("unroll") for (int kt = 0; kt < 4; ++kt) _Pragma("unroll") for (int i = 0; i < 4; ++i) { const float p = __builtin_amdgcn_exp2f(__builtin_fmaf(st[kt][0][i], cs, -marg[0])); st[kt][0][i] = p; sum0 += p; } \
                        lrun[0] = lrun[0] * alr[0] + sum0; } \
                } } while (0)
#define MOBA_B() do { if (needB) { \
                    unsigned vslot_ = (unsigned)slotB * 32768u + 16384u; asm volatile("" : "+s"(vslot_)); \
                    int lnb_ = lane; asm volatile("" : "+v"(lnb_)); const int q4 = (lnb_ & 15) >> 2, p4 = lnb_ & 3, gb_ = lnb_ >> 4; \
                    const unsigned x32 = (unsigned)(((4 * gb_ + q4) & 7) * 32); \
                    const unsigned vbase = (unsigned)(size_t)L + vslot_ + (unsigned)(256 * (4 * gb_ + q4) + 16 * (p4 >> 1) + 8 * (p4 & 1)); \
                    h16x4 vr[8][2][2]; \
                    _Pragma("unroll") for (int dt = 0; dt < 4; ++dt) { const unsigned va = vbase + (((unsigned)dt * 32u) ^ x32); \
                        TR_READ(vr[dt][0][0], va, 0); TR_READ(vr[dt][0][1], va, 4096); TR_READ(vr[dt][1][0], va, 8192); TR_READ(vr[dt][1][1], va, 12288); } \
                    if (__any((int)chg)) { _Pragma("unroll") for (int dt = 0; dt < 8; ++dt) { o[dt][0] = o[dt][0] * alr[0]; o[dt][1] = o[dt][1] * alr[1]; } } \
                    h16x8 pf[2][2]; \
                    _Pragma("unroll") for (int qt = 0; qt < 2; ++qt) { if (qt == 1) { float sum = 0.f; \
                        _Pragma("unroll") for (int kt = 0; kt < 4; ++kt) _Pragma("unroll") for (int i = 0; i < 4; ++i) { const float p = __builtin_amdgcn_exp2f(__builtin_fmaf(st[kt][qt][i], cs, -marg[qt])); st[kt][qt][i] = p; sum += p; } \
                        lrun[qt] = lrun[qt] * alr[qt] + sum; } \
                        _Pragma("unroll") for (int ks = 0; ks < 2; ++ks) { const f32x4 p0 = st[2 * ks][qt], p1 = st[2 * ks + 1][qt]; h16x8 f; \
                            f[0] = (h16)p0[0]; f[1] = (h16)p0[1]; f[2] = (h16)p0[2]; f[3] = (h16)p0[3]; f[4] = (h16)p1[0]; f[5] = (h16)p1[1]; f[6] = (h16)p1[2]; f[7] = (h16)p1[3]; pf[ks][qt] = f; } } \
                    __builtin_amdgcn_sched_barrier(0); \
                    _Pragma("unroll") for (int dt = 4; dt < 8; ++dt) { const unsigned va = vbase + (((unsigned)dt * 32u) ^ x32); \
                        TR_READ(vr[dt][0][0], va, 0); TR_READ(vr[dt][0][1], va, 4096); TR_READ(vr[dt][1][0], va, 8192); TR_READ(vr[dt][1][1], va, 12288); } \
                    asm volatile("s_waitcnt lgkmcnt(15)" ::: "memory"); __builtin_amdgcn_sched_barrier(0);     \
                    _Pragma("unroll") for (int dt = 0; dt < 4; ++dt) _Pragma("unroll") for (int ks = 0; ks < 2; ++ks) { const h16x8 a = cat8(vr[dt][ks][0], vr[dt][ks][1]); \
                            o[dt][0] = __builtin_amdgcn_mfma_f32_16x16x32_f16(a, pf[ks][0], o[dt][0], 0, 0, 0); \
                            o[dt][1] = __builtin_amdgcn_mfma_f32_16x16x32_f16(a, pf[ks][1], o[dt][1], 0, 0, 0); } \
                    __builtin_amdgcn_sched_barrier(0); asm volatile("s_waitcnt lgkmcnt(0)" ::: "memory"); __builtin_amdgcn_sched_barrier(0); \
                    _Pragma("unroll") for (int dt = 4; dt < 8; ++dt) _Pragma("unroll") for (int ks = 0; ks < 2; ++ks) { const h16x8 a = cat8(vr[dt][ks][0], vr[dt][ks][1]); \
                            o[dt][0] = __builtin_amdgcn_mfma_f32_16x16x32_f16(a, pf[ks][0], o[dt][0], 0, 0, 0); \
                            o[dt][1] = __builtin_amdgcn_mfma_f32_16x16x32_f16(a, pf[ks][1], o[dt][1], 0, 0, 0); } \
                } } while (0)
#define MOBA_TOP(it_) do { if ((it_) + 1 < ntiles) asm volatile("s_waitcnt vmcnt(4)" ::: "memory"); else asm volatile("s_waitcnt vmcnt(0)" ::: "memory");     \
                asm volatile("s_waitcnt lgkmcnt(0)" ::: "memory"); __builtin_amdgcn_s_barrier(); asm volatile("" ::: "memory"); \
                if ((it_) + 2 < ntiles) MOBA_FILL((it_) + 2, ((it_) + 2) & 3); } while (0)
#define MOBA_MID() do { asm volatile("s_waitcnt lgkmcnt(0)" ::: "memory"); __builtin_amdgcn_s_barrier(); asm volatile("" ::: "memory"); } while (0)
#define STAMP() do { if (PROBE_ATT_STAMP >= 0) { __builtin_amdgcn_sched_barrier(0); stamp_t = __builtin_amdgcn_s_memtime(); __builtin_amdgcn_s_waitcnt(0xC07F); __builtin_amdgcn_sched_barrier(0); } } while (0)
#define STAMP_ACC(k) do { if (PROBE_ATT_STAMP >= 0) { __builtin_amdgcn_sched_barrier(0); const unsigned long long t2_ = __builtin_amdgcn_s_memtime(); __builtin_amdgcn_s_waitcnt(0xC07F); if (PROBE_ATT_STAMP == (k)) stamp_sum += t2_ - stamp_t; stamp_t = t2_; __builtin_amdgcn_sched_barrier(0); } } while (0)
            stamp_n += ntiles;
            MOBA_FILL(0, 0); MOBA_FILL(1, 1);
            if (lead) {
                for (int it = 0; it < ntiles; ++it) { STAMP(); MOBA_TOP(it); STAMP_ACC(2); MOBA_A(it); STAMP_ACC(0); MOBA_MID(); STAMP_ACC(3); MOBA_B(); STAMP_ACC(1); }
                MOBA_MID();
            } else {
                for (int it = 0; it < ntiles; ++it) { STAMP(); MOBA_TOP(it); STAMP_ACC(2); MOBA_B(); STAMP_ACC(1); MOBA_MID(); STAMP_ACC(3); MOBA_A(it); STAMP_ACC(0); }
                MOBA_MID();
                MOBA_B();
            }
#undef MOBA_FILL
#undef MOBA_A
#undef MOBA_B
#undef MOBA_TOP
#undef MOBA_MID
#pragma unroll
            for (int qt = 0; qt < 2; ++qt) { float lt = lrun[qt]; lt += __shfl_xor(lt, 16); lt += __shfl_xor(lt, 32); const float inv = 1.0f / lt; const size_t rowoff = (row0 + 16 * qt + r) * MOBA_W + h * 128 + 4 * g;
#pragma unroll
                for (int dt = 0; dt < 8; ++dt) { const h16x4 gv = *(const h16x4*)(Gt + rowoff + 16 * dt); const f32x4 ov = o[dt][qt] * inv;
                    u32x2 wv; wv.x = pk_h2(ov[0] * silu((float)gv[0]), ov[1] * silu((float)gv[1])); wv.y = pk_h2(ov[2] * silu((float)gv[2]), ov[3] * silu((float)gv[3]));
                    *(u32x2*)(A + rowoff + 16 * dt) = wv; } }
        }
    }
    if (PROBE_ATT_STAMP >= 0 && VAR == 0 && bid == 0 && w == PROBE_ATT_WAVE && lane == 0) ((float*)L)[0] = 0.f;
    if (PROBE_ATT_STAMP >= 0 && VAR == 0 && bid == 0 && w == PROBE_ATT_WAVE && lane == 0) *(float*)kmean = (float)stamp_sum / (float)stamp_n * 0.01f;
    asm volatile("s_waitcnt vmcnt(0)" ::: "memory"); __syncthreads();
}

struct Args { const void* in[11]; float* out; unsigned char* ws; int ph_lo, ph_hi; };
constexpr int NPHASE = 12;
#ifndef PROBE_DUP
#define PROBE_DUP 0u
#endif
#ifndef PROBE_MOBA_VAR
#define PROBE_MOBA_VAR -1
#endif
#ifndef PROBE_DUMMY_GEMM
#define PROBE_DUMMY_GEMM 0
#define PROBE_DG_N 3072
#define PROBE_DG_K 1024
#define PROBE_DG_BF16 false
#define PROBE_DG_FIXED 0
#define PROBE_DG_EPI -1
#endif
#ifndef PROBE_CLOCK_PHASE
#define PROBE_CLOCK_PHASE -1
#endif
#ifndef PROBE_XCC
#define PROBE_XCC 0
#endif
#ifndef PROBE_BAR2
#define PROBE_BAR2 0
#endif
__global__ void __launch_bounds__(NT, 2) mk_fwd(Args a) {
    extern __shared__ __attribute__((aligned(16))) unsigned char lds[];
    LAS unsigned char* L = (LAS unsigned char*)lds;
    float* ldsf = (float*)lds;
    const int tid = threadIdx.x, bid = blockIdx.x, G = gridDim.x;
    volatile LAS unsigned* MISC = (volatile LAS unsigned*)(L + MISC_OFF);
    if (tid < 32) MISC[tid] = 0u;
    __syncthreads();
    unsigned char* ws = a.ws;
    Ptrs P;
    P.x = (const float*)a.in[0]; P.c = (const float*)a.in[1]; P.pos = (const int*)a.in[2];
    P.ret_w_in = (const float*)a.in[3]; P.ret_w_out = (const float*)a.in[4]; P.moba_w_in = (const float*)a.in[5]; P.moba_w_out = (const float*)a.in[6];
    P.w_ada = (const float*)a.in[7]; P.b_ada = (const float*)a.in[8]; P.ln_g = (const float*)a.in[9]; P.ln_b = (const float*)a.in[10];
    P.out = a.out; P.MOD = (float*)(ws + WS_MOD); P.PART = (float*)(ws + WS_PART); P.KMEAN = (float*)(ws + WS_KMEAN);
    P.RCS0 = (float2*)(ws + WS_RCS0); P.RCS1 = (float2*)(ws + WS_RCS1);
    P.X1H = (h16*)(ws + WS_W0IN);
    P.W0IN = (h16*)(ws + WS_W0IN); P.W0OUT = (h16*)(ws + WS_W0OUT); P.W1IN = (h16*)(ws + WS_W1IN); P.W1OUT = (h16*)(ws + WS_W1OUT);
    P.Q0 = (h16*)(ws + WS_Q0); P.K0 = (h16*)(ws + WS_K0); P.V0 = (h16*)(ws + WS_V0); P.G0 = (h16*)(ws + WS_G0); P.H0 = (h16*)a.out;
    P.H1 = (h16*)(ws + WS_H1); P.Q1 = (h16*)(ws + WS_Q1); P.K1 = (h16*)(ws + WS_K1); P.V1 = (h16*)(ws + WS_V1); P.G1 = (h16*)(ws + WS_G1); P.A1 = (h16*)(ws + WS_A1);
    if (PROBE_XCC && tid == 0) ((unsigned*)(ws + WS_CTL))[3000 + bid] = xb_xcc_id() + 1u;
    XcdBarrier bar = xcd_barrier_post((unsigned*)(ws + WS_CTL) + CW_BAR, MISC + 8);
    const int lo = a.ph_lo, hi = a.ph_hi;
#define IN(k) (lo <= (k) && (k) < hi)
#define CLK0(k) do { if (PROBE_CLOCK_PHASE == (k) && bid == 0 && tid == 0) { ((unsigned long long*)(ws + WS_CTL))[1024] = __builtin_amdgcn_s_memtime(); ((unsigned long long*)(ws + WS_CTL))[1025] = __builtin_amdgcn_s_memrealtime(); } } while (0)
#define CLK1(k) do { if (PROBE_CLOCK_PHASE == (k) && bid == 0 && tid == 0) { ((unsigned long long*)(ws + WS_CTL))[1026] = __builtin_amdgcn_s_memtime(); ((unsigned long long*)(ws + WS_CTL))[1027] = __builtin_amdgcn_s_memrealtime(); } } while (0)
#define SEAM(k) do { if (IN(k) && IN((k) + 1)) { xcd_barrier(bar); if (PROBE_BAR2) xcd_barrier(bar); } } while (0)
#define REP(k) for (int rep_ = 0; rep_ < (((PROBE_DUP >> (k)) & 1u) ? 2 : 1); ++rep_)
    if (IN(0)) REP(0) { if (rep_) xcd_barrier(bar); phase0(P, ldsf, bid, G); }
    SEAM(0);
    if (IN(1)) REP(1) { if (rep_) xcd_barrier(bar); phase1(P, ldsf, bid, G); }
    SEAM(1);
    CLK0(2);
    if (IN(2)) REP(2) { if (rep_) xcd_barrier(bar); pg8::Gemm g{P.H0, P.W0IN, M, RET_IN, D, 0}; pg8::StaticOrder S; S.init(M, RET_IN, G, bid); EpiRet E{P.Q0, P.K0, P.V0, P.G0, P.pos, P.PART};
        pg8::gemm_phase<EpiRet, pg8::StaticOrder, true, true>(L, g, S, E); }
    CLK1(2);
    SEAM(2);
    if (IN(3)) phase_retention(P.Q0, P.K0, P.V0, L, bid, G);
    SEAM(3);
    if (IN(4)) phase_norm_gate(P.V0, P.G0, P.G0, bid, G);
    SEAM(4);
    if (IN(5)) REP(5) { if (rep_) xcd_barrier(bar); pg8::Gemm g{P.G0, P.W0OUT, M, D, RET_V, 0}; pg8::StaticOrder S; S.init(M, D, G, bid); EpiRes E{P.V0, P.MOD + 2 * D};
        pg8::gemm_phase<EpiRes, pg8::StaticOrder, true, true>(L, g, S, E); }
    SEAM(5);
    if (IN(6)) phase_layernorm<false>(P.x, P.V0, nullptr, P.X1H, P.ln_g, P.ln_b, P.MOD + 8 * MODW, P.H1, bid, G);
    SEAM(6);
    if (IN(7)) REP(7) { if (rep_) xcd_barrier(bar); pg8::Gemm g{P.H1, P.W1IN, M, MOBA_IN, D, 0}; pg8::StaticOrder S; S.init(M, MOBA_IN, G, bid); EpiMoba E{P.Q1, P.K1, P.V1, P.G1, P.pos};
        pg8::gemm_phase<EpiMoba, pg8::StaticOrder, true, true>(L, g, S, E); }
    SEAM(7);
    if (IN(8)) REP(8) { if (rep_) xcd_barrier(bar); phase_kmean(P.K1, P.KMEAN, bid, G); }
    SEAM(8);
    CLK0(9);
    if (IN(9)) { phase_moba<0>(P.Q1, P.K1, P.V1, P.G1, P.KMEAN, P.A1, L, bid, G);
        if (PROBE_MOBA_VAR >= 0) { xcd_barrier(bar); phase_moba<(PROBE_MOBA_VAR < 0 ? 0 : PROBE_MOBA_VAR)>(P.Q1, P.K1, P.V1, P.G1, P.KMEAN, P.H1, L, bid, G); } }
    CLK1(9);
    SEAM(9);
    if (IN(10)) { pg8::Gemm g{P.A1, P.W1OUT, M, D, MOBA_W, 0}; pg8::StaticOrder S; S.init(M, D, G, bid); EpiRes E{P.H1, P.MOD + 8 * MODW + 2 * D};
        pg8::gemm_phase<EpiRes, pg8::StaticOrder, true, true>(L, g, S, E); }
    SEAM(10);
    if (IN(11)) phase_layernorm<true>(P.X1H, P.H1, P.out, nullptr, P.ln_g + D, P.ln_b + D, nullptr, nullptr, bid, G);
    if (PROBE_ATT_STAMP >= 0 && bid == 0) { __syncthreads(); if (tid == 0) { __threadfence(); P.out[0] += __hip_atomic_load(P.KMEAN, __ATOMIC_RELAXED, __HIP_MEMORY_SCOPE_AGENT); } }
    if (PROBE_GEMM_STAMP >= 0 && bid == 0) { __syncthreads(); if (tid == 0) { __threadfence(); P.out[0] += __hip_atomic_load(P.PART, __ATOMIC_RELAXED, __HIP_MEMORY_SCOPE_AGENT); } }
    if (PROBE_XCC && bid == 0) { __syncthreads(); if (tid == 0) { const unsigned* xp = (const unsigned*)(ws + WS_CTL) + 3000; int bad = 0; for (int i2 = 0; i2 < G; ++i2) bad += (xp[i2] != xp[i2 & 7]) ? 1 : 0; P.out[0] += 1.0f + (float)bad; } }
    if (PROBE_CLOCK_PHASE >= 0 && bid == 0) { __syncthreads(); if (tid == 0) { const unsigned long long* tsp = (const unsigned long long*)(ws + WS_CTL) + 1024;
        const float ghz = (float)(tsp[2] - tsp[0]) / ((float)(tsp[3] - tsp[1]) * 10.0f); __threadfence(); P.out[0] += ghz; } }
#if PROBE_DUMMY_GEMM
    { xcd_barrier(bar); pg8::Gemm g{P.H1, P.W1IN, M, PROBE_DG_N, PROBE_DG_K, 0}; pg8::StaticOrder S; S.init(M, PROBE_DG_N, G, bid); EpiMoba E{P.Q1, P.K1, P.V1, P.G1, P.pos};
        if (PROBE_DG_EPI >= 0) { EpiProbe<(PROBE_DG_EPI < 0 ? 0 : PROBE_DG_EPI)> E2{P.Q1}; pg8::gemm_phase<EpiProbe<(PROBE_DG_EPI < 0 ? 0 : PROBE_DG_EPI)>, pg8::StaticOrder, true, true>(L, g, S, E2); }
        else pg8::gemm_phase<EpiMoba, pg8::StaticOrder, true, true, PROBE_DG_BF16>(L, g, S, E); }
#endif
#undef IN
#undef SEAM
}

#ifndef MK_N_LAUNCHES
#define MK_N_LAUNCHES 1
#endif
extern "C" void kernel_launch(void* const* d_in, const int* in_sizes, int n_in, void* d_out, int out_size, void* d_ws, size_t ws_size, hipStream_t stream) {
    static int grid = 0;
    if (grid == 0) {
        if (n_in != 11 || out_size != M * D || ws_size < WS_END) { fprintf(stderr, "kernel_launch: unexpected shapes (n_in %d out %d ws %zu)\n", n_in, out_size, ws_size); grid = -1; return; }
        int dev = 0, cus = 0, per_cu = 0;
        if (hipGetDevice(&dev) != hipSuccess || hipDeviceGetAttribute(&cus, hipDeviceAttributeMultiprocessorCount, dev) != hipSuccess) { grid = -1; return; }
        if (hipFuncSetAttribute((const void*)mk_fwd, hipFuncAttributeMaxDynamicSharedMemorySize, LDS_BYTES) != hipSuccess) { fprintf(stderr, "kernel_launch: hipFuncSetAttribute failed\n"); grid = -1; return; }
        if (hipOccupancyMaxActiveBlocksPerMultiprocessor(&per_cu, (const void*)mk_fwd, NT, LDS_BYTES) != hipSuccess || per_cu < 1) { fprintf(stderr, "kernel_launch: occupancy query says %d\n", per_cu); (void)hipGetLastError(); grid = -1; return; }
        grid = cus;
    }
    if (grid < 0) return;
    if (hipMemsetAsync((char*)d_ws + WS_CTL, 0, CTL_ZERO_BYTES, stream) != hipSuccess) return;
    Args a{};
    for (int i = 0; i < 11; ++i) a.in[i] = d_in[i];
    a.out = (float*)d_out; a.ws = (unsigned char*)d_ws;
    if (MK_N_LAUNCHES == 1) { a.ph_lo = 0; a.ph_hi = NPHASE; hipLaunchKernelGGL(mk_fwd, dim3(grid), dim3(NT), LDS_BYTES, stream, a); }
    else for (int p = 0; p < NPHASE; ++p) { a.ph_lo = p; a.ph_hi = p + 1; hipLaunchKernelGGL(mk_fwd, dim3(grid), dim3(NT), LDS_BYTES, stream, a); }
}
```

```cpp
#include <hip/hip_runtime.h>
#include <cstdio>
#include <cstdint>
#include <cmath>

#ifndef PROBE_ATT_STAMP
#define PROBE_ATT_STAMP -1
#define PROBE_ATT_WAVE 0
#endif
#ifndef PROBE_GEMM_STAMP
#define PROBE_GEMM_STAMP -1
#define PROBE_GEMM_WAVE 0
#endif
typedef _Float16 h16;
typedef _Float16 h16x8 __attribute__((ext_vector_type(8)));
typedef _Float16 h16x4 __attribute__((ext_vector_type(4)));
typedef _Float16 h16x2 __attribute__((ext_vector_type(2)));
typedef float f32x4 __attribute__((ext_vector_type(4)));
typedef float f32x2 __attribute__((ext_vector_type(2)));
typedef unsigned u32x4 __attribute__((ext_vector_type(4)));
typedef unsigned u32x2 __attribute__((ext_vector_type(2)));
#define LAS __attribute__((address_space(3)))

constexpr int D = 2048, BATCH = 8, SEQ = 2048, M = BATCH * SEQ;
constexpr int RET_HEADS = 8, RET_DK = 256, RET_DV = 512, RET_QK = 2048, RET_V = 4096, RET_IN = 12288;
constexpr int MOBA_HEADS = 16, MOBA_DH = 128, MOBA_W = 2048, MOBA_IN = 8192, MOBA_BLOCK = 256, NBLK = 8;
constexpr float ALPHA = 1.4142135623730951f;
constexpr float LN_EPS = 1e-5f, GN_EPS = 1e-5f;
constexpr int MODW = 3 * D;
constexpr int KSPLIT = 4;

constexpr size_t MiB = 1u << 20;
constexpr size_t WS_CTL = 0;
constexpr size_t WS_MOD = 1 * MiB;
constexpr size_t WS_KMEAN = WS_MOD + 512 * 1024;
constexpr size_t WS_RCS1 = 2 * MiB;
constexpr size_t WS_W0IN = 4 * MiB;
constexpr size_t WS_W0OUT = 52 * MiB;
constexpr size_t WS_W1IN = 68 * MiB;
constexpr size_t WS_W1OUT = 100 * MiB;
constexpr size_t WS_ACT = 108 * MiB;
constexpr size_t WS_Q0 = WS_ACT, WS_K0 = WS_ACT + 64 * MiB, WS_V0 = WS_ACT + 128 * MiB, WS_G0 = WS_ACT + 256 * MiB;
constexpr size_t WS_H1 = WS_ACT, WS_Q1 = WS_ACT + 64 * MiB, WS_K1 = WS_ACT + 128 * MiB, WS_V1 = WS_ACT + 192 * MiB, WS_G1 = WS_ACT + 256 * MiB, WS_A1 = WS_ACT + 320 * MiB;
constexpr size_t WS_RCS0 = 492 * MiB;
constexpr size_t WS_PART = 508 * MiB;
constexpr size_t WS_END = 512 * MiB;

__device__ __forceinline__ int opaque_tid() { int t = threadIdx.x; asm volatile("" : "+v"(t)); return t; }
__device__ __forceinline__ unsigned pk_h2(float lo, float hi) { h16x2 h = {(h16)lo, (h16)hi}; return __builtin_bit_cast(unsigned, h); }
__device__ __forceinline__ float wave_sum(float v) {
#pragma unroll
    for (int o = 1; o < 64; o <<= 1) v += __shfl_xor(v, o);
    return v;
}
__device__ __forceinline__ float silu(float g) { return g / (1.0f + __expf(-g)); }

namespace pg8 {
typedef __bf16 bf16x8_t __attribute__((ext_vector_type(8)));
constexpr int BM = 256, BK = 64, HALF = 128, HTB = HALF * BK * 2, STAGE_BYTES = 8 * HTB, NXCD = 8, WGM = 8;
__host__ __device__ __forceinline__ int lds_byte(int r, int c) { const int st = (r >> 4) * 2 + (c >> 5), rr = r & 15, cc = c & 31, ob = rr * 64 + cc * 2; return st * 1024 + (ob ^ (((ob >> 9) & 1) << 5)); }
__host__ __device__ __forceinline__ void stage_rc(int b, int& R, int& C) { const int st = b / 1024, sb = b % 1024, swz = sb ^ (((sb >> 9) & 1) << 5); R = (st >> 1) * 16 + swz / 64; C = (st & 1) * 32 + (swz % 64) / 2; }
__host__ __device__ __forceinline__ int perm32(int rho) { const int n = rho >> 4, i = rho & 15; return 8 * (i >> 2) + 4 * n + (i & 3); }
struct Unit { int pm, pn; };
struct Gemm { const h16* A; const h16* Bt; int M, N, K, pad; };
struct StaticOrder {
    int nM, nN, nwg, G, c;
    __host__ __device__ void init(int M_, int N_, int G_, int c_) { nM = M_ / BM; nN = N_ / BM; nwg = nM * nN; G = G_; c = c_; }
    __host__ __device__ bool next(int i, Unit& u) const {
        const long L = (long)i * G + c; if (L >= nwg) return false;
        int wgid = (int)L; { const int q = nwg / NXCD, r = nwg % NXCD, xcd = wgid % NXCD, off = wgid / NXCD; wgid = (xcd < r ? xcd * (q + 1) : r * (q + 1) + (xcd - r) * q) + off; }
        const int nig = WGM * nN, gid = wgid / nig, fm = gid * WGM, gsz = (nM - fm) < WGM ? (nM - fm) : WGM;
        u.pm = fm + ((wgid % nig) % gsz); u.pn = (wgid % nig) / gsz; return true;
    }
    __device__ __forceinline__ void a_ready(const Unit&) const {}
    __device__ __forceinline__ void done(const Unit&) const {}
};

struct FixedOrder : StaticOrder {
    __host__ __device__ bool next(int i, Unit& u) const { Unit t; const bool ok = StaticOrder::next(i, t); u.pm = 0; u.pn = 0; return ok; }
};
template <class Epi, class Sched, bool ALIGN_EPI = false, bool SP2 = false, bool USE_BF16 = false, bool SIM = false>
__device__ __forceinline__ void gemm_phase(LAS unsigned char* lds, const Gemm g, const Sched& S, const Epi& E) {
    const int tid = opaque_tid(), wid = __builtin_amdgcn_readfirstlane(tid >> 6), lane = tid & 63, wr = wid >> 2, wc = wid & 3, fr = lane & 15, fq = lane >> 4;
    const int K = g.K, nt = K / BK;
    unsigned voffA, voffB;
    { int R, C; stage_rc(tid * 16, R, C); const int Rb = Epi::PERM ? ((R & ~31) + perm32(R & 31)) : R;
        voffA = (unsigned)(R * K + C) * 2u; voffB = (unsigned)(Rb * K + C) * 2u; }
    const size_t pstep = (size_t)64 * K * 2;
    const size_t kstep = (size_t)(BK * 2);
    const size_t hstep = (size_t)HALF * K * 2;
    const size_t tstep = 2 * hstep;
    const unsigned ldsw = (unsigned)wid * 1024u;
    const int aoff = lds_byte(wr * 64 + fr, fq * 8), boff = lds_byte(wc * 32 + fr, fq * 8);
#define PG8_SA(b, h) (((b) * 2 + (h)) * HTB)
#define PG8_SB(b, h) ((4 + (b) * 2 + (h)) * HTB)
#define PG8_STAGE(bufoff, gbase, voff) do { _Pragma("unroll") for (int _i = 0; _i < 2; ++_i) \
        __builtin_amdgcn_global_load_lds((const unsigned*)((const char*)(gbase) + _i * pstep + (voff)), (LAS unsigned*)(lds + (bufoff) + ldsw + _i * 8192), 16, 0, 0); } while (0)
#define PG8_LDA(dst, b, h) do { _Pragma("unroll") for (int m = 0; m < 4; ++m) _Pragma("unroll") for (int k = 0; k < 2; ++k) dst[m][k] = *(const LAS h16x8*)(lds + PG8_SA(b, h) + aoff + m * 2048 + k * 1024); } while (0)
#define PG8_LDB(dst, b, h) do { _Pragma("unroll") for (int n = 0; n < 2; ++n) _Pragma("unroll") for (int k = 0; k < 2; ++k) dst[n][k] = *(const LAS h16x8*)(lds + PG8_SB(b, h) + boff + n * 2048 + k * 1024); } while (0)
#define PG8_MMA(ai, bj, At, Bt) do { __builtin_amdgcn_s_setprio(1); _Pragma("unroll") for (int m = 0; m < 4; ++m) _Pragma("unroll") for (int n = 0; n < 2; ++n) _Pragma("unroll") for (int k = 0; k < 2; ++k) \
        acc[ai][bj][m][n] = USE_BF16 ? __builtin_amdgcn_mfma_f32_16x16x32_bf16(__builtin_bit_cast(bf16x8_t, Bt[n][k]), __builtin_bit_cast(bf16x8_t, At[m][k]), acc[ai][bj][m][n], 0, 0, 0) : __builtin_amdgcn_mfma_f32_16x16x32_f16(Bt[n][k], At[m][k], acc[ai][bj][m][n], 0, 0, 0); __builtin_amdgcn_s_setprio(0); } while (0)
#define PG8_MMAQ(ai, bj, mlo, At, Bt) do { __builtin_amdgcn_s_setprio(1); _Pragma("unroll") for (int m = (mlo); m < (mlo) + 2; ++m) _Pragma("unroll") for (int n = 0; n < 2; ++n) _Pragma("unroll") for (int k = 0; k < 2; ++k) \
        acc[ai][bj][m][n] = __builtin_amdgcn_mfma_f32_16x16x32_f16(Bt[n][k], At[m][k], acc[ai][bj][m][n], 0, 0, 0); __builtin_amdgcn_s_setprio(0); __builtin_amdgcn_sched_barrier(0); } while (0)
#define PG8_STAGE_P(bufoff, gbase, voff) do { PG8_STAGE(bufoff, gbase, voff); __builtin_amdgcn_sched_barrier(0); } while (0)
#define PG8_WAIT_V(n) asm volatile("s_waitcnt vmcnt(" #n ")" ::: "memory")
#define PG8_WAIT_L(n) asm volatile("s_waitcnt lgkmcnt(" #n ")" ::: "memory")
#define PG8_BAR __builtin_amdgcn_s_barrier()
#define PG8_SCHED __builtin_amdgcn_sched_barrier(0)
#define GS0() do { if (PROBE_GEMM_STAMP >= 0 && Epi::STAMPED) { __builtin_amdgcn_sched_barrier(0); gs_t = __builtin_amdgcn_s_memtime(); __builtin_amdgcn_s_waitcnt(0xC07F); __builtin_amdgcn_sched_barrier(0); } } while (0)
#define GS(k) do { if (PROBE_GEMM_STAMP >= 0 && Epi::STAMPED) { __builtin_amdgcn_sched_barrier(0); const unsigned long long t2_ = __builtin_amdgcn_s_memtime(); __builtin_amdgcn_s_waitcnt(0xC07F); if (PROBE_GEMM_STAMP == (k)) { gs_sum += t2_ - gs_t; gs_n += 1; } gs_t = t2_; __builtin_amdgcn_sched_barrier(0); } } while (0)
    unsigned long long gs_t = 0, gs_sum = 0; int gs_n = 0;
    Unit cur, nxt; int ui = 0;
    if (!S.next(0, cur)) return;
    f32x4 acc[2][2][4][2];
#pragma unroll
    for (int a = 0; a < 2; ++a)
#pragma unroll
        for (int b = 0; b < 2; ++b)
#pragma unroll
            for (int m = 0; m < 4; ++m)
#pragma unroll
                for (int n = 0; n < 2; ++n) acc[a][b][m][n] = (f32x4){0.f, 0.f, 0.f, 0.f};
    h16x8 At[4][2], B0[2][2], B1[2][2];
    const char* cA = (const char*)g.A + (size_t)cur.pm * tstep; const char* cB = (const char*)g.Bt + (size_t)cur.pn * tstep;
    S.a_ready(cur);
    if constexpr (SP2) {
        PG8_STAGE(PG8_SB(0, 0), cB, voffB); PG8_STAGE(PG8_SB(0, 1), cB + hstep, voffB); PG8_STAGE(PG8_SA(0, 0), cA, voffA); PG8_STAGE(PG8_SA(0, 1), cA + hstep, voffA);
        if (wr == 1) PG8_BAR;
        PG8_WAIT_V(2); PG8_BAR;
        PG8_STAGE(PG8_SB(1, 0), cB + kstep, voffB); PG8_STAGE(PG8_SA(1, 0), cA + kstep, voffA); PG8_STAGE(PG8_SB(1, 1), cB + hstep + kstep, voffB);
        PG8_WAIT_V(6); PG8_BAR;
    } else {
        PG8_STAGE(PG8_SB(0, 0), cB, voffB); PG8_STAGE(PG8_SA(0, 0), cA, voffA); PG8_STAGE(PG8_SB(0, 1), cB + hstep, voffB); PG8_STAGE(PG8_SA(0, 1), cA + hstep, voffA);
        if (wr == 1) PG8_BAR;
        PG8_WAIT_V(4); PG8_BAR;
        PG8_STAGE(PG8_SB(1, 0), cB + kstep, voffB); PG8_STAGE(PG8_SA(1, 0), cA + kstep, voffA); PG8_STAGE(PG8_SB(1, 1), cB + hstep + kstep, voffB);
        PG8_WAIT_V(6); PG8_BAR;
    }
    for (;;) {
        const bool has_next = S.next(ui + 1, nxt);
        const char* nA = has_next ? (const char*)g.A + (size_t)nxt.pm * tstep : cA; const char* nB = has_next ? (const char*)g.Bt + (size_t)nxt.pn * tstep : cB;
        for (int t = 0; t < nt; t += 2) {
            const bool last = (t == nt - 2);
            const char* a1 = cA + (size_t)(t + 1) * kstep;
            const char* a2 = last ? nA : cA + (size_t)(t + 2) * kstep; const char* b2 = last ? nB : cB + (size_t)(t + 2) * kstep;
            const char* a3 = a2 + kstep; const char* b3 = b2 + kstep;
            if (last && has_next) S.a_ready(nxt);
            if constexpr (SP2 && SIM) {
            PG8_LDB(B0, 0, 0); PG8_LDB(B1, 0, 1); PG8_SCHED; PG8_LDA(At, 0, 0);
            PG8_WAIT_V(6); PG8_WAIT_L(0); PG8_BAR; PG8_SCHED;
            PG8_MMAQ(0, 0, 0, At, B0); PG8_STAGE_P(PG8_SA(1, 1), a1 + hstep, voffA); PG8_MMAQ(0, 0, 2, At, B0); PG8_MMAQ(0, 1, 0, At, B1); PG8_MMAQ(0, 1, 2, At, B1); PG8_BAR; PG8_SCHED;
            PG8_LDA(At, 0, 1);
            PG8_WAIT_V(2); PG8_WAIT_L(0); PG8_BAR; PG8_SCHED;
            PG8_MMAQ(1, 0, 0, At, B0); PG8_STAGE_P(PG8_SB(0, 0), b2, voffB); PG8_MMAQ(1, 0, 2, At, B0); PG8_STAGE_P(PG8_SB(0, 1), b2 + hstep, voffB); PG8_MMAQ(1, 1, 0, At, B1); PG8_STAGE_P(PG8_SA(0, 0), a2, voffA); PG8_MMAQ(1, 1, 2, At, B1); PG8_BAR; PG8_SCHED;
            PG8_LDB(B0, 1, 0); PG8_LDB(B1, 1, 1); PG8_SCHED; PG8_LDA(At, 1, 0);
            PG8_WAIT_V(6); PG8_WAIT_L(0); PG8_BAR; PG8_SCHED;
            PG8_MMAQ(0, 0, 0, At, B0); PG8_STAGE_P(PG8_SA(0, 1), a2 + hstep, voffA); PG8_MMAQ(0, 0, 2, At, B0); PG8_MMAQ(0, 1, 0, At, B1); PG8_MMAQ(0, 1, 2, At, B1); PG8_BAR; PG8_SCHED;
            PG8_LDA(At, 1, 1);
            PG8_WAIT_V(2); PG8_WAIT_L(0); PG8_BAR; PG8_SCHED;
            PG8_MMAQ(1, 0, 0, At, B0); PG8_STAGE_P(PG8_SB(1, 0), b3, voffB); PG8_MMAQ(1, 0, 2, At, B0); PG8_STAGE_P(PG8_SB(1, 1), b3 + hstep, voffB); PG8_MMAQ(1, 1, 0, At, B1); PG8_STAGE_P(PG8_SA(1, 0), a3, voffA); PG8_MMAQ(1, 1, 2, At, B1); PG8_BAR; PG8_SCHED;
            } else if constexpr (SP2) {
            GS0(); PG8_LDB(B0, 0, 0); PG8_LDB(B1, 0, 1); PG8_SCHED; PG8_LDA(At, 0, 0); PG8_STAGE(PG8_SA(1, 1), a1 + hstep, voffA);
            PG8_WAIT_V(8); PG8_WAIT_L(0); PG8_BAR; GS(0); PG8_MMA(0, 0, At, B0); PG8_MMA(0, 1, At, B1); GS(1); PG8_BAR; GS(2); PG8_SCHED;
            GS0(); PG8_LDA(At, 0, 1); PG8_STAGE(PG8_SB(0, 0), b2, voffB); PG8_STAGE(PG8_SB(0, 1), b2 + hstep, voffB); PG8_STAGE(PG8_SA(0, 0), a2, voffA);
            PG8_WAIT_V(8); PG8_WAIT_L(0); PG8_BAR; GS(3); PG8_MMA(1, 0, At, B0); PG8_MMA(1, 1, At, B1); GS(1); PG8_BAR; GS(2); PG8_SCHED;
            PG8_LDB(B0, 1, 0); PG8_LDB(B1, 1, 1); PG8_SCHED; PG8_LDA(At, 1, 0); PG8_STAGE(PG8_SA(0, 1), a2 + hstep, voffA);
            PG8_WAIT_V(8); PG8_WAIT_L(0); PG8_BAR; PG8_MMA(0, 0, At, B0); PG8_MMA(0, 1, At, B1); PG8_BAR; PG8_SCHED;
            PG8_LDA(At, 1, 1); PG8_STAGE(PG8_SB(1, 0), b3, voffB); PG8_STAGE(PG8_SB(1, 1), b3 + hstep, voffB); PG8_STAGE(PG8_SA(1, 0), a3, voffA);
            PG8_WAIT_V(8); PG8_WAIT_L(0); PG8_BAR; PG8_MMA(1, 0, At, B0); PG8_MMA(1, 1, At, B1); PG8_BAR; PG8_SCHED;
            } else {
            PG8_LDB(B0, 0, 0); PG8_SCHED; PG8_LDA(At, 0, 0); PG8_STAGE(PG8_SA(1, 1), a1 + hstep, voffA);
            PG8_WAIT_L(8); PG8_BAR; PG8_WAIT_L(0); PG8_MMA(0, 0, At, B0); PG8_BAR; PG8_SCHED;
            PG8_LDB(B1, 0, 1); PG8_STAGE(PG8_SB(0, 0), b2, voffB);
            PG8_BAR; PG8_WAIT_L(0); PG8_MMA(0, 1, At, B1); PG8_BAR;
            PG8_LDA(At, 0, 1); PG8_STAGE(PG8_SA(0, 0), a2, voffA);
            PG8_BAR; PG8_WAIT_L(0); PG8_MMA(1, 0, At, B0); PG8_BAR; PG8_SCHED;
            PG8_STAGE(PG8_SB(0, 1), b2 + hstep, voffB);
            PG8_WAIT_V(6); PG8_BAR; PG8_MMA(1, 1, At, B1); PG8_BAR;
            PG8_LDB(B0, 1, 0); PG8_SCHED; PG8_LDA(At, 1, 0); PG8_STAGE(PG8_SA(0, 1), a2 + hstep, voffA);
            PG8_WAIT_L(8); PG8_BAR; PG8_WAIT_L(0); PG8_MMA(0, 0, At, B0); PG8_BAR; PG8_SCHED;
            PG8_LDB(B1, 1, 1); PG8_STAGE(PG8_SB(1, 0), b3, voffB);
            PG8_BAR; PG8_WAIT_L(0); PG8_MMA(0, 1, At, B1); PG8_BAR;
            PG8_LDA(At, 1, 1); PG8_STAGE(PG8_SA(1, 0), a3, voffA);
            PG8_BAR; PG8_WAIT_L(0); PG8_MMA(1, 0, At, B0); PG8_BAR; PG8_SCHED;
            PG8_STAGE(PG8_SB(1, 1), b3 + hstep, voffB);
            PG8_WAIT_V(6); PG8_BAR; PG8_MMA(1, 1, At, B1); PG8_BAR;
            }
        }
        if constexpr (ALIGN_EPI) { if (wr == 0) PG8_BAR; }
        if constexpr (!Epi::AFTER_DRAIN) { E(acc, cur, wr, wc, fr, fq); S.done(cur); }
        if (!has_next) break;
#pragma unroll
        for (int a = 0; a < 2; ++a)
#pragma unroll
            for (int b = 0; b < 2; ++b)
#pragma unroll
                for (int m = 0; m < 4; ++m)
#pragma unroll
                    for (int n = 0; n < 2; ++n) acc[a][b][m][n] = (f32x4){0.f, 0.f, 0.f, 0.f};
        cur = nxt; cA = nA; cB = nB; ++ui;
        if constexpr (ALIGN_EPI) { if (wr == 1) PG8_BAR; }
    }
    PG8_WAIT_V(0);
    if constexpr (!ALIGN_EPI) { if (wr == 0) PG8_BAR; }
    PG8_BAR;
    if (PROBE_GEMM_STAMP >= 0 && Epi::STAMPED && blockIdx.x == 0 && wid == PROBE_GEMM_WAVE && lane == 0) E.park((float)gs_sum / (float)(gs_n > 0 ? gs_n : 1) * 0.01f);
#undef PG8_SA
#undef PG8_SB
#undef PG8_STAGE
#undef PG8_LDA
#undef PG8_LDB
#undef PG8_MMA
#undef PG8_MMAQ
#undef PG8_STAGE_P
#undef PG8_WAIT_V
#undef PG8_WAIT_L
#undef PG8_BAR
#undef PG8_SCHED
}
}

struct EpiRet {
    static constexpr bool PERM = true, AFTER_DRAIN = false, STAMPED = true;
    __device__ __forceinline__ void park(float v) const { *stamp_dst = v; }
    h16 *Q, *K, *V, *G; const int* pos; float* stamp_dst;
    __device__ __forceinline__ void operator()(const f32x4 (&acc)[2][2][4][2], const pg8::Unit& u, int wr, int wc, int fr, int fq) const {
        const int row0 = u.pm * 256 + wr * 64 + fr;
        if (u.pn < 16) {
            h16* base = (u.pn < 8) ? Q + u.pn * 256 : K + (u.pn - 8) * 256; const float sc = (u.pn < 8) ? 1.0f : 0.0625f;
            const int d0 = wc * 32 + 8 * fq;
            float pf_[8];
#pragma unroll
            for (int ai = 0; ai < 2; ++ai)
#pragma unroll
                for (int m = 0; m < 4; ++m) pf_[ai * 4 + m] = (float)pos[row0 + ai * 128 + m * 16];
            float irev[8];
#pragma unroll
            for (int q = 0; q < 8; ++q) irev[q] = __builtin_amdgcn_exp2f(-(float)(d0 + q) * (2.0f / 256.0f * 13.287712379549449f)) * 0.15915494309189535f;
#pragma unroll
            for (int ai = 0; ai < 2; ++ai)
#pragma unroll
                for (int m = 0; m < 4; ++m) {
                    const int row = row0 + ai * 128 + m * 16; const float pv = pf_[ai * 4 + m];
                    float o1[8], o2[8];
#pragma unroll
                    for (int n = 0; n < 2; ++n) { const f32x4 x1 = acc[ai][0][m][n], x2 = acc[ai][1][m][n];
#pragma unroll
                        for (int j = 0; j < 4; ++j) { const float fr_ = __builtin_amdgcn_fractf(pv * irev[4 * n + j]); const float cc = __builtin_amdgcn_cosf(fr_) * sc, ss = __builtin_amdgcn_sinf(fr_) * sc;
                            o1[4 * n + j] = x1[j] * cc - x2[j] * ss; o2[4 * n + j] = x2[j] * cc + x1[j] * ss; } }
                    u32x4 w1, w2; w1.x = pk_h2(o1[0], o1[1]); w1.y = pk_h2(o1[2], o1[3]); w1.z = pk_h2(o1[4], o1[5]); w1.w = pk_h2(o1[6], o1[7]);
                    w2.x = pk_h2(o2[0], o2[1]); w2.y = pk_h2(o2[2], o2[3]); w2.z = pk_h2(o2[4], o2[5]); w2.w = pk_h2(o2[6], o2[7]);
                    h16* rp = base + (size_t)row * RET_QK + d0;
                    *(u32x4*)rp = w1; *(u32x4*)(rp + 128) = w2;
                }
        } else {
            h16* base = (u.pn < 32) ? V + (u.pn - 16) * 256 : G + (u.pn - 32) * 256;
            const int c0 = wc * 32 + 8 * fq;
#pragma unroll
            for (int ai = 0; ai < 2; ++ai)
#pragma unroll
                for (int m = 0; m < 4; ++m) {
                    h16* rp = base + (size_t)(row0 + ai * 128 + m * 16) * RET_V + c0;
#pragma unroll
                    for (int bj = 0; bj < 2; ++bj) { const f32x4 v0 = acc[ai][bj][m][0], v1 = acc[ai][bj][m][1];
                        u32x4 w; w.x = pk_h2(v0[0], v0[1]); w.y = pk_h2(v0[2], v0[3]); w.z = pk_h2(v1[0], v1[1]); w.w = pk_h2(v1[2], v1[3]);
                        *(u32x4*)(rp + bj * 128) = w; }
                }
        }
    }
};
struct EpiMoba {
    static constexpr bool PERM = true, AFTER_DRAIN = false, STAMPED = false;
    __device__ __forceinline__ void park(float) const {}
    h16 *Q, *K, *V, *G; const int* pos;
    __device__ __forceinline__ void operator()(const f32x4 (&acc)[2][2][4][2], const pg8::Unit& u, int wr, int wc, int fr, int fq) const {
        const int row0 = u.pm * 256 + wr * 64 + fr; const int sel = u.pn >> 3;
        h16* base = (sel == 0 ? Q : sel == 1 ? K : sel == 2 ? V : G) + (u.pn & 7) * 256 + wc * 32 + 8 * fq;
        const bool rope = (sel < 2) && (wc == 0);
        float irev[8];
#pragma unroll
        for (int q = 0; q < 8; ++q) irev[q] = __builtin_amdgcn_exp2f(-(float)(((8 * fq) & 15) + q) * (2.0f / 32.0f * 18.931568569324174f)) * 0.15915494309189535f;
#pragma unroll
        for (int ai = 0; ai < 2; ++ai)
#pragma unroll
            for (int m = 0; m < 4; ++m) {
                const int row = row0 + ai * 128 + m * 16;
                float cc[8], ss[8];
                if (rope) { const float pv = (float)pos[row];
#pragma unroll
                    for (int q = 0; q < 8; ++q) { const float fr_ = __builtin_amdgcn_fractf(pv * irev[q]); cc[q] = __builtin_amdgcn_cosf(fr_); ss[q] = __builtin_amdgcn_sinf(fr_); } }
#pragma unroll
                for (int bj = 0; bj < 2; ++bj) {
                    float o[8];
#pragma unroll
                    for (int n = 0; n < 2; ++n)
#pragma unroll
                        for (int j = 0; j < 4; ++j) { const float x = acc[ai][bj][m][n][j]; float r = x;
                            if (rope) { const auto sw = __builtin_amdgcn_permlane32_swap(__builtin_bit_cast(unsigned, x), __builtin_bit_cast(unsigned, x), false, false);
                                const float y = __builtin_bit_cast(float, fq < 2 ? sw[1] : sw[0]);
                                r = (fq < 2) ? (x * cc[4 * n + j] - y * ss[4 * n + j]) : (x * cc[4 * n + j] + y * ss[4 * n + j]); }
                            o[4 * n + j] = r; }
                    u32x4 w; w.x = pk_h2(o[0], o[1]); w.y = pk_h2(o[2], o[3]); w.z = pk_h2(o[4], o[5]); w.w = pk_h2(o[6], o[7]);
                    *(u32x4*)(base + (size_t)row * MOBA_W + bj * 128) = w;
                }
            }
    }
};
struct EpiRes {
    static constexpr bool PERM = true, AFTER_DRAIN = false, STAMPED = false;
    __device__ __forceinline__ void park(float) const {}
    h16* Y; const float* gate;
    __device__ __forceinline__ void operator()(const f32x4 (&acc)[2][2][4][2], const pg8::Unit& u, int wr, int wc, int fr, int fq) const {
        const int row0 = u.pm * 256 + wr * 64 + fr, col0 = u.pn * 256 + wc * 32 + 8 * fq; const int b = u.pm >> 3;
        f32x4 gv[2][2];
#pragma unroll
        for (int bj = 0; bj < 2; ++bj)
#pragma unroll
            for (int n = 0; n < 2; ++n) gv[bj][n] = *(const f32x4*)(gate + (size_t)b * MODW + col0 + bj * 128 + n * 4);
#pragma unroll
        for (int ai = 0; ai < 2; ++ai)
#pragma unroll
            for (int m = 0; m < 4; ++m) { h16* rp = Y + (size_t)(row0 + ai * 128 + m * 16) * D + col0;
#pragma unroll
                for (int bj = 0; bj < 2; ++bj) { const f32x4 v0 = acc[ai][bj][m][0] * gv[bj][0], v1 = acc[ai][bj][m][1] * gv[bj][1];
                    u32x4 w; w.x = pk_h2(v0[0], v0[1]); w.y = pk_h2(v0[2], v0[3]); w.z = pk_h2(v1[0], v1[1]); w.w = pk_h2(v1[2], v1[3]);
                    *(u32x4*)(rp + bj * 128) = w; } }
    }
};


template <int MODE> struct EpiProbe {
    static constexpr bool PERM = true, AFTER_DRAIN = false, STAMPED = false;
    __device__ __forceinline__ void park(float) const {}
    h16* O;
    __device__ __forceinline__ void operator()(const f32x4 (&acc)[2][2][4][2], const pg8::Unit& u, int wr, int wc, int fr, int fq) const {
        const int lane = fr + 16 * fq;
#pragma unroll
        for (int ai = 0; ai < 2; ++ai)
#pragma unroll
            for (int m = 0; m < 4; ++m)
#pragma unroll
                for (int bj = 0; bj < 2; ++bj) { const f32x4 v0 = acc[ai][bj][m][0], v1 = acc[ai][bj][m][1];
                    u32x4 w; w.x = pk_h2(v0[0], v0[1]); w.y = pk_h2(v0[2], v0[3]); w.z = pk_h2(v1[0], v1[1]); w.w = pk_h2(v1[2], v1[3]);
                    if (MODE == 0) { asm volatile("" :: "v"(w)); }
                    else if (MODE == 1) { const int row = u.pm * 256 + wr * 128 + (ai * 4 + m) * 16 + bj * 8 + (lane >> 3); *(u32x4*)(O + (size_t)row * MOBA_W + (u.pn & 7) * 256 + wc * 64 + (lane & 7) * 8) = w; }
                    else { const int row = u.pm * 256 + wr * 64 + ai * 128 + m * 16 + fr; *(u32x4*)(O + (size_t)row * MOBA_W + (u.pn & 7) * 256 + bj * 128 + wc * 32 + 8 * fq) = w; }
                }
    }
};

constexpr int NWAVES = 8, NT = NWAVES * 64;
constexpr int RING_BYTES = 131072;
constexpr int LDS_BYTES = 147456;
constexpr int MISC_OFF = LDS_BYTES - 128;
constexpr int CW_BAR = 4096;
constexpr size_t CTL_ZERO_BYTES = 64 * 1024;

#define GAS __attribute__((address_space(1)))
#define XB_TMO      128
#define XB_XCNT(j)  (256  + 64 * (j))
#define XB_XSUB(j)  (1280 + 64 * (j))
#define XB_XGEN(j)  (2304 + 64 * (j))
#define XB_TOP      3328
#define XB_TOPGEN   3392
#define XCD_BAR_WORDS 3456
#define XB_SPIN_CAP (1u << 22)
__device__ __forceinline__ unsigned xb_ld(unsigned* p)              { return __hip_atomic_load(p, __ATOMIC_RELAXED, __HIP_MEMORY_SCOPE_AGENT); }
__device__ __forceinline__ unsigned xb_add(unsigned* p, unsigned v) { return __hip_atomic_fetch_add(p, v, __ATOMIC_RELAXED, __HIP_MEMORY_SCOPE_AGENT); }
__device__ __forceinline__ unsigned xb_xcc_id() { return (unsigned)__builtin_amdgcn_s_getreg((3 << 11) | 20) & 0xFu; }
#define XB_SPIN(cond, bar) do { unsigned _sp = 0; while (cond) { __builtin_amdgcn_s_sleep(1); \
    if ((++_sp & 255u) == 0u) { if (xb_ld(&(bar)[XB_TMO])) break; if (_sp > XB_SPIN_CAP) { atomicAdd(&(bar)[XB_TMO], 1u); break; } } } } while (0)
struct XcdBarrier { unsigned* bar; unsigned x; volatile LAS unsigned* st; };
__device__ __forceinline__ XcdBarrier xcd_barrier_post(unsigned* bar, volatile LAS unsigned* st) {
    XcdBarrier b; b.bar = bar; b.x = xb_xcc_id(); b.st = st;
    if (threadIdx.x == 0) (void)xb_add(&bar[XB_XCNT(b.x)], 1u);
    return b;
}
__device__ __forceinline__ void xcd_barrier_complete(unsigned* bar, unsigned x, unsigned& nloc, unsigned& nx) {
    const unsigned G = gridDim.x * gridDim.y * gridDim.z;
    unsigned sum, cnt, mine, sp = 0u;
    for (;;) {
        sum = 0u; cnt = 0u; mine = 0u;
#pragma unroll
        for (unsigned j = 0; j < 16; ++j) { const unsigned c = xb_ld(&bar[XB_XCNT(j)]); sum += c; cnt += (c > 0u) ? 1u : 0u; mine = (j == x) ? c : mine; }
        if (sum == G) break;
        __builtin_amdgcn_s_sleep(1);
        if ((++sp & 255u) == 0u) { if (xb_ld(&bar[XB_TMO])) break; if (sp > XB_SPIN_CAP) { atomicAdd(&bar[XB_TMO], 1u); break; } }
    }
    nloc = mine > 0u ? mine : 1u; nx = cnt > 0u ? cnt : 1u;
}
__device__ __forceinline__ void xcd_barrier(const XcdBarrier& b) {
    asm volatile("s_waitcnt vmcnt(0)" ::: "memory");
    __syncthreads();
    if (threadIdx.x == 0) {
        unsigned* bar = b.bar;
        __builtin_amdgcn_s_waitcnt(0);
        unsigned nloc = b.st[0], nx = b.st[1];
        if (nloc == 0u) { xcd_barrier_complete(bar, b.x, nloc, nx); b.st[0] = nloc; b.st[1] = nx; }
        const unsigned old = xb_add(&bar[XB_XSUB(b.x)], 1u);
        const unsigned gen = old / nloc;
        if (old + 1u == (gen + 1u) * nloc) {
            __builtin_amdgcn_fence(__ATOMIC_RELEASE, "agent");
            asm volatile("s_waitcnt vmcnt(0)" ::: "memory");
            const unsigned og = xb_add(&bar[XB_TOP], 1u);
            const unsigned tg = og / nx;
            if (og + 1u == (tg + 1u) * nx) xb_add(&bar[XB_TOPGEN], 1u);
            else XB_SPIN(xb_ld(&bar[XB_TOPGEN]) == tg, bar);
            __builtin_amdgcn_fence(__ATOMIC_ACQUIRE, "agent");
            xb_add(&bar[XB_XGEN(b.x)], 1u);
            asm volatile("s_waitcnt vmcnt(0)" ::: "memory");
        } else {
            XB_SPIN(xb_ld(&bar[XB_XGEN(b.x)]) == gen, bar);
            __builtin_amdgcn_fence(__ATOMIC_ACQUIRE, "agent");
            asm volatile("s_waitcnt vmcnt(0)" ::: "memory");
        }
    }
    __syncthreads();
}

__device__ __forceinline__ void mod_partial_item(int item, const float* c, const float* w_ada, float* part, float* ldsf) {
    constexpr int nks = NT / 16, kper = 512 / nks, nw = NT / 64;
    const int tid = opaque_tid();
    const int l = item / (96 * KSPLIT), r = item % (96 * KSPLIT), cg64 = r / KSPLIT, s = r % KSPLIT, k0 = s * 512, col0 = cg64 * 64;
    float* cs = ldsf;
    float* red = ldsf + 8 * 512;
    for (int i = tid; i < 8 * 512; i += NT) cs[i] = c[(i >> 9) * D + k0 + (i & 511)];
    __syncthreads();
    const int cg = tid & 15, ks = tid >> 4;
    f32x4 acc[8];
#pragma unroll
    for (int b = 0; b < 8; ++b) acc[b] = (f32x4){0.f, 0.f, 0.f, 0.f};
    const float* wp = w_ada + ((size_t)l * D + k0 + ks * kper) * MODW + col0 + cg * 4;
#pragma unroll 4
    for (int kk = 0; kk < kper; ++kk) { const f32x4 w = *(const f32x4*)(wp + (size_t)kk * MODW);
#pragma unroll
        for (int b = 0; b < 8; ++b) acc[b] += w * cs[b * 512 + ks * kper + kk]; }
#pragma unroll
    for (int b = 0; b < 8; ++b)
#pragma unroll
        for (int j = 0; j < 4; ++j) { float v = acc[b][j]; v += __shfl_xor(v, 16); v += __shfl_xor(v, 32); acc[b][j] = v; }
    if ((tid & 63) < 16) {
#pragma unroll
        for (int b = 0; b < 8; ++b) *(f32x4*)(red + ((tid >> 6) * 8 + b) * 64 + cg * 4) = acc[b];
    }
    __syncthreads();
    for (int o = tid; o < 512; o += NT) { float v = 0.f;
#pragma unroll
        for (int w = 0; w < nw; ++w) v += red[w * 512 + o];
        part[(((size_t)l * KSPLIT + s) * 8 + (o >> 6)) * MODW + col0 + (o & 63)] = v; }
    __syncthreads();
}
__device__ __forceinline__ void transpose_item(const float* W, int K, int N, h16* WT, float* scr, int item, int lane) {
    const int nblk = N / 32, kb = item / nblk, nb = item % nblk, k0 = 64 * kb, n0 = 32 * nb;
#pragma unroll 8
    for (int i = 0; i < 32; ++i) { const int kk = 2 * i + (lane >> 5); scr[kk * 33 + (lane & 31)] = W[(size_t)(k0 + kk) * N + n0 + (lane & 31)]; }
    asm volatile("s_waitcnt lgkmcnt(0)" ::: "memory");
    const int c = lane & 7;
#pragma unroll
    for (int j = 0; j < 4; ++j) { const int n = (lane >> 3) + 8 * j; const float* s = scr + (8 * c) * 33 + n;
        u32x4 o; o.x = pk_h2(s[0 * 33], s[1 * 33]); o.y = pk_h2(s[2 * 33], s[3 * 33]); o.z = pk_h2(s[4 * 33], s[5 * 33]); o.w = pk_h2(s[6 * 33], s[7 * 33]);
        *(u32x4*)(WT + (size_t)(n0 + n) * K + k0 + 8 * c) = o; }
    asm volatile("s_waitcnt lgkmcnt(0)" ::: "memory");
}
constexpr int IT_W0IN = (D / 64) * (RET_IN / 32), IT_W0OUT = (RET_V / 64) * (D / 32), IT_W1IN = (D / 64) * (MOBA_IN / 32), IT_W1OUT = (MOBA_W / 64) * (D / 32);
constexpr int IT_WALL = IT_W0IN + IT_W0OUT + IT_W1IN + IT_W1OUT;

struct Ptrs {
    const float *x, *c; const int* pos; const float *ret_w_in, *ret_w_out, *moba_w_in, *moba_w_out, *w_ada, *b_ada, *ln_g, *ln_b;
    float* out; float *MOD, *PART, *KMEAN; float2 *RCS0, *RCS1;
    h16 *W0IN, *W0OUT, *W1IN, *W1OUT, *X1H, *Q0, *K0, *V0, *G0, *H0, *H1, *Q1, *K1, *V1, *G1, *A1;
};

__device__ __forceinline__ void phase0(const Ptrs& P, float* ldsf, int bid, int G) {
    const int tid = opaque_tid(), wave = tid >> 6, lane = tid & 63;
    for (int it = bid; it < 2 * 96 * KSPLIT; it += G) mod_partial_item(it, P.c, P.w_ada, P.PART, ldsf);
    float* scr = ldsf + wave * (64 * 33);
    for (int it = bid * NWAVES + wave; it < IT_WALL; it += G * NWAVES) { int r = it;
        if (r < IT_W0IN) { transpose_item(P.ret_w_in, D, RET_IN, P.W0IN, scr, r, lane); continue; } r -= IT_W0IN;
        if (r < IT_W0OUT) { transpose_item(P.ret_w_out, RET_V, D, P.W0OUT, scr, r, lane); continue; } r -= IT_W0OUT;
        if (r < IT_W1IN) { transpose_item(P.moba_w_in, D, MOBA_IN, P.W1IN, scr, r, lane); continue; } r -= IT_W1IN;
        transpose_item(P.moba_w_out, MOBA_W, D, P.W1OUT, scr, r, lane); }
}
__device__ __forceinline__ void phase1(const Ptrs& P, float* ldsf, int bid, int G) {
    const int tid = opaque_tid();
    for (int i = bid * NT + tid; i < 2 * 8 * MODW; i += G * NT) { const int l = i / (8 * MODW), r = i % (8 * MODW), b = r / MODW, j = r % MODW;
        float v = P.b_ada[l * MODW + j];
#pragma unroll
        for (int s = 0; s < KSPLIT; ++s) v += P.PART[(((size_t)l * KSPLIT + s) * 8 + b) * MODW + j];
        P.MOD[i] = v; }
    for (int ch = bid; ch < M / 64; ch += G) {
        const int b = ch / (SEQ / 64);
        __syncthreads();
        for (int j = tid; j < 2 * D; j += NT) { float v = P.b_ada[j];
#pragma unroll
            for (int s = 0; s < KSPLIT; ++s) v += P.PART[(((size_t)0 * KSPLIT + s) * 8 + b) * MODW + j];
            ldsf[j] = v; }
        __syncthreads();
        for (int e = tid; e < 64 * D / 4; e += NT) { const int rr = e / (D / 4), j = (e % (D / 4)) * 4; const size_t off = (size_t)(ch * 64 + rr) * D + j;
            const f32x4 xv = *(const f32x4*)(P.x + off), sh = *(const f32x4*)(ldsf + j), sc = *(const f32x4*)(ldsf + D + j);
            const f32x4 h = xv * (sc + 1.0f) + sh; u32x2 w; w.x = pk_h2(h[0], h[1]); w.y = pk_h2(h[2], h[3]); *(u32x2*)(P.H0 + off) = w; }
    }
}
__device__ __forceinline__ void phase_norm_gate(const h16* O, const h16* Gt, h16* A, int bid, int G) {
    const int tid_ = opaque_tid(); const int gw = bid * NWAVES + (tid_ >> 6), lane = tid_ & 63, NGW = G * NWAVES;
    for (int it = gw; it < M * RET_HEADS; it += NGW) {
        const size_t off = (size_t)it * RET_DV + lane * 8;
        const h16x8 ov = *(const h16x8*)(O + off), gv = *(const h16x8*)(Gt + off);
        float o[8]; float s = 0.f;
#pragma unroll
        for (int j = 0; j < 8; ++j) { o[j] = (float)ov[j]; s += o[j]; }
        const float mu = wave_sum(s) * (1.0f / RET_DV); float q = 0.f;
#pragma unroll
        for (int j = 0; j < 8; ++j) { o[j] -= mu; q += o[j] * o[j]; }
        const float rstd = 1.0f / sqrtf(wave_sum(q) * (1.0f / RET_DV) + GN_EPS);
        float r[8];
#pragma unroll
        for (int j = 0; j < 8; ++j) r[j] = o[j] * rstd * silu((float)gv[j]);
        u32x4 w; w.x = pk_h2(r[0], r[1]); w.y = pk_h2(r[2], r[3]); w.z = pk_h2(r[4], r[5]); w.w = pk_h2(r[6], r[7]);
        *(u32x4*)(A + off) = w;
    }
}
template <bool XIN_H>
__device__ __forceinline__ void phase_layernorm(const void* xin_, const h16* Y, float* xout_f, h16* xout_h, const float* g, const float* bta, const float* mod_next, h16* H, int bid, int G) {
    const int tid_ = opaque_tid(); const int gw = bid * NWAVES + (tid_ >> 6), lane = tid_ & 63, NGW = G * NWAVES;
    for (int m = gw; m < M; m += NGW) {
        const h16* yr = Y + (size_t)m * D; f32x4 v[8]; float s = 0.f;
#pragma unroll
        for (int j = 0; j < 4; ++j) { const h16x8 yv = *(const h16x8*)(yr + j * 512 + lane * 8); f32x4 x0, x1;
            if (XIN_H) { const h16x8 xv = *(const h16x8*)((const h16*)xin_ + (size_t)m * D + j * 512 + lane * 8); x0 = (f32x4){(float)xv[0], (float)xv[1], (float)xv[2], (float)xv[3]}; x1 = (f32x4){(float)xv[4], (float)xv[5], (float)xv[6], (float)xv[7]}; }
            else { const float* xr = (const float*)xin_ + (size_t)m * D + j * 512 + lane * 8; x0 = *(const f32x4*)xr; x1 = *(const f32x4*)(xr + 4); }
            v[2 * j] = x0 * ALPHA + (f32x4){(float)yv[0], (float)yv[1], (float)yv[2], (float)yv[3]}; v[2 * j + 1] = x1 * ALPHA + (f32x4){(float)yv[4], (float)yv[5], (float)yv[6], (float)yv[7]}; }
#pragma unroll
        for (int j = 0; j < 8; ++j) s += (v[j][0] + v[j][1]) + (v[j][2] + v[j][3]);
        const float mu = wave_sum(s) * (1.0f / D); float q = 0.f;
#pragma unroll
        for (int j = 0; j < 8; ++j) { v[j] = v[j] - mu; q += (v[j][0] * v[j][0] + v[j][1] * v[j][1]) + (v[j][2] * v[j][2] + v[j][3] * v[j][3]); }
        const float rstd = 1.0f / sqrtf(wave_sum(q) * (1.0f / D) + LN_EPS);
        const int b = m / SEQ;
#pragma unroll
        for (int j = 0; j < 4; ++j) { const int c = j * 512 + lane * 8;
            const f32x4 xo0 = v[2 * j] * rstd * *(const f32x4*)(g + c) + *(const f32x4*)(bta + c), xo1 = v[2 * j + 1] * rstd * *(const f32x4*)(g + c + 4) + *(const f32x4*)(bta + c + 4);
            if (xout_f) { *(f32x4*)(xout_f + (size_t)m * D + c) = xo0; *(f32x4*)(xout_f + (size_t)m * D + c + 4) = xo1; }
            if (xout_h) { u32x4 w; w.x = pk_h2(xo0[0], xo0[1]); w.y = pk_h2(xo0[2], xo0[3]); w.z = pk_h2(xo1[0], xo1[1]); w.w = pk_h2(xo1[2], xo1[3]); *(u32x4*)(xout_h + (size_t)m * D + c) = w; }
            if (H) { const float* mp = mod_next + (size_t)b * MODW + c; const f32x4 sh0 = *(const f32x4*)mp, sh1 = *(const f32x4*)(mp + 4), sc0 = *(const f32x4*)(mp + D), sc1 = *(const f32x4*)(mp + D + 4);
                const f32x4 h0 = xo0 * (sc0 + 1.0f) + sh0, h1 = xo1 * (sc1 + 1.0f) + sh1; u32x4 w; w.x = pk_h2(h0[0], h0[1]); w.y = pk_h2(h0[2], h0[3]); w.z = pk_h2(h1[0], h1[1]); w.w = pk_h2(h1[2], h1[3]); *(u32x4*)(H + (size_t)m * D + c) = w; } }
    }
}

__device__ __forceinline__ void phase_retention_naive(const h16* Q, const h16* K, h16* VO, float* ldsf, int bid, int G) {
    constexpr int TT = 4;
    const int tid_ = opaque_tid(); const int half = tid_ >> 8, tid = tid_ & 255, vi = tid & 63, dq = tid >> 6;
    float* qs = ldsf + half * (3 * TT * 256);
    float* ks = qs + TT * 256;
    float* red = ks + TT * 256;
    for (int vb0 = bid * 2; vb0 < BATCH * RET_HEADS * 8; vb0 += 2 * G) {
        const int blk = vb0 + half, vg = blk & 7, h = (blk >> 3) & 7, b = blk >> 6;
        const float gamma = 1.0f - exp2f(-5.0f - (float)h);
        float S[64];
#pragma unroll
        for (int d = 0; d < 64; ++d) S[d] = 0.f;
        for (int t0 = 0; t0 < SEQ; t0 += TT) {
            __syncthreads();
            for (int i = tid; i < TT * 256; i += 256) { const int tt = i >> 8, d = i & 255; const size_t row = (size_t)(b * SEQ + t0 + tt);
                qs[tt * 256 + d] = (float)Q[row * RET_QK + h * 256 + d]; ks[tt * 256 + d] = (float)K[row * RET_QK + h * 256 + d]; }
            __syncthreads();
            float po[TT];
#pragma unroll
            for (int tt = 0; tt < TT; ++tt) {
                const float v = (float)VO[(size_t)(b * SEQ + t0 + tt) * RET_V + h * 512 + vg * 64 + vi];
                float a = 0.f;
#pragma unroll
                for (int d = 0; d < 64; ++d) { S[d] = gamma * S[d] + ks[tt * 256 + dq * 64 + d] * v; a += qs[tt * 256 + dq * 64 + d] * S[d]; }
                po[tt] = a;
            }
#pragma unroll
            for (int tt = 0; tt < TT; ++tt) red[(dq * TT + tt) * 64 + vi] = po[tt];
            __syncthreads();
            for (int i = tid; i < TT * 64; i += 256) { const int tt = i >> 6, v = i & 63;
                const float o = (red[(0 * TT + tt) * 64 + v] + red[(1 * TT + tt) * 64 + v]) + (red[(2 * TT + tt) * 64 + v] + red[(3 * TT + tt) * 64 + v]);
                VO[(size_t)(b * SEQ + t0 + tt) * RET_V + h * 512 + vg * 64 + v] = (h16)o; }
        }
        __syncthreads();
    }
}


#define TR_READ(dst, addr, off) asm volatile("ds_read_b64_tr_b16 %0, %1 offset:%2" : "=v"(dst) : "v"(addr), "i"(off))
typedef short v4i16 __attribute__((__vector_size__(8)));
__device__ __forceinline__ h16x4 lds_tr_read(LAS unsigned char* p) { const v4i16 v = __builtin_amdgcn_ds_read_tr16_b64_v4i16((LAS v4i16*)p); return __builtin_bit_cast(h16x4, v); }
__device__ __forceinline__ int off_b(int row, int ch) { return 256 * row + 16 * (ch ^ (((row & 3) << 2) | ((row >> 2) & 3))); }
__device__ __forceinline__ int tr_addr16(int lane, int c, int ks, int t) { const int g = lane >> 4, q = (lane & 15) >> 2, p = lane & 3; return off_b(32 * ks + 8 * g + 4 * t + q, 2 * c + (p >> 1)) + 8 * (p & 1); }
__device__ __forceinline__ h16x8 cat8(h16x4 a, h16x4 b) { return __builtin_shufflevector(a, b, 0, 1, 2, 3, 4, 5, 6, 7); }
__device__ __forceinline__ void fill_piece(LAS unsigned char* tile, const h16* g0, size_t pitch_elems, int piece, int lane) {
    const int rr = lane >> 4, cp = lane & 15, row = 4 * piece + rr, ch = cp ^ ((rr << 2) | (piece & 3));
    __builtin_amdgcn_global_load_lds((const unsigned*)(g0 + (size_t)row * pitch_elems + ch * 8), (LAS unsigned*)(tile + piece * 1024), 16, 0, 0);
}
constexpr int R_Q = 0, R_KV = 32768, KV_STRIDE = 49152  , R_SC = 131072, SC_PITCH = 144;
static_assert(R_SC + 64 * SC_PITCH <= MISC_OFF, "retention LDS map");
__device__ __forceinline__ void phase_retention(const h16* Q, const h16* K, h16* VO, LAS unsigned char* L, int bid, int G) {
    const int tid = opaque_tid(), w = __builtin_amdgcn_readfirstlane(tid >> 6), lane = tid & 63, r = lane & 15, g = lane >> 4;
    for (int item = bid; item < BATCH * RET_HEADS * 4; item += G) {
        const int bh = (item & 7) | ((item >> 5) << 3), vs = (item >> 3) & 3, b = bh >> 3, h = bh & 7;
        const float l2g = log2f(1.0f - exp2f(-5.0f - (float)h));
        const int mt = w >> 1, nt0 = (w & 1) * 2;
        float mk[2][4], qd[4];
#pragma unroll
        for (int t = 0; t < 2; ++t)
#pragma unroll
            for (int i = 0; i < 4; ++i) { const int n = 16 * (nt0 + t) + r, m = 16 * mt + 4 * g + i; mk[t][i] = (n >= m) ? exp2f((float)(n - m) * l2g) : 0.0f; }
#pragma unroll
        for (int nt = 0; nt < 4; ++nt) qd[nt] = exp2f((float)(16 * nt + r + 1) * l2g);
        h16x8 kd[2];
#pragma unroll
        for (int ks = 0; ks < 2; ++ks)
#pragma unroll
            for (int j = 0; j < 8; ++j) kd[ks][j] = (h16)exp2f((float)(63 - (32 * ks + 8 * g + j)) * l2g);
        const float gC = exp2f(64.0f * l2g);
        f32x4 S[16];
#pragma unroll
        for (int dt = 0; dt < 16; ++dt) S[dt] = (f32x4){0.f, 0.f, 0.f, 0.f};
        const h16* Qg = Q + (size_t)b * SEQ * RET_QK + h * 256;
        const h16* Kg = K + (size_t)b * SEQ * RET_QK + h * 256;
        h16* Vg = VO + (size_t)b * SEQ * RET_V + h * 512 + vs * 128;
        const int hfw = w >> 2, p0w = (w & 3) * 4;
#define RET_FILL_Q(c_) do { int ln_ = lane; asm volatile("" : "+v"(ln_)); _Pragma("unroll") for (int i = 0; i < 4; ++i) fill_piece(L + R_Q + hfw * 16384, Qg + (size_t)(c_) * 64 * RET_QK + hfw * 128, RET_QK, p0w + i, ln_); } while (0)
#define RET_FILL_KV(c_, buf_) do { int ln_ = lane; asm volatile("" : "+v"(ln_)); LAS unsigned char* kvb_ = L + R_KV + (buf_) * KV_STRIDE; \
            _Pragma("unroll") for (int i = 0; i < 4; ++i) fill_piece(kvb_ + hfw * 16384, Kg + (size_t)(c_) * 64 * RET_QK + hfw * 128, RET_QK, p0w + i, ln_); \
            _Pragma("unroll") for (int i = 0; i < 2; ++i) fill_piece(kvb_ + 32768, Vg + (size_t)(c_) * 64 * RET_V, RET_V, 2 * w + i, ln_); } while (0)
        RET_FILL_KV(0, 0); RET_FILL_Q(0);
        for (int c = 0; c < SEQ / 64; ++c) {
            asm volatile("s_waitcnt vmcnt(0)" ::: "memory"); asm volatile("s_waitcnt lgkmcnt(0)" ::: "memory"); __builtin_amdgcn_s_barrier(); asm volatile("" ::: "memory");
            if (c + 1 < SEQ / 64) RET_FILL_KV(c + 1, (c + 1) & 1);
            unsigned kvoff = (unsigned)(R_KV + (c & 1) * KV_STRIDE); asm volatile("" : "+s"(kvoff));
            LAS unsigned char* Kb = L + kvoff; LAS unsigned char* Vb = Kb + 32768;
            { f32x4 sc[2] = {(f32x4){0.f, 0.f, 0.f, 0.f}, (f32x4){0.f, 0.f, 0.f, 0.f}};
#pragma unroll
                for (int hf = 0; hf < 2; ++hf)
#pragma unroll
                    for (int s = 0; s < 4; ++s) {
                        const h16x8 a = *(const LAS h16x8*)(Kb + hf * 16384 + off_b(16 * mt + r, 4 * s + g));
                        const h16x8 b0 = *(const LAS h16x8*)(L + R_Q + hf * 16384 + off_b(16 * nt0 + r, 4 * s + g));
                        const h16x8 b1 = *(const LAS h16x8*)(L + R_Q + hf * 16384 + off_b(16 * (nt0 + 1) + r, 4 * s + g));
                        sc[0] = __builtin_amdgcn_mfma_f32_16x16x32_f16(a, b0, sc[0], 0, 0, 0);
                        sc[1] = __builtin_amdgcn_mfma_f32_16x16x32_f16(a, b1, sc[1], 0, 0, 0); }
#pragma unroll
                for (int t = 0; t < 2; ++t) { u32x2 wv; wv.x = pk_h2(sc[t][0] * mk[t][0], sc[t][1] * mk[t][1]); wv.y = pk_h2(sc[t][2] * mk[t][2], sc[t][3] * mk[t][3]);
                    *(LAS u32x2*)(L + R_SC + (16 * (nt0 + t) + r) * SC_PITCH + 2 * (16 * mt + 4 * g)) = wv; } }
            f32x4 o3[4];
#pragma unroll
            for (int nt = 0; nt < 4; ++nt) o3[nt] = (f32x4){0.f, 0.f, 0.f, 0.f};
#pragma unroll
            for (int s = 0; s < 8; ++s) {
                const f32x4 s0 = S[2 * s], s1 = S[2 * s + 1];
                h16x8 af; af[0] = (h16)s0[0]; af[1] = (h16)s0[1]; af[2] = (h16)s0[2]; af[3] = (h16)s0[3]; af[4] = (h16)s1[0]; af[5] = (h16)s1[1]; af[6] = (h16)s1[2]; af[7] = (h16)s1[3];
                const int hf = s >> 2, ss = s & 3;
#pragma unroll
                for (int nt = 0; nt < 4; ++nt) {
                    const h16x4 lo = *(const LAS h16x4*)(L + R_Q + hf * 16384 + off_b(16 * nt + r, 4 * ss + (g >> 1)) + 8 * (g & 1));
                    const h16x4 hi = *(const LAS h16x4*)(L + R_Q + hf * 16384 + off_b(16 * nt + r, 4 * ss + 2 + (g >> 1)) + 8 * (g & 1));
                    o3[nt] = __builtin_amdgcn_mfma_f32_16x16x32_f16(af, cat8(lo, hi), o3[nt], 0, 0, 0); }
            }
            asm volatile("s_waitcnt lgkmcnt(0)" ::: "memory"); __builtin_amdgcn_s_barrier(); asm volatile("" ::: "memory");
            if (c + 1 < SEQ / 64) RET_FILL_Q(c + 1);
            int lnb = lane; asm volatile("" : "+v"(lnb));
            const unsigned vb32 = (unsigned)(size_t)Vb, kb32 = (unsigned)(size_t)Kb;
            h16x4 vq[2][2];
#pragma unroll
            for (int ks = 0; ks < 2; ++ks) { TR_READ(vq[ks][0], vb32 + (unsigned)tr_addr16(lnb, w, ks, 0), 0); TR_READ(vq[ks][1], vb32 + (unsigned)tr_addr16(lnb, w, ks, 1), 0); }
            asm volatile("s_waitcnt lgkmcnt(0)" ::: "memory"); __builtin_amdgcn_sched_barrier(0);
            h16x8 vf[2]; vf[0] = cat8(vq[0][0], vq[0][1]); vf[1] = cat8(vq[1][0], vq[1][1]);
#pragma unroll
            for (int nt = 0; nt < 4; ++nt) {
                f32x4 o2 = (f32x4){0.f, 0.f, 0.f, 0.f};
#pragma unroll
                for (int ks = 0; ks < 2; ++ks) { const h16x8 bf = *(const LAS h16x8*)(L + R_SC + (16 * nt + r) * SC_PITCH + 2 * (32 * ks + 8 * g));
                    o2 = __builtin_amdgcn_mfma_f32_16x16x32_f16(vf[ks], bf, o2, 0, 0, 0); }
                const f32x4 o = o2 + o3[nt] * qd[nt];
                u32x2 wv; wv.x = pk_h2(o[0], o[1]); wv.y = pk_h2(o[2], o[3]);
                *(u32x2*)(Vg + (size_t)(c * 64 + 16 * nt + r) * RET_V + 16 * w + 4 * g) = wv; }
            const h16x8 vk0 = vf[0] * kd[0], vk1 = vf[1] * kd[1];
            asm volatile("s_waitcnt lgkmcnt(0)" ::: "memory"); __builtin_amdgcn_sched_barrier(0);
            h16x4 ka[2][4];
            { const unsigned a0 = kb32 + (unsigned)tr_addr16(lnb, 0, 0, 0), a1 = kb32 + (unsigned)tr_addr16(lnb, 0, 0, 1), a2 = kb32 + (unsigned)tr_addr16(lnb, 0, 1, 0), a3 = kb32 + (unsigned)tr_addr16(lnb, 0, 1, 1);
                TR_READ(ka[0][0], a0, 0); TR_READ(ka[0][1], a1, 0); TR_READ(ka[0][2], a2, 0); TR_READ(ka[0][3], a3, 0); }
#pragma unroll
            for (int dt = 0; dt < 16; ++dt) {
                if (dt + 1 < 16) { const int hf = (dt + 1) >> 3, c8 = (dt + 1) & 7;
                    const unsigned a0 = kb32 + (unsigned)(hf * 16384 + tr_addr16(lnb, c8, 0, 0)), a1 = kb32 + (unsigned)(hf * 16384 + tr_addr16(lnb, c8, 0, 1)), a2 = kb32 + (unsigned)(hf * 16384 + tr_addr16(lnb, c8, 1, 0)), a3 = kb32 + (unsigned)(hf * 16384 + tr_addr16(lnb, c8, 1, 1));
                    TR_READ(ka[(dt + 1) & 1][0], a0, 0); TR_READ(ka[(dt + 1) & 1][1], a1, 0); TR_READ(ka[(dt + 1) & 1][2], a2, 0); TR_READ(ka[(dt + 1) & 1][3], a3, 0);
                    asm volatile("s_waitcnt lgkmcnt(4)" ::: "memory"); } else { asm volatile("s_waitcnt lgkmcnt(0)" ::: "memory"); }
                __builtin_amdgcn_sched_barrier(0);
                f32x4 acc = S[dt] * gC;
                acc = __builtin_amdgcn_mfma_f32_16x16x32_f16(cat8(ka[dt & 1][0], ka[dt & 1][1]), vk0, acc, 0, 0, 0);
                acc = __builtin_amdgcn_mfma_f32_16x16x32_f16(cat8(ka[dt & 1][2], ka[dt & 1][3]), vk1, acc, 0, 0, 0);
                S[dt] = acc; __builtin_amdgcn_sched_barrier(0); }
        }
        asm volatile("s_waitcnt vmcnt(0) lgkmcnt(0)" ::: "memory"); __builtin_amdgcn_s_barrier(); asm volatile("" ::: "memory");
#undef RET_FILL_Q
#undef RET_FILL_KV
    }
    asm volatile("s_waitcnt vmcnt(0)" ::: "memory"); __syncthreads();
}

__device__ __forceinline__ void phase_kmean(const h16* K, float* kmean, int bid, int G) {
    const int tid_ = opaque_tid();
    for (int i = bid * NT + tid_; i < BATCH * NBLK * MOBA_W; i += G * NT) {
        const int col = i % MOBA_W, bb = i / MOBA_W;
        float s = 0.f; for (int t = 0; t < MOBA_BLOCK; ++t) s += (float)K[((size_t)bb * MOBA_BLOCK + t) * MOBA_W + col];
        kmean[i] = s * (1.0f / MOBA_BLOCK); }
}
__device__ __forceinline__ void phase_moba_naive(const h16* Q, const h16* K, const h16* V, const h16* Gt, const float* kmean, h16* A, int bid, int G) {
    const int tid_ = opaque_tid(); const int half = tid_ >> 8, tid = tid_ & 255, qi = tid >> 2, part = tid & 3;
    for (int vb0 = bid * 2; vb0 < BATCH * MOBA_HEADS * 32; vb0 += 2 * G) {
        const int blk = vb0 + half, qt = blk & 31, h = (blk >> 5) & 15, b = blk >> 9;
        const int t = qt * 64 + qi, own = t >> 8; const size_t row = (size_t)b * SEQ + t;
        float q[32];
#pragma unroll
        for (int j = 0; j < 32; ++j) q[j] = (float)Q[row * MOBA_W + h * 128 + part * 32 + j];
        float gs[NBLK]; unsigned sel = 0u;
#pragma unroll
        for (int n = 0; n < NBLK; ++n) { float a = 0.f;
#pragma unroll
            for (int j = 0; j < 32; ++j) a += q[j] * kmean[((size_t)(b * NBLK + n)) * MOBA_W + h * 128 + part * 32 + j];
            a += __shfl_xor(a, 1); a += __shfl_xor(a, 2); gs[n] = a; }
#pragma unroll
        for (int r = 0; r < 3; ++r) { int best = -1; float bv = -3e38f;
#pragma unroll
            for (int n = 0; n < NBLK; ++n) if (n < own && !((sel >> n) & 1u) && gs[n] > bv) { bv = gs[n]; best = n; }
            if (best >= 0) sel |= 1u << best; }
        const float scale = 0.08838834764831845f;
        float mrun = -1e30f, lrun = 0.f, acc[32];
#pragma unroll
        for (int j = 0; j < 32; ++j) acc[j] = 0.f;
        for (int n = 0; n <= own; ++n) {
            const bool use = (n == own) || ((sel >> n) & 1u);
            if (!use) continue;
            const int kend = (n == own) ? (t & 255) + 1 : MOBA_BLOCK;
            for (int kk = 0; kk < kend; ++kk) {
                const size_t krow = (size_t)b * SEQ + n * MOBA_BLOCK + kk;
                const h16* kp = K + krow * MOBA_W + h * 128 + part * 32; float s = 0.f;
#pragma unroll
                for (int j = 0; j < 32; ++j) s += q[j] * (float)kp[j];
                s += __shfl_xor(s, 1); s += __shfl_xor(s, 2); s *= scale;
                const float mn = fmaxf(mrun, s), al = __expf(mrun - mn), p = __expf(s - mn);
                lrun = lrun * al + p; mrun = mn;
                const h16* vp = V + krow * MOBA_W + h * 128 + part * 32;
#pragma unroll
                for (int j = 0; j < 32; ++j) acc[j] = acc[j] * al + p * (float)vp[j];
            }
        }
        const float inv = 1.0f / lrun;
#pragma unroll
        for (int j = 0; j < 32; ++j) { const size_t o = row * MOBA_W + h * 128 + part * 32 + j; A[o] = (h16)(acc[j] * inv * silu((float)Gt[o])); }
    }
}


__device__ __forceinline__ int off_v(int row, int ch) { return 256 * row + 16 * (ch ^ (2 * (row & 7))); }
#define LDS_READ128(dst, addr, off) asm volatile("ds_read_b128 %0, %1 offset:%2" : "=v"(dst) : "v"(addr), "i"(off))
__device__ __forceinline__ void fill_piece_k(LAS unsigned char* tile, const h16* g0, size_t pitch_elems, int piece, int lane) {
    const int rr = lane >> 4, cp = lane & 15, row = 4 * piece + rr, ch = cp ^ (row & 15);
    __builtin_amdgcn_global_load_lds((const unsigned*)(g0 + (size_t)row * pitch_elems + ch * 8), (LAS unsigned*)(tile + piece * 1024), 16, 0, 0);
}
__device__ __forceinline__ void fill_piece_v(LAS unsigned char* tile, const h16* g0, size_t pitch_elems, int piece, int lane) {
    const int rr = lane >> 4, cp = lane & 15, row = 4 * piece + rr, ch = cp ^ (2 * (row & 7));
    __builtin_amdgcn_global_load_lds((const unsigned*)(g0 + (size_t)row * pitch_elems + ch * 8), (LAS unsigned*)(tile + piece * 1024), 16, 0, 0);
}
__device__ __forceinline__ float xmax16(float x) { const auto r_ = __builtin_amdgcn_permlane16_swap(__builtin_bit_cast(unsigned, x), __builtin_bit_cast(unsigned, x), false, false); return fmaxf(__builtin_bit_cast(float, r_[0]), __builtin_bit_cast(float, r_[1])); }
__device__ __forceinline__ float xmax32(float x) { const auto r_ = __builtin_amdgcn_permlane32_swap(__builtin_bit_cast(unsigned, x), __builtin_bit_cast(unsigned, x), false, false); return fmaxf(__builtin_bit_cast(float, r_[0]), __builtin_bit_cast(float, r_[1])); }
template <int VAR>
__device__ __forceinline__ void phase_moba(const h16* Q, const h16* K, const h16* V, const h16* Gt, const float* kmean, h16* A, LAS unsigned char* L, int bid, int G) {
    const int tid = opaque_tid(), w = __builtin_amdgcn_readfirstlane(tid >> 6), lane = tid & 63, r = lane & 15, g = lane >> 4;
    const float NEG_INF = -__builtin_inff();
    const float cs = 0.08838834764831845f * 1.4426950408889634f;
    const bool lead = w < 4;
    unsigned long long stamp_t = 0, stamp_sum = 0; int stamp_n = 0;
    for (int vb = bid; vb < BATCH * MOBA_HEADS * 4; vb += G) {
        const int xcd = vb & 7, jj = vb >> 3, pr = jj & 3, bh = xcd + 8 * (jj >> 2), b = bh >> 4, h = bh & 15;
        const h16* Kg = K + (size_t)b * SEQ * MOBA_W + h * 128;
        const h16* Vg = V + (size_t)b * SEQ * MOBA_W + h * 128;
        for (int half = 0; half < 2; ++half) {
            const int qb = half ? 7 - pr : pr;
            const size_t row0 = (size_t)b * SEQ + qb * 256 + 32 * w;
            h16x8 qf[2][4];
#pragma unroll
            for (int qt = 0; qt < 2; ++qt)
#pragma unroll
                for (int s = 0; s < 4; ++s) qf[qt][s] = *(const h16x8*)(Q + (row0 + 16 * qt + r) * MOBA_W + h * 128 + 32 * s + 8 * g);
            unsigned sel[2] = {0u, 0u};
            if (qb > 0) {
                f32x4 gt[2] = {(f32x4){0.f, 0.f, 0.f, 0.f}, (f32x4){0.f, 0.f, 0.f, 0.f}};
#pragma unroll
                for (int s = 0; s < 4; ++s) {
                    h16x8 hi, lo;
                    const float* kp = kmean + ((size_t)(b * NBLK + (r & 7))) * MOBA_W + h * 128 + 32 * s + 8 * g;
                    const f32x4 k0 = *(const f32x4*)kp, k1 = *(const f32x4*)(kp + 4);
#pragma unroll
                    for (int j = 0; j < 8; ++j) { const float kv = (r < 8) ? (j < 4 ? k0[j & 3] : k1[j & 3]) : 0.0f; const h16 hh = (h16)kv; hi[j] = hh; lo[j] = (h16)(kv - (float)hh); }
#pragma unroll
                    for (int qt = 0; qt < 2; ++qt) { gt[qt] = __builtin_amdgcn_mfma_f32_16x16x32_f16(hi, qf[qt][s], gt[qt], 0, 0, 0); gt[qt] = __builtin_amdgcn_mfma_f32_16x16x32_f16(lo, qf[qt][s], gt[qt], 0, 0, 0); }
                }
#pragma unroll
                for (int qt = 0; qt < 2; ++qt) {
                    float gs[8];
#pragma unroll
                    for (int i = 0; i < 4; ++i) { gs[i] = __shfl(gt[qt][i], r); gs[4 + i] = __shfl(gt[qt][i], r + 16); }
                    unsigned sm = 0u;
#pragma unroll
                    for (int rr = 0; rr < 3; ++rr) { int best = -1; float bv = -3e38f;
#pragma unroll
                        for (int n = 0; n < NBLK; ++n) if (n < qb && !((sm >> n) & 1u) && gs[n] > bv) { bv = gs[n]; best = n; }
                        if (best >= 0) sm |= 1u << best; }
                    sel[qt] = sm;
                }
            }
            f32x4 o[8][2];
#pragma unroll
            for (int dt = 0; dt < 8; ++dt) { o[dt][0] = (f32x4){0.f, 0.f, 0.f, 0.f}; o[dt][1] = (f32x4){0.f, 0.f, 0.f, 0.f}; }
            float mrun[2] = {NEG_INF, NEG_INF}, lrun[2] = {0.f, 0.f};
            const int ntiles = 4 * (qb + 1);
            f32x4 st[4][2]; float marg[2] = {0.f, 0.f}, alr[2] = {1.f, 1.f}; bool chg = false, needB = false; int slotB = 0;
#pragma unroll
            for (int kt = 0; kt < 4; ++kt) { st[kt][0] = (f32x4){0.f, 0.f, 0.f, 0.f}; st[kt][1] = (f32x4){0.f, 0.f, 0.f, 0.f}; }
#define MOBA_FILL(it_, slot_) do { const int n_ = (it_) < 4 ? qb : (((it_) - 4) >> 2); const size_t k0_ = (size_t)n_ * 256 + 64 * ((it_) & 3); \
                LAS unsigned char* kb_ = L + (slot_) * 32768; int ln_ = lane; asm volatile("" : "+v"(ln_)); \
                fill_piece_k(kb_, Kg + k0_ * MOBA_W, MOBA_W, 2 * w, ln_); fill_piece_k(kb_, Kg + k0_ * MOBA_W, MOBA_W, 2 * w + 1, ln_); \
                fill_piece_v(kb_ + 16384, Vg + k0_ * MOBA_W, MOBA_W, 2 * w, ln_); fill_piece_v(kb_ + 16384, Vg + k0_ * MOBA_W, MOBA_W, 2 * w + 1, ln_); } while (0)
#define MOBA_A(it_) do { const int ita_ = (it_); const bool own_ = ita_ < 4; const int n_ = own_ ? qb : ((ita_ - 4) >> 2), t_ = ita_ & 3; \
                needB = (VAR != 1) && (own_ ? (t_ <= (w >> 1)) : (__any((int)(((sel[0] | sel[1]) >> n_) & 1u)) != 0)); slotB = ita_ & 3; \
                if (needB) { \
                    unsigned kslot_ = (unsigned)(ita_ & 3) * 32768u; asm volatile("" : "+s"(kslot_));     \
                    h16x8 kf[4][4]; unsigned ka_[4]; \
                    { int ln_ = lane; asm volatile("" : "+v"(ln_)); const int r_ = ln_ & 15, g_ = ln_ >> 4; const unsigned kbase = (unsigned)(size_t)L + kslot_ + (unsigned)(256 * r_); \
                        _Pragma("unroll") for (int s = 0; s < 4; ++s) ka_[s] = kbase + (unsigned)(16 * ((4 * s + g_) ^ r_)); } \
                    _Pragma("unroll") for (int kt = 0; kt < 4; ++kt) { st[kt][0] = (f32x4){0.f, 0.f, 0.f, 0.f}; st[kt][1] = (f32x4){0.f, 0.f, 0.f, 0.f}; } \
                      \
                    LDS_READ128(kf[0][0], ka_[0], 0); LDS_READ128(kf[1][0], ka_[0], 4096); LDS_READ128(kf[2][0], ka_[0], 8192); LDS_READ128(kf[3][0], ka_[0], 12288); \
                    LDS_READ128(kf[0][1], ka_[1], 0); LDS_READ128(kf[1][1], ka_[1], 4096); LDS_READ128(kf[2][1], ka_[1], 8192); LDS_READ128(kf[3][1], ka_[1], 12288); \
                    asm volatile("s_waitcnt lgkmcnt(4)" ::: "memory"); __builtin_amdgcn_sched_barrier(0); \
                    _Pragma("unroll") for (int kt = 0; kt < 4; ++kt) { \
                            st[kt][0] = __builtin_amdgcn_mfma_f32_16x16x32_f16(kf[kt][0], qf[0][0], st[kt][0], 0, 0, 0); \
                            st[kt][1] = __builtin_amdgcn_mfma_f32_16x16x32_f16(kf[kt][0], qf[1][0], st[kt][1], 0, 0, 0); } \
                    __builtin_amdgcn_sched_barrier(0); \
                    LDS_READ128(kf[0][2], ka_[2], 0); LDS_READ128(kf[1][2], ka_[2], 4096); LDS_READ128(kf[2][2], ka_[2], 8192); LDS_READ128(kf[3][2], ka_[2], 12288); \
                    asm volatile("s_waitcnt lgkmcnt(4)" ::: "memory"); __builtin_amdgcn_sched_barrier(0); \
                    _Pragma("unroll") for (int kt = 0; kt < 4; ++kt) { \
                            st[kt][0] = __builtin_amdgcn_mfma_f32_16x16x32_f16(kf[kt][1], qf[0][1], st[kt][0], 0, 0, 0); \
                            st[kt][1] = __builtin_amdgcn_mfma_f32_16x16x32_f16(kf[kt][1], qf[1][1], st[kt][1], 0, 0, 0); } \
                    __builtin_amdgcn_sched_barrier(0); \
                    LDS_READ128(kf[0][3], ka_[3], 0); LDS_READ128(kf[1][3], ka_[3], 4096); LDS_READ128(kf[2][3], ka_[3], 8192); LDS_READ128(kf[3][3], ka_[3], 12288); \
                    asm volatile("s_waitcnt lgkmcnt(4)" ::: "memory"); __builtin_amdgcn_sched_barrier(0); \
                    _Pragma("unroll") for (int kt = 0; kt < 4; ++kt) { \
                            st[kt][0] = __builtin_amdgcn_mfma_f32_16x16x32_f16(kf[kt][2], qf[0][2], st[kt][0], 0, 0, 0); \
                            st[kt][1] = __builtin_amdgcn_mfma_f32_16x16x32_f16(kf[kt][2], qf[1][2], st[kt][1], 0, 0, 0); } \
                    __builtin_amdgcn_sched_barrier(0); asm volatile("s_waitcnt lgkmcnt(0)" ::: "memory"); __builtin_amdgcn_sched_barrier(0); \
                    _Pragma("unroll") for (int kt = 0; kt < 4; ++kt) { \
                            st[kt][0] = __builtin_amdgcn_mfma_f32_16x16x32_f16(kf[kt][3], qf[0][3], st[kt][0], 0, 0, 0); \
                            st[kt][1] = __builtin_amdgcn_mfma_f32_16x16x32_f16(kf[kt][3], qf[1][3], st[kt][1], 0, 0, 0); } \
                    const bool diag_ = own_ && (t_ == (w >> 1)); chg = false; \
                    _Pragma("unroll") for (int qt = 0; qt < 2; ++qt) { \
                        const bool rowsel = own_ || (((sel[qt] >> n_) & 1u) != 0u); \
                        if (diag_) { const int qpos = 32 * w + 16 * qt + r; \
                            _Pragma("unroll") for (int kt = 0; kt < 4; ++kt) _Pragma("unroll") for (int i = 0; i < 4; ++i) { const int kpos = 64 * t_ + 16 * kt + 4 * g + i; if (kpos > qpos) st[kt][qt][i] = NEG_INF; } } \
                        float mx = NEG_INF; \
                        _Pragma("unroll") for (int kt = 0; kt < 4; ++kt) { mx = fmaxf(fmaxf(mx, st[kt][qt][0]), st[kt][qt][1]); mx = fmaxf(fmaxf(mx, st[kt][qt][2]), st[kt][qt][3]); } \
                        mx = xmax32(xmax16(mx)); \
                        mx = rowsel ? mx * cs : NEG_INF; \
                        const float mold = mrun[qt]; \
                        const float mn = (mx > mold + 6.0f) ? mx : mold;            \
                        marg[qt] = rowsel ? mn : __builtin_inff();                     \
                        alr[qt] = __builtin_amdgcn_exp2f(mold - mn); chg = chg || (mn != mold); mrun[qt] = mn; } \
                    { float sum0 = 0.f;     \
                        _Pragma("unroll") for (int kt = 0; kt < 4; ++kt) _Pragma("unroll") for (int i = 0; i < 4; ++i) { const float p = __builtin_amdgcn_exp2f(__builtin_fmaf(st[kt][0][i], cs, -marg[0])); st[kt][0][i] = p; sum0 += p; } \
                        lrun[0] = lrun[0] * alr[0] + sum0; } \
                } } while (0)
#define MOBA_B() do { if (needB) { \
                    unsigned vslot_ = (unsigned)slotB * 32768u + 16384u; asm volatile("" : "+s"(vslot_)); \
                    int lnb_ = lane; asm volatile("" : "+v"(lnb_)); const int q4 = (lnb_ & 15) >> 2, p4 = lnb_ & 3, gb_ = lnb_ >> 4; \
                    const unsigned x32 = (unsigned)(((4 * gb_ + q4) & 7) * 32); \
                    const unsigned vbase = (unsigned)(size_t)L + vslot_ + (unsigned)(256 * (4 * gb_ + q4) + 16 * (p4 >> 1) + 8 * (p4 & 1)); \
                    h16x4 vr[8][2][2]; \
                    _Pragma("unroll") for (int dt = 0; dt < 4; ++dt) { const unsigned va = vbase + (((unsigned)dt * 32u) ^ x32); \
                        TR_READ(vr[dt][0][0], va, 0); TR_READ(vr[dt][0][1], va, 4096); TR_READ(vr[dt][1][0], va, 8192); TR_READ(vr[dt][1][1], va, 12288); } \
                    if (__any((int)chg)) { _Pragma("unroll") for (int dt = 0; dt < 8; ++dt) { o[dt][0] = o[dt][0] * alr[0]; o[dt][1] = o[dt][1] * alr[1]; } } \
                    h16x8 pf[2][2]; \
                    _Pragma("unroll") for (int qt = 0; qt < 2; ++qt) { if (qt == 1) { float sum = 0.f; \
                        _Pragma("unroll") for (int kt = 0; kt < 4; ++kt) _Pragma("unroll") for (int i = 0; i < 4; ++i) { const float p = __builtin_amdgcn_exp2f(__builtin_fmaf(st[kt][qt][i], cs, -marg[qt])); st[kt][qt][i] = p; sum += p; } \
                        lrun[qt] = lrun[qt] * alr[qt] + sum; } \
                        _Pragma("unroll") for (int ks = 0; ks < 2; ++ks) { const f32x4 p0 = st[2 * ks][qt], p1 = st[2 * ks + 1][qt]; h16x8 f; \
                            f[0] = (h16)p0[0]; f[1] = (h16)p0[1]; f[2] = (h16)p0[2]; f[3] = (h16)p0[3]; f[4] = (h16)p1[0]; f[5] = (h16)p1[1]; f[6] = (h16)p1[2]; f[7] = (h16)p1[3]; pf[ks][qt] = f; } } \
                    __builtin_amdgcn_sched_barrier(0); \
                    _Pragma("unroll") for (int dt = 4; dt < 8; ++dt) { const unsigned va = vbase + (((unsigned)dt * 32u) ^ x32); \
                        TR_READ(vr[dt][0][0], va, 0); TR_READ(vr[dt][0][1], va, 4096); TR_READ(vr[dt][1][0], va, 8192); TR_READ(vr[dt][1][1], va, 12288); } \
                    asm volatile("s_waitcnt lgkmcnt(15)" ::: "memory"); __builtin_amdgcn_sched_barrier(0);     \
                    _Pragma("unroll") for (int dt = 0; dt < 4; ++dt) _Pragma("unroll") for (int ks = 0; ks < 2; ++ks) { const h16x8 a = cat8(vr[dt][ks][0], vr[dt][ks][1]); \
                            o[dt][0] = __builtin_amdgcn_mfma_f32_16x16x32_f16(a, pf[ks][0], o[dt][0], 0, 0, 0); \
                            o[dt][1] = __builtin_amdgcn_mfma_f32_16x16x32_f16(a, pf[ks][1], o[dt][1], 0, 0, 0); } \
                    __builtin_amdgcn_sched_barrier(0); asm volatile("s_waitcnt lgkmcnt(0)" ::: "memory"); __builtin_amdgcn_sched_barrier(0); \
                    _Pragma("unroll") for (int dt = 4; dt < 8; ++dt) _Pragma("unroll") for (int ks = 0; ks < 2; ++ks) { const h16x8 a = cat8(vr[dt][ks][0], vr[dt][ks][1]); \
                            o[dt][0] = __builtin_amdgcn_mfma_f32_16x16x32_f16(a, pf[ks][0], o[dt][0], 0, 0, 0); \
                            o[dt][1] = __builtin_amdgcn_mfma_f32_16x16x32_f16(a, pf[ks][1], o[dt][1], 0, 0, 0); } \
                } } while (0)
#define MOBA_TOP(it_) do { if ((it_) + 1 < ntiles) asm volatile("s_waitcnt vmcnt(4)" ::: "memory"); else asm volatile("s_waitcnt vmcnt(0)" ::: "memory");     \
                asm volatile("s_waitcnt lgkmcnt(0)" ::: "memory"); __builtin_amdgcn_s_barrier(); asm volatile("" ::: "memory"); \
                if ((it_) + 2 < ntiles) MOBA_FILL((it_) + 2, ((it_) + 2) & 3); } while (0)
#define MOBA_MID() do { asm volatile("s_waitcnt lgkmcnt(0)" ::: "memory"); __builtin_amdgcn_s_barrier(); asm volatile("" ::: "memory"); } while (0)
#define STAMP() do { if (PROBE_ATT_STAMP >= 0) { __builtin_amdgcn_sched_barrier(0); stamp_t = __builtin_amdgcn_s_memtime(); __builtin_amdgcn_s_waitcnt(0xC07F); __builtin_amdgcn_sched_barrier(0); } } while (0)
#define STAMP_ACC(k) do { if (PROBE_ATT_STAMP >= 0) { __builtin_amdgcn_sched_barrier(0); const unsigned long long t2_ = __builtin_amdgcn_s_memtime(); __builtin_amdgcn_s_waitcnt(0xC07F); if (PROBE_ATT_STAMP == (k)) stamp_sum += t2_ - stamp_t; stamp_t = t2_; __builtin_amdgcn_sched_barrier(0); } } while (0)
            stamp_n += ntiles;
            MOBA_FILL(0, 0); MOBA_FILL(1, 1);
            if (lead) {
                for (int it = 0; it < ntiles; ++it) { STAMP(); MOBA_TOP(it); STAMP_ACC(2); MOBA_A(it); STAMP_ACC(0); MOBA_B(); STAMP_ACC(1); }
            } else {
                for (int it = 0; it < ntiles; ++it) { STAMP(); MOBA_TOP(it); STAMP_ACC(2); MOBA_B(); STAMP_ACC(1); MOBA_A(it); STAMP_ACC(0); }
                MOBA_B();
            }
#undef MOBA_FILL
#undef MOBA_A
#undef MOBA_B
#undef MOBA_TOP
#undef MOBA_MID
#pragma unroll
            for (int qt = 0; qt < 2; ++qt) { float lt = lrun[qt]; lt += __shfl_xor(lt, 16); lt += __shfl_xor(lt, 32); const float inv = 1.0f / lt; const size_t rowoff = (row0 + 16 * qt + r) * MOBA_W + h * 128 + 4 * g;
#pragma unroll
                for (int dt = 0; dt < 8; ++dt) { const h16x4 gv = *(const h16x4*)(Gt + rowoff + 16 * dt); const f32x4 ov = o[dt][qt] * inv;
                    u32x2 wv; wv.x = pk_h2(ov[0] * silu((float)gv[0]), ov[1] * silu((float)gv[1])); wv.y = pk_h2(ov[2] * silu((float)gv[2]), ov[3] * silu((float)gv[3]));
                    *(u32x2*)(A + rowoff + 16 * dt) = wv; } }
        }
    }
    if (PROBE_ATT_STAMP >= 0 && VAR == 0 && bid == 0 && w == PROBE_ATT_WAVE && lane == 0) ((float*)L)[0] = 0.f;
    if (PROBE_ATT_STAMP >= 0 && VAR == 0 && bid == 0 && w == PROBE_ATT_WAVE && lane == 0) *(float*)kmean = (float)stamp_sum / (float)stamp_n * 0.01f;
    asm volatile("s_waitcnt vmcnt(0)" ::: "memory"); __syncthreads();
}

struct Args { const void* in[11]; float* out; unsigned char* ws; int ph_lo, ph_hi; };
constexpr int NPHASE = 12;
#ifndef PROBE_DUP
#define PROBE_DUP 0u
#endif
#ifndef PROBE_MOBA_VAR
#define PROBE_MOBA_VAR -1
#endif
#ifndef PROBE_DUMMY_GEMM
#define PROBE_DUMMY_GEMM 0
#define PROBE_DG_N 3072
#define PROBE_DG_K 1024
#define PROBE_DG_BF16 false
#define PROBE_DG_FIXED 0
#define PROBE_DG_EPI -1
#endif
#ifndef PROBE_CLOCK_PHASE
#define PROBE_CLOCK_PHASE -1
#endif
#ifndef PROBE_XCC
#define PROBE_XCC 0
#endif
#ifndef PROBE_BAR2
#define PROBE_BAR2 0
#endif
__global__ void __launch_bounds__(NT, 2) mk_fwd(Args a) {
    extern __shared__ __attribute__((aligned(16))) unsigned char lds[];
    LAS unsigned char* L = (LAS unsigned char*)lds;
    float* ldsf = (float*)lds;
    const int tid = threadIdx.x, bid = blockIdx.x, G = gridDim.x;
    volatile LAS unsigned* MISC = (volatile LAS unsigned*)(L + MISC_OFF);
    if (tid < 32) MISC[tid] = 0u;
    __syncthreads();
    unsigned char* ws = a.ws;
    Ptrs P;
    P.x = (const float*)a.in[0]; P.c = (const float*)a.in[1]; P.pos = (const int*)a.in[2];
    P.ret_w_in = (const float*)a.in[3]; P.ret_w_out = (const float*)a.in[4]; P.moba_w_in = (const float*)a.in[5]; P.moba_w_out = (const float*)a.in[6];
    P.w_ada = (const float*)a.in[7]; P.b_ada = (const float*)a.in[8]; P.ln_g = (const float*)a.in[9]; P.ln_b = (const float*)a.in[10];
    P.out = a.out; P.MOD = (float*)(ws + WS_MOD); P.PART = (float*)(ws + WS_PART); P.KMEAN = (float*)(ws + WS_KMEAN);
    P.RCS0 = (float2*)(ws + WS_RCS0); P.RCS1 = (float2*)(ws + WS_RCS1);
    P.X1H = (h16*)(ws + WS_W0IN);
    P.W0IN = (h16*)(ws + WS_W0IN); P.W0OUT = (h16*)(ws + WS_W0OUT); P.W1IN = (h16*)(ws + WS_W1IN); P.W1OUT = (h16*)(ws + WS_W1OUT);
    P.Q0 = (h16*)(ws + WS_Q0); P.K0 = (h16*)(ws + WS_K0); P.V0 = (h16*)(ws + WS_V0); P.G0 = (h16*)(ws + WS_G0); P.H0 = (h16*)a.out;
    P.H1 = (h16*)(ws + WS_H1); P.Q1 = (h16*)(ws + WS_Q1); P.K1 = (h16*)(ws + WS_K1); P.V1 = (h16*)(ws + WS_V1); P.G1 = (h16*)(ws + WS_G1); P.A1 = (h16*)(ws + WS_A1);
    if (PROBE_XCC && tid == 0) ((unsigned*)(ws + WS_CTL))[3000 + bid] = xb_xcc_id() + 1u;
    XcdBarrier bar = xcd_barrier_post((unsigned*)(ws + WS_CTL) + CW_BAR, MISC + 8);
    const int lo = a.ph_lo, hi = a.ph_hi;
#define IN(k) (lo <= (k) && (k) < hi)
#define CLK0(k) do { if (PROBE_CLOCK_PHASE == (k) && bid == 0 && tid == 0) { ((unsigned long long*)(ws + WS_CTL))[1024] = __builtin_amdgcn_s_memtime(); ((unsigned long long*)(ws + WS_CTL))[1025] = __builtin_amdgcn_s_memrealtime(); } } while (0)
#define CLK1(k) do { if (PROBE_CLOCK_PHASE == (k) && bid == 0 && tid == 0) { ((unsigned long long*)(ws + WS_CTL))[1026] = __builtin_amdgcn_s_memtime(); ((unsigned long long*)(ws + WS_CTL))[1027] = __builtin_amdgcn_s_memrealtime(); } } while (0)
#define SEAM(k) do { if (IN(k) && IN((k) + 1)) { xcd_barrier(bar); if (PROBE_BAR2) xcd_barrier(bar); } } while (0)
#define REP(k) for (int rep_ = 0; rep_ < (((PROBE_DUP >> (k)) & 1u) ? 2 : 1); ++rep_)
    if (IN(0)) REP(0) { if (rep_) xcd_barrier(bar); phase0(P, ldsf, bid, G); }
    SEAM(0);
    if (IN(1)) REP(1) { if (rep_) xcd_barrier(bar); phase1(P, ldsf, bid, G); }
    SEAM(1);
    CLK0(2);
    if (IN(2)) REP(2) { if (rep_) xcd_barrier(bar); pg8::Gemm g{P.H0, P.W0IN, M, RET_IN, D, 0}; pg8::StaticOrder S; S.init(M, RET_IN, G, bid); EpiRet E{P.Q0, P.K0, P.V0, P.G0, P.pos, P.PART};
        pg8::gemm_phase<EpiRet, pg8::StaticOrder, true, true>(L, g, S, E); }
    CLK1(2);
    SEAM(2);
    if (IN(3)) phase_retention(P.Q0, P.K0, P.V0, L, bid, G);
    SEAM(3);
    if (IN(4)) phase_norm_gate(P.V0, P.G0, P.G0, bid, G);
    SEAM(4);
    if (IN(5)) REP(5) { if (rep_) xcd_barrier(bar); pg8::Gemm g{P.G0, P.W0OUT, M, D, RET_V, 0}; pg8::StaticOrder S; S.init(M, D, G, bid); EpiRes E{P.V0, P.MOD + 2 * D};
        pg8::gemm_phase<EpiRes, pg8::StaticOrder, true, true>(L, g, S, E); }
    SEAM(5);
    if (IN(6)) phase_layernorm<false>(P.x, P.V0, nullptr, P.X1H, P.ln_g, P.ln_b, P.MOD + 8 * MODW, P.H1, bid, G);
    SEAM(6);
    if (IN(7)) REP(7) { if (rep_) xcd_barrier(bar); pg8::Gemm g{P.H1, P.W1IN, M, MOBA_IN, D, 0}; pg8::StaticOrder S; S.init(M, MOBA_IN, G, bid); EpiMoba E{P.Q1, P.K1, P.V1, P.G1, P.pos};
        pg8::gemm_phase<EpiMoba, pg8::StaticOrder, true, true>(L, g, S, E); }
    SEAM(7);
    if (IN(8)) REP(8) { if (rep_) xcd_barrier(bar); phase_kmean(P.K1, P.KMEAN, bid, G); }
    SEAM(8);
    CLK0(9);
    if (IN(9)) { phase_moba<0>(P.Q1, P.K1, P.V1, P.G1, P.KMEAN, P.A1, L, bid, G);
        if (PROBE_MOBA_VAR >= 0) { xcd_barrier(bar); phase_moba<(PROBE_MOBA_VAR < 0 ? 0 : PROBE_MOBA_VAR)>(P.Q1, P.K1, P.V1, P.G1, P.KMEAN, P.H1, L, bid, G); } }
    CLK1(9);
    SEAM(9);
    if (IN(10)) { pg8::Gemm g{P.A1, P.W1OUT, M, D, MOBA_W, 0}; pg8::StaticOrder S; S.init(M, D, G, bid); EpiRes E{P.H1, P.MOD + 8 * MODW + 2 * D};
        pg8::gemm_phase<EpiRes, pg8::StaticOrder, true, true>(L, g, S, E); }
    SEAM(10);
    if (IN(11)) phase_layernorm<true>(P.X1H, P.H1, P.out, nullptr, P.ln_g + D, P.ln_b + D, nullptr, nullptr, bid, G);
    if (PROBE_ATT_STAMP >= 0 && bid == 0) { __syncthreads(); if (tid == 0) { __threadfence(); P.out[0] += __hip_atomic_load(P.KMEAN, __ATOMIC_RELAXED, __HIP_MEMORY_SCOPE_AGENT); } }
    if (PROBE_GEMM_STAMP >= 0 && bid == 0) { __syncthreads(); if (tid == 0) { __threadfence(); P.out[0] += __hip_atomic_load(P.PART, __ATOMIC_RELAXED, __HIP_MEMORY_SCOPE_AGENT); } }
    if (PROBE_XCC && bid == 0) { __syncthreads(); if (tid == 0) { const unsigned* xp = (const unsigned*)(ws + WS_CTL) + 3000; int bad = 0; for (int i2 = 0; i2 < G; ++i2) bad += (xp[i2] != xp[i2 & 7]) ? 1 : 0; P.out[0] += 1.0f + (float)bad; } }
    if (PROBE_CLOCK_PHASE >= 0 && bid == 0) { __syncthreads(); if (tid == 0) { const unsigned long long* tsp = (const unsigned long long*)(ws + WS_CTL) + 1024;
        const float ghz = (float)(tsp[2] - tsp[0]) / ((float)(tsp[3] - tsp[1]) * 10.0f); __threadfence(); P.out[0] += ghz; } }
#if PROBE_DUMMY_GEMM
    { xcd_barrier(bar); pg8::Gemm g{P.H1, P.W1IN, M, PROBE_DG_N, PROBE_DG_K, 0}; pg8::StaticOrder S; S.init(M, PROBE_DG_N, G, bid); EpiMoba E{P.Q1, P.K1, P.V1, P.G1, P.pos};
        if (PROBE_DG_EPI >= 0) { EpiProbe<(PROBE_DG_EPI < 0 ? 0 : PROBE_DG_EPI)> E2{P.Q1}; pg8::gemm_phase<EpiProbe<(PROBE_DG_EPI < 0 ? 0 : PROBE_DG_EPI)>, pg8::StaticOrder, true, true>(L, g, S, E2); }
        else pg8::gemm_phase<EpiMoba, pg8::StaticOrder, true, true, PROBE_DG_BF16>(L, g, S, E); }
#endif
#undef IN
#undef SEAM
}

#ifndef MK_N_LAUNCHES
#define MK_N_LAUNCHES 1
#endif
extern "C" void kernel_launch(void* const* d_in, const int* in_sizes, int n_in, void* d_out, int out_size, void* d_ws, size_t ws_size, hipStream_t stream) {
    static int grid = 0;
    if (grid == 0) {
        if (n_in != 11 || out_size != M * D || ws_size < WS_END) { fprintf(stderr, "kernel_launch: unexpected shapes (n_in %d out %d ws %zu)\n", n_in, out_size, ws_size); grid = -1; return; }
        int dev = 0, cus = 0, per_cu = 0;
        if (hipGetDevice(&dev) != hipSuccess || hipDeviceGetAttribute(&cus, hipDeviceAttributeMultiprocessorCount, dev) != hipSuccess) { grid = -1; return; }
        if (hipFuncSetAttribute((const void*)mk_fwd, hipFuncAttributeMaxDynamicSharedMemorySize, LDS_BYTES) != hipSuccess) { fprintf(stderr, "kernel_launch: hipFuncSetAttribute failed\n"); grid = -1; return; }
        if (hipOccupancyMaxActiveBlocksPerMultiprocessor(&per_cu, (const void*)mk_fwd, NT, LDS_BYTES) != hipSuccess || per_cu < 1) { fprintf(stderr, "kernel_launch: occupancy query says %d\n", per_cu); (void)hipGetLastError(); grid = -1; return; }
        grid = cus;
    }
    if (grid < 0) return;
    if (hipMemsetAsync((char*)d_ws + WS_CTL, 0, CTL_ZERO_BYTES, stream) != hipSuccess) return;
    Args a{};
    for (int i = 0; i < 11; ++i) a.in[i] = d_in[i];
    a.out = (float*)d_out; a.ws = (unsigned char*)d_ws;
    if (MK_N_LAUNCHES == 1) { a.ph_lo = 0; a.ph_hi = NPHASE; hipLaunchKernelGGL(mk_fwd, dim3(grid), dim3(NT), LDS_BYTES, stream, a); }
    else for (int p = 0; p < NPHASE; ++p) { a.ph_lo = p; a.ph_hi = p + 1; hipLaunchKernelGGL(mk_fwd, dim3(grid), dim3(NT), LDS_BYTES, stream, a); }
}
```
